# Optimizing an MI355X kernel written in HIP

```python
import math
import jax, jax.numpy as jnp
from jax import lax
import numpy as np

D_MODEL = 2048
BATCH = 2
SEQ = 8192
DEPTH = 1

N_META = 16
D_CONV = D_MODEL
CONV_W = 3
CONV_GROUPS = 8
MLSTM_HEADS = 8
D_MV = D_MODEL
D_MQK = D_MODEL // 2
HEAD_V = D_MV // MLSTM_HEADS
HEAD_QK = D_MQK // MLSTM_HEADS
CHUNK = 64
PEER_HEADS = 8
N_KEYS = 128
N_EXPERTS = N_KEYS * N_KEYS
D_KEY = 256
HALF_KEY = D_KEY // 2
TOPK = 16
PEER_BLOCK = 128
N_IN = 3 * D_CONV + 2 * D_MQK + 2 * D_MV + 2 * MLSTM_HEADS + 2 * D_MODEL
ALPHA = (2 * DEPTH) ** 0.25
BETA = (8 * DEPTH) ** -0.25
LN_EPS = 1e-5
I_GATE_PAD = -1e30

kernel_name = "hybrid_conv_mlstm_peer_block"


def layer_norm(x, g, b):
    xf = x.astype(jnp.float32)
    mu = xf.mean(-1, keepdims=True)
    var = jnp.square(xf - mu).mean(-1, keepdims=True)
    y = (xf - mu) * lax.rsqrt(var + LN_EPS)
    return (y * g + b).astype(x.dtype)


def short_conv_mixer(b_gate, c_gate, xc, conv_w):
    z = c_gate * xc
    L = z.shape[1]
    zp = jnp.pad(z, ((0, 0), (CONV_W - 1, 0), (0, 0)))
    y = sum(conv_w[k] * zp[:, k:k + L] for k in range(CONV_W))
    return b_gate * y


def mlstm_chunkwise(q, k, v, i_pre, f_pre):
    Bsz, L = q.shape[:2]
    pad = (-L) % CHUNK

    def lead_pad(a, value=0.0):
        return jnp.pad(a, ((0, 0), (pad, 0)) + ((0, 0),) * (a.ndim - 2), constant_values=value)

    q = lead_pad(q.astype(jnp.float32) * (HEAD_QK ** -0.5))
    k = lead_pad(k.astype(jnp.float32))
    v = lead_pad(v.astype(jnp.float32))
    log_i = lead_pad(i_pre.astype(jnp.float32), I_GATE_PAD)
    log_f = lead_pad(jax.nn.log_sigmoid(f_pre.astype(jnp.float32)))
    Lp = L + pad
    nc = Lp // CHUNK

    def to_chunks(a):
        a = a.reshape((Bsz, nc, CHUNK) + a.shape[2:])
        return jnp.moveaxis(a, (1, 3), (0, 2))

    xs = (to_chunks(q), to_chunks(k), to_chunks(v), to_chunks(log_i), to_chunks(log_f))
    causal = jnp.tril(jnp.ones((CHUNK, CHUNK), dtype=bool))

    def step(carry, xs_c):
        C, n, m = carry
        qc, kc, vc, li, lf = xs_c
        b = jnp.cumsum(lf, axis=-1)
        d = b[..., :, None] - b[..., None, :] + li[..., None, :]
        d = jnp.where(causal, d, -jnp.inf)
        inter = b + m[..., None]
        m_t = jnp.maximum(inter, d.max(-1))
        w = jnp.exp(d - m_t[..., None])
        s = jnp.einsum('bhtd,bhsd->bhts', qc, kc) * w
        sc_inter = jnp.exp(inter - m_t)
        num = (jnp.einsum('bhts,bhsv->bhtv', s, vc)
               + sc_inter[..., None] * jnp.einsum('bhtd,bhdv->bhtv', qc, C))
        den = s.sum(-1) + sc_inter * jnp.einsum('bhtd,bhd->bht', qc, n)
        h = num / jnp.maximum(jnp.abs(den), jnp.exp(-m_t))[..., None]
        b_last = b[..., -1]
        dl = b_last[..., None] - b + li
        m_new = jnp.maximum(b_last + m, dl.max(-1))
        wl = jnp.exp(dl - m_new[..., None])
        decay = jnp.exp(b_last + m - m_new)
        C_new = decay[..., None, None] * C + jnp.einsum('bhs,bhsd,bhsv->bhdv', wl, kc, vc)
        n_new = decay[..., None] * n + jnp.einsum('bhs,bhsd->bhd', wl, kc)
        return (C_new, n_new, m_new), h

    H = q.shape[2]
    init = (jnp.zeros((Bsz, H, HEAD_QK, HEAD_V), jnp.float32),
            jnp.zeros((Bsz, H, HEAD_QK), jnp.float32),
            jnp.zeros((Bsz, H), jnp.float32))
    _, hs = lax.scan(step, init, xs)
    hs = jnp.transpose(hs, (1, 0, 3, 2, 4)).reshape(Bsz, Lp, H, HEAD_V)
    return hs[:, pad:]


def token_mixer(h, w_in, b_if, conv_w, mh_norm_w, p_a, p_b, w_o):
    Bsz, L, _ = h.shape
    proj = jnp.einsum('bld,dn->bln', h, w_in)
    sizes = [D_CONV, D_CONV, D_CONV, D_MQK, D_MQK, D_MV, D_MV, 2 * MLSTM_HEADS, D_MODEL, D_MODEL]
    offsets = np.cumsum(sizes)[:-1].tolist()
    cb, cc, cx, q, k, v, o, gif, ga, gb = jnp.split(proj, offsets, axis=-1)
    y_a = short_conv_mixer(cb, cc, cx, conv_w)
    i_pre = gif[..., :MLSTM_HEADS] + b_if[:MLSTM_HEADS]
    f_pre = gif[..., MLSTM_HEADS:] + b_if[MLSTM_HEADS:]
    hm = mlstm_chunkwise(q.reshape(Bsz, L, MLSTM_HEADS, HEAD_QK),
                         k.reshape(Bsz, L, MLSTM_HEADS, HEAD_QK),
                         v.reshape(Bsz, L, MLSTM_HEADS, HEAD_V), i_pre, f_pre)
    hm = hm * lax.rsqrt(jnp.mean(jnp.square(hm), -1, keepdims=True) + LN_EPS)
    hm = hm.reshape(Bsz, L, D_MV) * mh_norm_w
    y_b = jax.nn.sigmoid(o) * hm.astype(h.dtype)
    merged = (jax.nn.sigmoid(ga) * jnp.einsum('blc,cd->bld', y_a, p_a)
              + jax.nn.sigmoid(gb) * jnp.einsum('blc,cd->bld', y_b, p_b))
    return jnp.einsum('bld,de->ble', merged, w_o)


def peer_ffn(h, peer_wq, peer_keys, peer_u, peer_v):
    Bsz, L, D = h.shape
    T = Bsz * L
    t = h.reshape(T, D)
    q = (t @ peer_wq).reshape(T, PEER_HEADS, 2, HALF_KEY)
    sc = jnp.einsum('thpk,hpnk->thpn', q, peer_keys).astype(jnp.float32)
    s_top, i_top = lax.top_k(sc, TOPK)
    cand = s_top[..., 0, :, None] + s_top[..., 1, None, :]
    cand_idx = i_top[..., 0, :, None] * N_KEYS + i_top[..., 1, None, :]
    best_s, best_pos = lax.top_k(cand.reshape(T, PEER_HEADS, TOPK * TOPK), TOPK)
    expert_idx = jnp.take_along_axis(cand_idx.reshape(T, PEER_HEADS, TOPK * TOPK), best_pos, axis=-1)
    g = jax.nn.softmax(best_s, axis=-1)
    idx = expert_idx.reshape(T, PEER_HEADS * TOPK)
    g = g.reshape(T, PEER_HEADS * TOPK).astype(h.dtype)
    npad = (-T) % PEER_BLOCK
    tb = jnp.pad(t, ((0, npad), (0, 0))).reshape(-1, PEER_BLOCK, D)
    ib = jnp.pad(idx, ((0, npad), (0, 0))).reshape(-1, PEER_BLOCK, PEER_HEADS * TOPK)
    gbk = jnp.pad(g, ((0, npad), (0, 0))).reshape(-1, PEER_BLOCK, PEER_HEADS * TOPK)

    def eval_block(args):
        xb, eb, wb = args
        u = peer_u[eb]
        a = jax.nn.gelu(jnp.einsum('td,tkd->tk', xb, u), approximate=False)
        return jnp.einsum('tk,tkd->td', wb * a, peer_v[eb])

    out = lax.map(eval_block, (tb, ib, gbk))
    return out.reshape(-1, D)[:T].reshape(Bsz, L, D)


def setup_inputs(seed: int = 0) -> dict:
    key = jax.random.key(seed)
    ks = jax.random.split(key, 24)
    nrm = jax.random.normal
    D = D_MODEL
    H = MLSTM_HEADS
    b_i = 0.1 * nrm(ks[3], (DEPTH, H))
    b_f = jnp.linspace(3.0, 6.0, H)[None, :] + 0.1 * nrm(ks[4], (DEPTH, H))
    return {
        "x": nrm(ks[0], (BATCH, SEQ, D), jnp.float32),
        "meta_tokens": nrm(ks[1], (N_META, D), jnp.float32),
        "ln0_g": 1.0 + 0.1 * nrm(ks[20], (D,)),
        "ln0_b": 0.02 * nrm(ks[21], (D,)),
        "w_in": nrm(ks[2], (DEPTH, D, N_IN)) * D ** -0.5,
        "b_if": jnp.concatenate([b_i, b_f], axis=-1),
        "conv_w": nrm(ks[5], (DEPTH, CONV_W, D_CONV)) * CONV_W ** -0.5,
        "mh_norm_w": 1.0 + 0.1 * nrm(ks[6], (DEPTH, D_MV)),
        "p_a": nrm(ks[7], (DEPTH, D_CONV, D)) * D_CONV ** -0.5,
        "p_b": nrm(ks[8], (DEPTH, D_MV, D)) * D_MV ** -0.5,
        "w_o": nrm(ks[9], (DEPTH, D, D)) * (D ** -0.5) * BETA,
        "ln1_g": 1.0 + 0.1 * nrm(ks[10], (DEPTH, D)),
        "ln1_b": 0.02 * nrm(ks[11], (DEPTH, D)),
        "peer_wq": nrm(ks[12], (DEPTH, D, PEER_HEADS * D_KEY)) * D ** -0.5,
        "peer_keys": nrm(ks[13], (DEPTH, PEER_HEADS, 2, N_KEYS, HALF_KEY)) * HALF_KEY ** -0.5,
        "peer_u": nrm(ks[14], (DEPTH, N_EXPERTS, D)) * D ** -0.5,
        "peer_v": nrm(ks[15], (DEPTH, N_EXPERTS, D)) * BETA,
        "ln2_g": 1.0 + 0.1 * nrm(ks[16], (DEPTH, D)),
        "ln2_b": 0.02 * nrm(ks[17], (DEPTH, D)),
    }


def reference(x, meta_tokens, ln0_g, ln0_b, w_in, b_if, conv_w, mh_norm_w, p_a, p_b, w_o,
              ln1_g, ln1_b, peer_wq, peer_keys, peer_u, peer_v, ln2_g, ln2_b):
    Bsz = x.shape[0]
    meta = jnp.broadcast_to(meta_tokens[None].astype(x.dtype), (Bsz, N_META, D_MODEL))
    h = layer_norm(jnp.concatenate([meta, x], axis=1), ln0_g, ln0_b)
    for l in range(DEPTH):
        mix = token_mixer(h, w_in[l], b_if[l], conv_w[l], mh_norm_w[l], p_a[l], p_b[l], w_o[l])
        h = layer_norm(ALPHA * h + mix, ln1_g[l], ln1_b[l])
        ffn = peer_ffn(h, peer_wq[l], peer_keys[l], peer_u[l], peer_v[l])
        h = layer_norm(ALPHA * h + ffn, ln2_g[l], ln2_b[l])
    return h[:, N_META:]
```

```cpp
#include <hip/hip_runtime.h>
#include <hip/hip_cooperative_groups.h>
#include <cstdio>
#include <cstdint>
namespace pg8 {
#define PG8_LAS __attribute__((address_space(3)))
typedef unsigned short bf16_t;
typedef short bf16x8 __attribute__((ext_vector_type(8)));
typedef float f32x4 __attribute__((ext_vector_type(4)));
typedef unsigned u32x4 __attribute__((ext_vector_type(4)));
constexpr int BM = 256, BK = 64, HALF = 128, HTB = HALF * BK * 2  , STAGE_BYTES = 8 * HTB, NXCD = 8, WGM = 8;

__host__ __device__ __forceinline__ int lds_byte(int r, int c) { const int st = (r >> 4) * 2 + (c >> 5), rr = r & 15, cc = c & 31, ob = rr * 64 + cc * 2; return st * 1024 + (ob ^ (((ob >> 9) & 1) << 5)); }
__host__ __device__ __forceinline__ void stage_rc(int b, int& R, int& C) { const int st = b / 1024, sb = b % 1024, swz = sb ^ (((sb >> 9) & 1) << 5); R = (st >> 1) * 16 + swz / 64; C = (st & 1) * 32 + (swz % 64) / 2; }
__host__ __device__ __forceinline__ int perm32(int rho) { const int n = rho >> 4, i = rho & 15; return 8 * (i >> 2) + 4 * n + (i & 3); }

struct Unit { int pm, pn; };
struct Gemm { const bf16_t* A; const bf16_t* Bt; int M, N, K; };

struct StaticOrder {
    int nM, nN, nwg, G, c;
    __host__ __device__ void init(int M, int N, int G_, int c_) { nM = M / BM; nN = N / BM; nwg = nM * nN; G = G_; c = c_; }
    __host__ __device__ bool next(int i, Unit& u) const {
        const long L = (long)i * G + c; if (L >= nwg) return false;
        int wgid = (int)L; { const int q = nwg / NXCD, r = nwg % NXCD, xcd = wgid % NXCD, off = wgid / NXCD; wgid = (xcd < r ? xcd * (q + 1) : r * (q + 1) + (xcd - r) * q) + off; }
        const int nig = WGM * nN, gid = wgid / nig, fm = gid * WGM, gsz = (nM - fm) < WGM ? (nM - fm) : WGM;
        u.pm = fm + ((wgid % nig) % gsz); u.pn = (wgid % nig) / gsz; return true;
    }
    __device__ __forceinline__ void a_ready(const Unit&) const {}
    __device__ __forceinline__ void done(const Unit&) const {}
};

typedef __bf16 bf16x2_t __attribute__((ext_vector_type(2)));
__device__ __forceinline__ unsigned cvt_pk_bf16(float lo, float hi) { bf16x2_t v; v[0] = (__bf16)lo; v[1] = (__bf16)hi; return __builtin_bit_cast(unsigned, v); }
typedef float f32x2 __attribute__((ext_vector_type(2)));
__device__ __forceinline__ f32x2 gelu_pk(f32x2 v) {
    const f32x2 av = __builtin_elementwise_abs(v), d = av * 0.2316418882f + 1.0f;
    f32x2 t; t.x = __builtin_amdgcn_rcpf(d.x); t.y = __builtin_amdgcn_rcpf(d.y);
    f32x2 q = t * 0.5307027145f + (-0.7265760135f); q = q * t + 0.7107068705f; q = q * t + (-0.142248368f); q = q * t + 0.127414796f; q = q * t;
    const f32x2 s = (v * v) * (-0.72134752044f);
    f32x2 e; e.x = __builtin_amdgcn_exp2f(s.x); e.y = __builtin_amdgcn_exp2f(s.y);
    const f32x2 m = v * (q * e), r = v - m;
    f32x2 o; o.x = v.x < 0.f ? m.x : r.x; o.y = v.y < 0.f ? m.y : r.y; return o;
}

template <int ACT  > struct EpiBf16 {
    static constexpr bool PERM = true, AFTER_DRAIN = false; static_assert(ACT == 0 || ACT == 1, "EpiBf16: ACT is 0 (none) or 1 (gelu_pk)");
    bf16_t* O; int ldc; const float* bias; int split_cols; size_t split_stride; float scale0;
    __device__ __forceinline__ void operator()(const f32x4 (&acc)[2][2][4][2], const Unit& u, int wr, int wc, int fr, int fq) const {
        const int row0 = u.pm * BM + wr * 64 + fr; int colt = u.pn * BM; bf16_t* base = O;
        float sc = 1.f; if (split_cols) { const int t = colt / split_cols; base += (size_t)t * split_stride; colt -= t * split_cols; if (t == 0) sc = scale0; }
        const int col0 = colt + wc * 32 + 8 * fq, bcol0 = u.pn * BM + wc * 32 + 8 * fq;
        f32x4 bv[2][2];
#pragma unroll
        for (int bj = 0; bj < 2; ++bj)
#pragma unroll
            for (int n = 0; n < 2; ++n) bv[bj][n] = bias ? *(const f32x4*)(bias + bcol0 + bj * HALF + 4 * n) : (f32x4){0.f, 0.f, 0.f, 0.f};
#pragma unroll
        for (int ai = 0; ai < 2; ++ai)
#pragma unroll
            for (int m = 0; m < 4; ++m) { bf16_t* rowp = base + (size_t)(row0 + ai * HALF + m * 16) * ldc + col0;
#pragma unroll
                for (int bj = 0; bj < 2; ++bj) { f32x4 v0 = acc[ai][bj][m][0] + bv[bj][0], v1 = acc[ai][bj][m][1] + bv[bj][1];
                    if (ACT == 1) { f32x2 a = gelu_pk((f32x2){v0[0], v0[1]}), b = gelu_pk((f32x2){v0[2], v0[3]}), c = gelu_pk((f32x2){v1[0], v1[1]}), d = gelu_pk((f32x2){v1[2], v1[3]});
                        v0 = (f32x4){a.x, a.y, b.x, b.y}; v1 = (f32x4){c.x, c.y, d.x, d.y}; }
                    v0 = v0 * sc; v1 = v1 * sc; u32x4 w; w.x = cvt_pk_bf16(v0[0], v0[1]); w.y = cvt_pk_bf16(v0[2], v0[3]); w.z = cvt_pk_bf16(v1[0], v1[1]); w.w = cvt_pk_bf16(v1[2], v1[3]);
                    *(u32x4*)(rowp + bj * HALF) = w; } }
    }
};
template <class Epi, class Sched, bool ALIGN_EPI = false, bool SP2 = false>
__device__ __forceinline__ void gemm_phase(PG8_LAS unsigned char* lds, const Gemm g, const Sched& S, const Epi& E) {
    const int tid = threadIdx.x, wid = __builtin_amdgcn_readfirstlane(tid >> 6), lane = tid & 63, wr = wid >> 2, wc = wid & 3, fr = lane & 15, fq = lane >> 4;
    const int K = g.K, nt = K / BK;
    unsigned voffA[2], voffB[2];
#pragma unroll
    for (int i = 0; i < 2; ++i) { int R, C; stage_rc(tid * 16 + i * 8192, R, C); const int Rb = Epi::PERM ? ((R & ~31) + perm32(R & 31)) : R;
        voffA[i] = (unsigned)(R * K + C) * 2u; voffB[i] = (unsigned)(Rb * K + C) * 2u; }
    const size_t kstep = (size_t)(BK * 2);
    const size_t hstep = (size_t)HALF * K * 2;
    const size_t tstep = 2 * hstep;
    const unsigned ldsw = (unsigned)wid * 1024u;
    const int aoff = lds_byte(wr * 64 + fr, fq * 8), boff = lds_byte(wc * 32 + fr, fq * 8);
#define PG8_SA(b, h) (((b) * 2 + (h)) * HTB)
#define PG8_SB(b, h) ((4 + (b) * 2 + (h)) * HTB)
#define PG8_STAGE(bufoff, gbase, voff) do { _Pragma("unroll") for (int _i = 0; _i < 2; ++_i) \
        __builtin_amdgcn_global_load_lds((const unsigned*)((const char*)(gbase) + (voff)[_i]), (PG8_LAS unsigned*)(lds + (bufoff) + ldsw + _i * 8192), 16, 0, 0); } while (0)
#define PG8_LDA(dst, b, h) do { _Pragma("unroll") for (int m = 0; m < 4; ++m) _Pragma("unroll") for (int k = 0; k < 2; ++k) dst[m][k] = *(const PG8_LAS bf16x8*)(lds + PG8_SA(b, h) + aoff + m * 2048 + k * 1024); } while (0)
#define PG8_LDB(dst, b, h) do { _Pragma("unroll") for (int n = 0; n < 2; ++n) _Pragma("unroll") for (int k = 0; k < 2; ++k) dst[n][k] = *(const PG8_LAS bf16x8*)(lds + PG8_SB(b, h) + boff + n * 2048 + k * 1024); } while (0)
#define PG8_MMA(ai, bj, At, Bt) do { __builtin_amdgcn_s_setprio(1); _Pragma("unroll") for (int m = 0; m < 4; ++m) _Pragma("unroll") for (int n = 0; n < 2; ++n) _Pragma("unroll") for (int k = 0; k < 2; ++k) \
        acc[ai][bj][m][n] = __builtin_amdgcn_mfma_f32_16x16x32_bf16(Bt[n][k], At[m][k], acc[ai][bj][m][n], 0, 0, 0); __builtin_amdgcn_s_setprio(0); } while (0)
#define PG8_WAIT_V(n) asm volatile("s_waitcnt vmcnt(" #n ")" ::: "memory")
#define PG8_WAIT_L(n) asm volatile("s_waitcnt lgkmcnt(" #n ")" ::: "memory")
#define PG8_BAR __builtin_amdgcn_s_barrier()
#define PG8_SCHED __builtin_amdgcn_sched_barrier(0)
    Unit cur, nxt; int ui = 0;
    if (!S.next(0, cur)) return;
    f32x4 acc[2][2][4][2];
#pragma unroll
    for (int a = 0; a < 2; ++a)
#pragma unroll
        for (int b = 0; b < 2; ++b)
#pragma unroll
            for (int m = 0; m < 4; ++m)
#pragma unroll
                for (int n = 0; n < 2; ++n) acc[a][b][m][n] = (f32x4){0.f, 0.f, 0.f, 0.f};
    bf16x8 At[4][2], B0[2][2], B1[2][2];
    const char* cA = (const char*)g.A + (size_t)cur.pm * tstep; const char* cB = (const char*)g.Bt + (size_t)cur.pn * tstep;
    S.a_ready(cur);
    if constexpr (SP2) {
        PG8_STAGE(PG8_SB(0, 0), cB, voffB); PG8_STAGE(PG8_SB(0, 1), cB + hstep, voffB); PG8_STAGE(PG8_SA(0, 0), cA, voffA); PG8_STAGE(PG8_SA(0, 1), cA + hstep, voffA);
        if (wr == 1) PG8_BAR;
        PG8_WAIT_V(2); PG8_BAR;
        PG8_STAGE(PG8_SB(1, 0), cB + kstep, voffB); PG8_STAGE(PG8_SA(1, 0), cA + kstep, voffA); PG8_STAGE(PG8_SB(1, 1), cB + hstep + kstep, voffB);
        PG8_WAIT_V(6); PG8_BAR;
    } else {
        PG8_STAGE(PG8_SB(0, 0), cB, voffB); PG8_STAGE(PG8_SA(0, 0), cA, voffA); PG8_STAGE(PG8_SB(0, 1), cB + hstep, voffB); PG8_STAGE(PG8_SA(0, 1), cA + hstep, voffA);
        if (wr == 1) PG8_BAR;
        PG8_WAIT_V(4); PG8_BAR;
        PG8_STAGE(PG8_SB(1, 0), cB + kstep, voffB); PG8_STAGE(PG8_SA(1, 0), cA + kstep, voffA); PG8_STAGE(PG8_SB(1, 1), cB + hstep + kstep, voffB);
        PG8_WAIT_V(6); PG8_BAR;
    }
    for (;;) {
        const bool has_next = S.next(ui + 1, nxt);
        const char* nA = has_next ? (const char*)g.A + (size_t)nxt.pm * tstep : cA; const char* nB = has_next ? (const char*)g.Bt + (size_t)nxt.pn * tstep : cB;
        for (int t = 0; t < nt; t += 2) {
            const bool last = (t == nt - 2);
            const char* a1 = cA + (size_t)(t + 1) * kstep;
            const char* a2 = last ? nA : cA + (size_t)(t + 2) * kstep; const char* b2 = last ? nB : cB + (size_t)(t + 2) * kstep;
            const char* a3 = a2 + kstep; const char* b3 = b2 + kstep;
            if (last && has_next) S.a_ready(nxt);
            if constexpr (SP2) {
            PG8_LDB(B0, 0, 0); PG8_LDB(B1, 0, 1); PG8_SCHED; PG8_LDA(At, 0, 0); PG8_STAGE(PG8_SA(1, 1), a1 + hstep, voffA);
            PG8_WAIT_V(8); PG8_WAIT_L(0); PG8_BAR; PG8_MMA(0, 0, At, B0); PG8_MMA(0, 1, At, B1); PG8_BAR; PG8_SCHED;
            PG8_LDA(At, 0, 1); PG8_STAGE(PG8_SB(0, 0), b2, voffB); PG8_STAGE(PG8_SB(0, 1), b2 + hstep, voffB); PG8_STAGE(PG8_SA(0, 0), a2, voffA);
            PG8_WAIT_V(8); PG8_WAIT_L(0); PG8_BAR; PG8_MMA(1, 0, At, B0); PG8_MMA(1, 1, At, B1); PG8_BAR; PG8_SCHED;
            PG8_LDB(B0, 1, 0); PG8_LDB(B1, 1, 1); PG8_SCHED; PG8_LDA(At, 1, 0); PG8_STAGE(PG8_SA(0, 1), a2 + hstep, voffA);
            PG8_WAIT_V(8); PG8_WAIT_L(0); PG8_BAR; PG8_MMA(0, 0, At, B0); PG8_MMA(0, 1, At, B1); PG8_BAR; PG8_SCHED;
            PG8_LDA(At, 1, 1); PG8_STAGE(PG8_SB(1, 0), b3, voffB); PG8_STAGE(PG8_SB(1, 1), b3 + hstep, voffB); PG8_STAGE(PG8_SA(1, 0), a3, voffA);
            PG8_WAIT_V(8); PG8_WAIT_L(0); PG8_BAR; PG8_MMA(1, 0, At, B0); PG8_MMA(1, 1, At, B1); PG8_BAR; PG8_SCHED;
            } else {
            PG8_LDB(B0, 0, 0); PG8_SCHED; PG8_LDA(At, 0, 0); PG8_STAGE(PG8_SA(1, 1), a1 + hstep, voffA);
            PG8_WAIT_L(8); PG8_BAR; PG8_WAIT_L(0); PG8_MMA(0, 0, At, B0); PG8_BAR; PG8_SCHED;
            PG8_LDB(B1, 0, 1); PG8_STAGE(PG8_SB(0, 0), b2, voffB);
            PG8_BAR; PG8_WAIT_L(0); PG8_MMA(0, 1, At, B1); PG8_BAR;
            PG8_LDA(At, 0, 1); PG8_STAGE(PG8_SA(0, 0), a2, voffA);
            PG8_BAR; PG8_WAIT_L(0); PG8_MMA(1, 0, At, B0); PG8_BAR; PG8_SCHED;
            PG8_STAGE(PG8_SB(0, 1), b2 + hstep, voffB);
            PG8_WAIT_V(6); PG8_BAR; PG8_MMA(1, 1, At, B1); PG8_BAR;
            PG8_LDB(B0, 1, 0); PG8_SCHED; PG8_LDA(At, 1, 0); PG8_STAGE(PG8_SA(0, 1), a2 + hstep, voffA);
            PG8_WAIT_L(8); PG8_BAR; PG8_WAIT_L(0); PG8_MMA(0, 0, At, B0); PG8_BAR; PG8_SCHED;
            PG8_LDB(B1, 1, 1); PG8_STAGE(PG8_SB(1, 0), b3, voffB);
            PG8_BAR; PG8_WAIT_L(0); PG8_MMA(0, 1, At, B1); PG8_BAR;
            PG8_LDA(At, 1, 1); PG8_STAGE(PG8_SA(1, 0), a3, voffA);
            PG8_BAR; PG8_WAIT_L(0); PG8_MMA(1, 0, At, B0); PG8_BAR; PG8_SCHED;
            PG8_STAGE(PG8_SB(1, 1), b3 + hstep, voffB);
            PG8_WAIT_V(6); PG8_BAR; PG8_MMA(1, 1, At, B1); PG8_BAR;
            }
        }
        if constexpr (ALIGN_EPI) { if (wr == 0) PG8_BAR; }
        if constexpr (!Epi::AFTER_DRAIN) { E(acc, cur, wr, wc, fr, fq); S.done(cur); }
        if (!has_next) break;
#pragma unroll
        for (int a = 0; a < 2; ++a)
#pragma unroll
            for (int b = 0; b < 2; ++b)
#pragma unroll
                for (int m = 0; m < 4; ++m)
#pragma unroll
                    for (int n = 0; n < 2; ++n) acc[a][b][m][n] = (f32x4){0.f, 0.f, 0.f, 0.f};
        cur = nxt; cA = nA; cB = nB; ++ui;
        if constexpr (ALIGN_EPI) { if (wr == 1) PG8_BAR; }
    }
    PG8_WAIT_V(0);
    if constexpr (!ALIGN_EPI) { if (wr == 0) PG8_BAR; }
    PG8_BAR;
    if constexpr (Epi::AFTER_DRAIN) { E.fused(acc, cur, wr, wc, fr, fq, lds, wid, lane); S.done(cur); }
#undef PG8_SA
#undef PG8_SB
#undef PG8_STAGE
#undef PG8_LDA
#undef PG8_LDB
#undef PG8_MMA
#undef PG8_WAIT_V
#undef PG8_WAIT_L
#undef PG8_BAR
#undef PG8_SCHED
}
}

#ifndef MK_DBG
#define MK_DBG 0
#endif
#ifndef MK_ALIGN
#define MK_ALIGN true
#endif
#ifndef MK_SP2
#define MK_SP2 true
#endif
namespace mk {
#define GAS __attribute__((address_space(1)))
#define LAS __attribute__((address_space(3)))
typedef unsigned short bf16;
typedef unsigned v4u __attribute__((ext_vector_type(4)));
typedef unsigned v2u __attribute__((ext_vector_type(2)));
typedef float f32x4 __attribute__((ext_vector_type(4)));
typedef float f32x2 __attribute__((ext_vector_type(2)));

constexpr int D = 2048, MX = 16384, MP = 16640, SEQ = 8192, NMETA = 16;
constexpr int NIN = 16400, NINP = 16640;
constexpr int NH = 8, DQK = 128, DV = 256;
constexpr int LSEQ = SEQ + NMETA;
constexpr float LN_EPS = 1e-5f;
constexpr float ALPHA = 1.189207115002721f;
constexpr float QSCALE = 0.08838834764831845f;

constexpr size_t MiB = 1u << 20;
constexpr size_t WS_CTL = 0, CTL_ZERO_BYTES = 512 * 1024;
constexpr size_t CTL_C1 = 256 * 1024;
constexpr size_t CTL_C0 = 264 * 1024;
constexpr size_t CTL_C1P = 512 * 1024, CTL_C0P = 768 * 1024;
constexpr size_t WS_GIF = 2 * MiB;
constexpr size_t WS_BT_PA = 4 * MiB, WS_BT_PB = 12 * MiB, WS_BT_WO = 20 * MiB, WS_BT_F = 28 * MiB;
constexpr size_t WS_H0 = 36 * MiB;
constexpr size_t WS_BT_IN = 101 * MiB;
constexpr size_t WS_UBF = WS_BT_IN;
constexpr size_t WS_CB = 166 * MiB;
constexpr size_t WS_R = WS_CB;
constexpr size_t WS_Z = 230 * MiB;
constexpr size_t WS_VBF = WS_Z;
constexpr size_t WS_Q = 295 * MiB;
constexpr size_t WS_K = 327 * MiB;
constexpr size_t WS_TMP = WS_Q;
constexpr size_t WS_V = 360 * MiB;
constexpr size_t WS_SIGO = 425 * MiB;
constexpr size_t WS_MERGED = WS_SIGO;
constexpr size_t WS_END = 489 * MiB;
constexpr size_t OUT_SGA = 0, OUT_SGB = 64 * MiB;

constexpr int LDS_BYTES = 147456;

struct Params {
    const float *x, *meta, *ln0_g, *ln0_b, *w_in, *b_if, *conv_w, *mh_w, *p_a, *p_b, *w_o, *ln1_g, *ln1_b, *peer_wq, *peer_keys, *peer_u, *peer_v, *ln2_g, *ln2_b;
    float* out; unsigned char* ws;
};

__device__ __forceinline__ float bf2f(unsigned u) { return __uint_as_float(u << 16); }
__device__ __forceinline__ float bflo(unsigned w) { return __uint_as_float(w << 16); }
__device__ __forceinline__ float bfhi(unsigned w) { return __uint_as_float(w & 0xffff0000u); }
__device__ __forceinline__ unsigned pk2(float lo, float hi) { return pg8::cvt_pk_bf16(lo, hi); }
__device__ __forceinline__ float wave_sum(float v) {
#pragma unroll
    for (int o = 1; o < 64; o <<= 1) v += __shfl_xor(v, o);
    return v;
}
__device__ __forceinline__ float sigmoidf_(float x) { return __builtin_amdgcn_rcpf(1.0f + __expf(-x)); }
#define LDS_WAIT() asm volatile("s_waitcnt lgkmcnt(0)" ::: "memory")

__device__ __forceinline__ int in_dest_row(int n) {
    if (n < 2048) return n;
    if (n < 4096) { const int c = n - 2048; return (8 + (c >> 7)) * 256 + (c & 127); }
    if (n < 6144) { const int c = n - 4096; return (8 + (c >> 7)) * 256 + 128 + (c & 127); }
    if (n < 7168) return 24 * 256 + (n - 6144);
    if (n < 8192) return 28 * 256 + (n - 7168);
    if (n < 10240) return 32 * 256 + (n - 8192);
    if (n < 12288) return 40 * 256 + (n - 10240);
    if (n < 12304) return 64 * 256 + (n - 12288);
    if (n < 14352) return 48 * 256 + (n - 12304);
    return 56 * 256 + (n - 14352);
}
template <bool INMAP>
__device__ __forceinline__ void transpose_item(const float* W, int K, int N, bf16* WT, LAS float* scr, int item, int lane) {
    const int nblk = (N + 31) / 32, kb = item / nblk, nb = item % nblk, k0 = 64 * kb, n0 = 32 * nb;
    const int nn = n0 + (lane & 31);
#pragma unroll 8
    for (int i = 0; i < 32; ++i) { const int kk = 2 * i + (lane >> 5); scr[kk * 33 + (lane & 31)] = (nn < N) ? W[(size_t)(k0 + kk) * N + nn] : 0.f; }
    LDS_WAIT();
    const int c = lane & 7;
#pragma unroll
    for (int j = 0; j < 4; ++j) { const int nl = (lane >> 3) + 8 * j; const int n = n0 + nl; const LAS float* s = scr + (8 * c) * 33 + nl;
        v4u o; o.x = pk2(s[0 * 33], s[1 * 33]); o.y = pk2(s[2 * 33], s[3 * 33]); o.z = pk2(s[4 * 33], s[5 * 33]); o.w = pk2(s[6 * 33], s[7 * 33]);
        if (n < N) { const int dr = INMAP ? in_dest_row(n) : n; *(v4u*)(WT + (size_t)dr * K + k0 + 8 * c) = o; } }
    LDS_WAIT();
}
__device__ __forceinline__ void ln0_row(const Params& p, int r, int lane) {
    bf16* orow = (bf16*)(p.ws + WS_H0) + (size_t)r * D;
    unsigned long long* o8 = (unsigned long long*)orow + lane;
    if (r >= MX + NMETA) {
#pragma unroll
        for (int j = 0; j < 8; ++j) o8[64 * j] = 0ull;
        return;
    }
    const float* src = (r < MX) ? p.x + (size_t)r * D : p.meta + (size_t)(r - MX) * D;
    const f32x4* xr = (const f32x4*)src + lane;
    f32x4 v[8]; float s = 0.f;
#pragma unroll
    for (int j = 0; j < 8; ++j) { v[j] = xr[64 * j]; s += (v[j].x + v[j].y) + (v[j].z + v[j].w); }
    const float mean = wave_sum(s) * (1.f / D); float s2 = 0.f;
#pragma unroll
    for (int j = 0; j < 8; ++j) { v[j] = v[j] - mean; s2 += (v[j].x * v[j].x + v[j].y * v[j].y) + (v[j].z * v[j].z + v[j].w * v[j].w); }
    const float rstd = 1.f / sqrtf(wave_sum(s2) * (1.f / D) + LN_EPS);
#pragma unroll
    for (int j = 0; j < 8; ++j) {
        const f32x4 g = *((const f32x4*)p.ln0_g + lane + 64 * j), b = *((const f32x4*)p.ln0_b + lane + 64 * j);
        const f32x4 y = v[j] * rstd * g + b;
        o8[64 * j] = (unsigned long long)pk2(y.x, y.y) | ((unsigned long long)pk2(y.z, y.w) << 32);
    }
}
__device__ __forceinline__ void wf_item(const Params& p, LAS unsigned char* lds, int item, int tid) {
    const int hp = item >> 5, dblk = item & 31;
    LAS float* keysT = (LAS float*)lds;
    LAS float* wqs = keysT + 128 * 129;
    const float* keys = p.peer_keys + (size_t)hp * 16384;
#pragma unroll 4
    for (int i = 0; i < 32; ++i) { const int e = i * 512 + tid; const int n = e >> 7, k = e & 127; keysT[k * 129 + n] = keys[e]; }
#pragma unroll 4
    for (int i = 0; i < 16; ++i) { const int e = i * 512 + tid; const int d = e >> 7, k = e & 127; wqs[d * 128 + k] = p.peer_wq[(size_t)(dblk * 64 + d) * D + hp * 128 + k]; }
    __syncthreads();
    const int n = tid & 127, dg = tid >> 7;
    float acc[16];
#pragma unroll
    for (int i = 0; i < 16; ++i) acc[i] = 0.f;
    for (int k4 = 0; k4 < 32; ++k4) {
        const float kv0 = keysT[(4 * k4 + 0) * 129 + n], kv1 = keysT[(4 * k4 + 1) * 129 + n], kv2 = keysT[(4 * k4 + 2) * 129 + n], kv3 = keysT[(4 * k4 + 3) * 129 + n];
#pragma unroll
        for (int i = 0; i < 16; ++i) { const f32x4 w = *(const LAS f32x4*)(wqs + (dg * 16 + i) * 128 + 4 * k4); acc[i] += w.x * kv0 + w.y * kv1 + w.z * kv2 + w.w * kv3; }
    }
    const int col = hp * 128 + n, d0 = dblk * 64 + dg * 16;
    float c1p = 0.f, c0p = 0.f; unsigned pk[8];
#pragma unroll
    for (int i = 0; i < 8; ++i) {
        const float f0 = p.ln1_g[d0 + 2 * i] * acc[2 * i], f1 = p.ln1_g[d0 + 2 * i + 1] * acc[2 * i + 1];
        pk[i] = pk2(f0, f1); c1p += bflo(pk[i]) + bfhi(pk[i]);
        c0p += p.ln1_b[d0 + 2 * i] * acc[2 * i] + p.ln1_b[d0 + 2 * i + 1] * acc[2 * i + 1];
    }
    bf16* dst = (bf16*)(p.ws + WS_BT_F) + (size_t)col * D + d0;
    *(v4u*)dst = (v4u){pk[0], pk[1], pk[2], pk[3]}; *(v4u*)(dst + 8) = (v4u){pk[4], pk[5], pk[6], pk[7]};
    __syncthreads();
    LAS float* cp = (LAS float*)lds;
    cp[(dg * 128 + n) * 2] = c1p; cp[(dg * 128 + n) * 2 + 1] = c0p;
    __syncthreads();
    if (tid < 128) { float a1 = 0.f, a0 = 0.f;
#pragma unroll
        for (int g = 0; g < 4; ++g) { a1 += cp[(g * 128 + tid) * 2]; a0 += cp[(g * 128 + tid) * 2 + 1]; }
        ((float*)(p.ws + CTL_C1P))[dblk * 2048 + hp * 128 + tid] = a1; ((float*)(p.ws + CTL_C0P))[dblk * 2048 + hp * 128 + tid] = a0; }
    __syncthreads();
}
__device__ __forceinline__ void phase0(const Params& p, LAS unsigned char* lds) {
    const int tid = threadIdx.x, lane = tid & 63, wave = tid >> 6;
    const int gw = blockIdx.x * 8 + wave, NGW = gridDim.x * 8;
    LAS float* scr = (LAS float*)(lds + wave * 16384);
    constexpr int I_IN = 32 * 513, I_SQ = 32 * 64;
    for (int it = gw; it < I_IN + 3 * I_SQ; it += NGW) {
        int r = it;
        if (r < I_IN) { transpose_item<true>(p.w_in, D, NIN, (bf16*)(p.ws + WS_BT_IN), scr, r, lane); continue; } r -= I_IN;
        if (r < I_SQ) { transpose_item<false>(p.p_a, D, D, (bf16*)(p.ws + WS_BT_PA), scr, r, lane); continue; } r -= I_SQ;
        if (r < I_SQ) { transpose_item<false>(p.p_b, D, D, (bf16*)(p.ws + WS_BT_PB), scr, r, lane); continue; } r -= I_SQ;
        transpose_item<false>(p.w_o, D, D, (bf16*)(p.ws + WS_BT_WO), scr, r, lane);
    }
    for (int r = gw; r < 240; r += NGW) { unsigned long long* o8 = (unsigned long long*)((bf16*)(p.ws + WS_BT_IN) + (size_t)(64 * 256 + 16 + r) * D) + lane;
#pragma unroll
        for (int j = 0; j < 8; ++j) o8[64 * j] = 0ull; }
    for (int r = gw; r < MP; r += NGW) ln0_row(p, r, lane);
    __syncthreads();
    for (int it = blockIdx.x; it < 512; it += gridDim.x) wf_item(p, lds, it, tid);
}
__device__ __forceinline__ void phase_uvconv(const Params& p) {
    const size_t n8 = (size_t)16384 * 2048 / 8;
    const size_t gt = (size_t)blockIdx.x * 512 + threadIdx.x, NT = (size_t)gridDim.x * 512;
    for (int t = 0; t < 2; ++t) {
        const float* src = t ? p.peer_v : p.peer_u; bf16* dst = (bf16*)(p.ws + (t ? WS_VBF : WS_UBF));
        for (size_t i = gt; i < n8; i += NT) {
            const f32x4 a = *((const f32x4*)src + 2 * i), b = *((const f32x4*)src + 2 * i + 1);
            *((v4u*)dst + i) = (v4u){pk2(a.x, a.y), pk2(a.z, a.w), pk2(b.x, b.y), pk2(b.z, b.w)};
        }
    }
}
}

namespace pg8 {
struct EpiInProj {
    static constexpr bool PERM = true, AFTER_DRAIN = false;
    bf16_t *CB, *Z, *Q, *K, *V, *SIGO, *SGA, *SGB; float* GIF;
    __device__ __forceinline__ void operator()(const f32x4 (&acc)[2][2][4][2], const Unit& u, int wr, int wc, int fr, int fq) const {
        const int pn = u.pn, pm = u.pm; const bool meta = (pm >= 64);
        const int row0 = pm * BM + wr * 64 + fr, cl = wc * 32 + 8 * fq;
        if (pn >= 8 && pn < 24) {
            bf16_t* base = Z + (size_t)(pn - 8) * 128 + cl;
#pragma unroll
            for (int ai = 0; ai < 2; ++ai)
#pragma unroll
                for (int m = 0; m < 4; ++m) { const f32x4 z0 = acc[ai][0][m][0] * acc[ai][1][m][0], z1 = acc[ai][0][m][1] * acc[ai][1][m][1];
                    u32x4 w; w.x = cvt_pk_bf16(z0[0], z0[1]); w.y = cvt_pk_bf16(z0[2], z0[3]); w.z = cvt_pk_bf16(z1[0], z1[1]); w.w = cvt_pk_bf16(z1[2], z1[3]);
                    *(u32x4*)(base + (size_t)(row0 + ai * HALF + m * 16) * 2048) = w; }
            return;
        }
        if (pn >= 64) {
            if (wc == 0 && fq < 2) {
#pragma unroll
                for (int ai = 0; ai < 2; ++ai)
#pragma unroll
                    for (int m = 0; m < 4; ++m) { float* g = GIF + (size_t)(row0 + ai * HALF + m * 16) * 16 + 8 * fq; *(f32x4*)g = acc[ai][0][m][0]; *(f32x4*)(g + 4) = acc[ai][0][m][1]; }
            }
            return;
        }
        if (pn < 8) { if (!meta) store<0>(acc, CB, 2048, pn, row0, cl); }
        else if (pn < 28) { if (!meta) store<2>(acc, Q, 1024, pn - 24, row0, cl); }
        else if (pn < 32) store<0>(acc, K, 1024, pn - 28, row0, cl);
        else if (pn < 40) store<0>(acc, V, 2048, pn - 32, row0, cl);
        else if (meta) return;
        else if (pn < 48) store<1>(acc, SIGO, 2048, pn - 40, row0, cl);
        else if (pn < 56) store<1>(acc, SGA, 2048, pn - 48, row0, cl);
        else store<1>(acc, SGB, 2048, pn - 56, row0, cl);
    }
    template <int ACT> __device__ __forceinline__ void store(const f32x4 (&acc)[2][2][4][2], bf16_t* base, int ld, int colt, int row0, int cl) const {
        base += (size_t)colt * 256 + cl;
#pragma unroll
        for (int ai = 0; ai < 2; ++ai)
#pragma unroll
            for (int m = 0; m < 4; ++m) { bf16_t* rowp = base + (size_t)(row0 + ai * HALF + m * 16) * ld;
#pragma unroll
                for (int bj = 0; bj < 2; ++bj) { f32x4 v0 = acc[ai][bj][m][0], v1 = acc[ai][bj][m][1];
                    if (ACT == 1) {
#pragma unroll
                        for (int e = 0; e < 4; ++e) { v0[e] = mk::sigmoidf_(v0[e]); v1[e] = mk::sigmoidf_(v1[e]); } }
                    else if (ACT == 2) { v0 = v0 * mk::QSCALE; v1 = v1 * mk::QSCALE; }
                    u32x4 w; w.x = cvt_pk_bf16(v0[0], v0[1]); w.y = cvt_pk_bf16(v0[2], v0[3]); w.z = cvt_pk_bf16(v1[0], v1[1]); w.w = cvt_pk_bf16(v1[2], v1[3]);
                    *(u32x4*)(rowp + bj * HALF) = w;
                    if (ACT == 1) asm volatile("" ::: "memory"); }
                asm volatile("" ::: "memory"); }
    }
};
template <bool SECOND> struct EpiGate {
    static constexpr bool PERM = true, AFTER_DRAIN = false;
    const bf16_t* G; const bf16_t* T; bf16_t* O;
    __device__ __forceinline__ void operator()(const f32x4 (&acc)[2][2][4][2], const Unit& u, int wr, int wc, int fr, int fq) const {
        const int row0 = u.pm * BM + wr * 64 + fr, col0 = u.pn * BM + wc * 32 + 8 * fq;
#pragma unroll
        for (int ai = 0; ai < 2; ++ai)
#pragma unroll
            for (int m = 0; m < 4; ++m) { const size_t ro = (size_t)(row0 + ai * HALF + m * 16) * 2048 + col0;
#pragma unroll
                for (int bj = 0; bj < 2; ++bj) { const size_t off = ro + bj * HALF;
                    const u32x4 g = *(const u32x4*)(G + off); u32x4 t = (u32x4){0u, 0u, 0u, 0u}; if (SECOND) t = *(const u32x4*)(T + off);
                    f32x4 v0 = acc[ai][bj][m][0], v1 = acc[ai][bj][m][1]; float o[8];
                    if ((MK_DBG == 3 && SECOND) || (MK_DBG == 4 && !SECOND)) { v0 = v0 * 0.f; v1 = v1 * 0.f; }
                    o[0] = mk::bflo(g.x) * v0[0] + mk::bflo(t.x); o[1] = mk::bfhi(g.x) * v0[1] + mk::bfhi(t.x);
                    o[2] = mk::bflo(g.y) * v0[2] + mk::bflo(t.y); o[3] = mk::bfhi(g.y) * v0[3] + mk::bfhi(t.y);
                    o[4] = mk::bflo(g.z) * v1[0] + mk::bflo(t.z); o[5] = mk::bfhi(g.z) * v1[1] + mk::bfhi(t.z);
                    o[6] = mk::bflo(g.w) * v1[2] + mk::bflo(t.w); o[7] = mk::bfhi(g.w) * v1[3] + mk::bfhi(t.w);
                    u32x4 w; w.x = cvt_pk_bf16(o[0], o[1]); w.y = cvt_pk_bf16(o[2], o[3]); w.z = cvt_pk_bf16(o[4], o[5]); w.w = cvt_pk_bf16(o[6], o[7]);
                    *(u32x4*)(O + off) = w; } }
    }
};
struct EpiResid {
    static constexpr bool PERM = true, AFTER_DRAIN = false;
    const bf16_t* H0; bf16_t* R;
    __device__ __forceinline__ void operator()(const f32x4 (&acc)[2][2][4][2], const Unit& u, int wr, int wc, int fr, int fq) const {
        const int row0 = u.pm * BM + wr * 64 + fr, col0 = u.pn * BM + wc * 32 + 8 * fq;
#pragma unroll
        for (int ai = 0; ai < 2; ++ai)
#pragma unroll
            for (int m = 0; m < 4; ++m) { const int row = row0 + ai * HALF + m * 16; const size_t ro = (size_t)row * 2048 + col0;
#pragma unroll
                for (int bj = 0; bj < 2; ++bj) { const size_t off = ro + bj * HALF;
                    const u32x4 h = *(const u32x4*)(H0 + off);
                    f32x4 v0 = acc[ai][bj][m][0], v1 = acc[ai][bj][m][1]; float o[8];
                    if (MK_DBG == 5) { v0 = v0 * 0.f; v1 = v1 * 0.f; }
                    o[0] = mk::ALPHA * mk::bflo(h.x) + v0[0]; o[1] = mk::ALPHA * mk::bfhi(h.x) + v0[1];
                    o[2] = mk::ALPHA * mk::bflo(h.y) + v0[2]; o[3] = mk::ALPHA * mk::bfhi(h.y) + v0[3];
                    o[4] = mk::ALPHA * mk::bflo(h.z) + v1[0]; o[5] = mk::ALPHA * mk::bfhi(h.z) + v1[1];
                    o[6] = mk::ALPHA * mk::bflo(h.w) + v1[2]; o[7] = mk::ALPHA * mk::bfhi(h.w) + v1[3];
                    u32x4 w; w.x = cvt_pk_bf16(o[0], o[1]); w.y = cvt_pk_bf16(o[2], o[3]); w.z = cvt_pk_bf16(o[4], o[5]); w.w = cvt_pk_bf16(o[6], o[7]);
                    *(u32x4*)(R + off) = w; } }
    }
};
struct EpiScores {
    static constexpr bool PERM = false, AFTER_DRAIN = false;
    float* S;
    __device__ __forceinline__ void operator()(const f32x4 (&acc)[2][2][4][2], const Unit& u, int wr, int wc, int fr, int fq) const {
        const int row0 = u.pm * BM + wr * 64 + fr, col0 = u.pn * BM + wc * 32 + 4 * fq;
#pragma unroll
        for (int ai = 0; ai < 2; ++ai)
#pragma unroll
            for (int m = 0; m < 4; ++m) { float* rowp = S + (size_t)(row0 + ai * HALF + m * 16) * 2048 + col0;
#pragma unroll
                for (int bj = 0; bj < 2; ++bj)
#pragma unroll
                    for (int n = 0; n < 2; ++n) *(f32x4*)(rowp + bj * HALF + n * 16) = acc[ai][bj][m][n]; }
    }
};
}

namespace mk {
__device__ __forceinline__ void phase_c1c0(const Params& p) {
    const int gt = blockIdx.x * 512 + threadIdx.x;
    if (gt < 4096) { const int col = gt & 2047; const float* src = (const float*)(p.ws + (gt < 2048 ? CTL_C1P : CTL_C0P)); float a = 0.f;
        for (int i = 0; i < 32; ++i) a += src[i * 2048 + col];
        ((float*)(p.ws + (gt < 2048 ? CTL_C1 : CTL_C0)))[col] = a; }
}
__device__ __forceinline__ void phase_conv(const Params& p) {
    bf16* CB = (bf16*)(p.ws + WS_CB); const bf16* Z = (const bf16*)(p.ws + WS_Z);
    const int gt = blockIdx.x * 512 + threadIdx.x, NT = gridDim.x * 512;
    for (int it = gt; it < 1024 * 256; it += NT) {
        const int cg = it & 255, rb = it >> 8, c0 = cg * 8, r0 = rb * 16;
        float w0[8], w1[8], w2[8];
#pragma unroll
        for (int e = 0; e < 8; ++e) { w0[e] = p.conv_w[c0 + e]; w1[e] = p.conv_w[2048 + c0 + e]; w2[e] = p.conv_w[4096 + c0 + e]; }
        const bool first = (r0 & (SEQ - 1)) == 0;
        v4u zm2 = *(const v4u*)(Z + (size_t)(first ? MX + 14 : r0 - 2) * D + c0);
        v4u zm1 = *(const v4u*)(Z + (size_t)(first ? MX + 15 : r0 - 1) * D + c0);
#pragma unroll 4
        for (int i = 0; i < 16; ++i) {
            const size_t off = (size_t)(r0 + i) * D + c0;
            const v4u z = *(const v4u*)(Z + off), cb = *(const v4u*)(CB + off);
            float y[8];
            y[0] = bflo(cb.x) * (w0[0] * bflo(zm2.x) + w1[0] * bflo(zm1.x) + w2[0] * bflo(z.x)); y[1] = bfhi(cb.x) * (w0[1] * bfhi(zm2.x) + w1[1] * bfhi(zm1.x) + w2[1] * bfhi(z.x));
            y[2] = bflo(cb.y) * (w0[2] * bflo(zm2.y) + w1[2] * bflo(zm1.y) + w2[2] * bflo(z.y)); y[3] = bfhi(cb.y) * (w0[3] * bfhi(zm2.y) + w1[3] * bfhi(zm1.y) + w2[3] * bfhi(z.y));
            y[4] = bflo(cb.z) * (w0[4] * bflo(zm2.z) + w1[4] * bflo(zm1.z) + w2[4] * bflo(z.z)); y[5] = bfhi(cb.z) * (w0[5] * bfhi(zm2.z) + w1[5] * bfhi(zm1.z) + w2[5] * bfhi(z.z));
            y[6] = bflo(cb.w) * (w0[6] * bflo(zm2.w) + w1[6] * bflo(zm1.w) + w2[6] * bflo(z.w)); y[7] = bfhi(cb.w) * (w0[7] * bfhi(zm2.w) + w1[7] * bfhi(zm1.w) + w2[7] * bfhi(z.w));
            *(v4u*)(CB + off) = (v4u){pk2(y[0], y[1]), pk2(y[2], y[3]), pk2(y[4], y[5]), pk2(y[6], y[7])};
            zm2 = zm1; zm1 = z;
        }
    }
}

__device__ __forceinline__ void phase_mlstm_naive(const Params& p, LAS unsigned char* lds) {
    const int bh = blockIdx.x; if (bh >= 16) return;
    const int b = bh >> 3, h = bh & 7, tid = threadIdx.x, lane = tid & 63, wave = tid >> 6;
    LAS float* ks = (LAS float*)lds; LAS float* qs = ks + 128; LAS float* vs = qs + 128; LAS float* part = vs + 256; LAS float* red = part + 512; LAS float* red2 = red + 8;
    const bf16* Q = (const bf16*)(p.ws + WS_Q); const bf16* K = (const bf16*)(p.ws + WS_K); bf16* V = (bf16*)(p.ws + WS_V);
    const bf16* SO = (const bf16*)(p.ws + WS_SIGO); const float* GIF = (const float*)(p.ws + WS_GIF);
    const float bi = p.b_if[h], bfg = p.b_if[8 + h];
    float C[64];
#pragma unroll
    for (int i = 0; i < 64; ++i) C[i] = 0.f;
    float nst = 0.f, m = 0.f;
    const int dv = tid & 255, half = tid >> 8;
    const float nw = p.mh_w[h * 256 + dv];
    auto rowof = [&](int l) { return (l < NMETA) ? MX + l : b * SEQ + (l - NMETA); };
    auto ldval = [&](int l) -> float {
        const int row = rowof(l);
        if (tid < 128) return bf2f(K[(size_t)row * 1024 + h * 128 + tid]);
        if (tid < 256) return (l >= NMETA) ? bf2f(Q[(size_t)row * 1024 + h * 128 + (tid - 128)]) : 0.f;
        return bf2f(V[(size_t)row * 2048 + h * 256 + (tid - 256)]);
    };
    float nxt = ldval(0); float gi_n = GIF[(size_t)rowof(0) * 16 + h], gf_n = GIF[(size_t)rowof(0) * 16 + 8 + h];
    for (int l = 0; l < LSEQ; ++l) {
        const int row = rowof(l);
        if (tid < 128) ks[tid] = nxt; else if (tid < 256) qs[tid - 128] = nxt; else vs[tid - 256] = nxt;
        const float ipre = gi_n + bi, fpre = gf_n + bfg;
        float so = 0.f;
        if (l >= NMETA && tid < 256) so = bf2f(SO[(size_t)row * 2048 + h * 256 + dv]);
        if (l + 1 < LSEQ) { nxt = ldval(l + 1); gi_n = GIF[(size_t)rowof(l + 1) * 16 + h]; gf_n = GIF[(size_t)rowof(l + 1) * 16 + 8 + h]; }
        __syncthreads();
        const float lf = fminf(fpre, 0.f) - log1pf(__expf(-fabsf(fpre)));
        const float mn = fmaxf(lf + m, ipre); const float decay = __expf(lf + m - mn), wi = __expf(ipre - mn); m = mn;
        const float vd = vs[dv] * wi; float pp = 0.f;
#pragma unroll
        for (int i = 0; i < 64; ++i) { const int dk = half * 64 + i; C[i] = decay * C[i] + ks[dk] * vd; pp += qs[dk] * C[i]; }
        part[tid] = pp;
        if (tid < 128) { nst = decay * nst + wi * ks[tid]; const float dp = wave_sum(qs[tid] * nst); if (lane == 0) red[wave] = dp; }
        __syncthreads();
        float hv = 0.f;
        if (tid < 256) {
            const float num = part[tid] + part[tid + 256]; const float den = red[0] + red[1];
            hv = num / fmaxf(fabsf(den), __expf(-m));
            const float ss = wave_sum(hv * hv); if (lane == 0) red2[wave] = ss;
        }
        __syncthreads();
        if (l >= NMETA && tid < 256) {
            const float ss = (red2[0] + red2[1]) + (red2[2] + red2[3]);
            const float rstd = 1.f / sqrtf(ss * (1.f / 256.f) + LN_EPS);
            const float y = so * (hv * rstd * nw);
            V[(size_t)row * 2048 + h * 256 + dv] = (bf16)(pk2(y, 0.f) & 0xffffu);
        }
        __syncthreads();
    }
}

__device__ __forceinline__ float gelu_exact(float a) { return 0.5f * a * (1.f + erff(a * 0.70710678118654752f)); }
__device__ __forceinline__ void phase_peer(const Params& p, LAS unsigned char* lds) {
    const int tid = threadIdx.x, lane = tid & 63, wave = tid >> 6;
    LAS float* Sv = (LAS float*)(lds + wave * 4096);
    LAS int* Si = (LAS int*)(lds + wave * 4096 + 1024);
    LAS int* Ei = (LAS int*)(lds + wave * 4096 + 2048);
    LAS float* Eg = (LAS float*)(lds + wave * 4096 + 2560);
    int ci = 0, cj = 0; bool cvalid = false;
    { int c = 0; for (int i = 0; i < 16; ++i) { const int nj = 16 / (i + 1); for (int j = 0; j < nj; ++j) { if (c == lane) { ci = i; cj = j; cvalid = true; } ++c; } } }
    const bf16* R = (const bf16*)(p.ws + ((MK_DBG >= 10 && MK_DBG <= 12) ? WS_TMP : (MK_DBG == 13 || MK_DBG == 14 || MK_DBG == 16) ? WS_MERGED : WS_R)); const float* C1 = (const float*)(p.ws + CTL_C1); const float* C0 = (const float*)(p.ws + CTL_C0);
    const bf16* U = (const bf16*)(p.ws + WS_UBF); const bf16* VT = (const bf16*)(p.ws + WS_VBF);
    float* SC = p.out;
    const int gw = blockIdx.x * 8 + wave, NGW = gridDim.x * 8;
    const int qd = lane & 3, qbase = lane & ~3;
    for (int r = gw; r < MX; r += NGW) {
        const float *l1g = p.ln1_g, *l1b = p.ln1_b, *l2g = p.ln2_g, *l2b = p.ln2_b;
        asm volatile("" : "+s"(l1g), "+s"(l1b), "+s"(l2g), "+s"(l2b), "+s"(C1), "+s"(C0));
        float mu, rstd;
        {
            v4u w[4]; float s1 = 0.f;
#pragma unroll
            for (int j = 0; j < 4; ++j) { w[j] = *(const v4u*)(R + (size_t)r * D + j * 512 + lane * 8);
                s1 += ((bflo(w[j].x) + bfhi(w[j].x)) + (bflo(w[j].y) + bfhi(w[j].y))) + ((bflo(w[j].z) + bfhi(w[j].z)) + (bflo(w[j].w) + bfhi(w[j].w))); }
            mu = wave_sum(s1) * (1.f / D); float s2 = 0.f;
#pragma unroll
            for (int j = 0; j < 4; ++j) { const float d0 = bflo(w[j].x) - mu, d1 = bfhi(w[j].x) - mu, d2 = bflo(w[j].y) - mu, d3 = bfhi(w[j].y) - mu, d4 = bflo(w[j].z) - mu, d5 = bfhi(w[j].z) - mu, d6 = bflo(w[j].w) - mu, d7 = bfhi(w[j].w) - mu;
                s2 += ((d0 * d0 + d1 * d1) + (d2 * d2 + d3 * d3)) + ((d4 * d4 + d5 * d5) + (d6 * d6 + d7 * d7)); }
            rstd = 1.f / sqrtf(wave_sum(s2) * (1.f / D) + LN_EPS);
        }
        {
            float v[32];
#pragma unroll
            for (int i = 0; i < 8; ++i) { const f32x4 t = *(const f32x4*)(SC + (size_t)r * D + lane * 32 + 4 * i);
                const f32x4 a1 = *(const f32x4*)(C1 + lane * 32 + 4 * i), a0 = *(const f32x4*)(C0 + lane * 32 + 4 * i);
                const f32x4 y = (t - a1 * mu) * rstd + a0;
                v[4 * i] = y.x; v[4 * i + 1] = y.y; v[4 * i + 2] = y.z; v[4 * i + 3] = y.w; }
            float topv[4]; int topi[4];
#pragma unroll
            for (int it = 0; it < 16; ++it) {
                float lm = v[0]; int li = 0;
#pragma unroll
                for (int i = 1; i < 32; ++i) { const bool g = v[i] > lm; lm = g ? v[i] : lm; li = g ? i : li; }
                float gm = fmaxf(lm, __shfl_xor(lm, 1)); gm = fmaxf(gm, __shfl_xor(gm, 2));
                const unsigned long long bal = __ballot(lm == gm);
                const int wq_ = __ffs((unsigned)((bal >> qbase) & 15ull)) - 1;
                const int widx = __shfl(qd * 32 + li, qbase + wq_);
                if (qd == (it & 3)) { topv[it >> 2] = gm; topi[it >> 2] = widx; }
                if (qd == wq_) {
#pragma unroll
                    for (int i = 0; i < 32; ++i) v[i] = (i == li) ? -INFINITY : v[i];
                }
            }
            const int g = lane >> 2;
#pragma unroll
            for (int s = 0; s < 4; ++s) { Sv[g * 16 + s * 4 + qd] = topv[s]; Si[g * 16 + s * 4 + qd] = topi[s]; }
        }
        LDS_WAIT();
#pragma unroll 1
        for (int h = 0; h < NH; ++h) {
            float s = -INFINITY; int e = 0;
            if (cvalid) { s = Sv[(2 * h) * 16 + ci] + Sv[(2 * h + 1) * 16 + cj]; e = Si[(2 * h) * 16 + ci] * 128 + Si[(2 * h + 1) * 16 + cj]; }
            int rank = 0;
#pragma unroll
            for (int c = 0; c < 50; ++c) { const float sc = __shfl(s, c); rank += (sc > s || (sc == s && c < lane)) ? 1 : 0; }
            const float smax = Sv[(2 * h) * 16] + Sv[(2 * h + 1) * 16];
            const bool sel = cvalid && rank < 16;
            const float ex = sel ? __expf(s - smax) : 0.f;
            const float den = wave_sum(ex);
            if (sel) { Ei[h * 16 + rank] = e; Eg[h * 16 + rank] = ex / den; }
        }
        LDS_WAIT();
        float x[32];
        {
#pragma unroll
            for (int j = 0; j < 4; ++j) {
                const v4u w = *(const v4u*)(R + (size_t)r * D + j * 512 + lane * 8);
                const f32x4 g0 = *(const f32x4*)(l1g + j * 512 + lane * 8), g1 = *(const f32x4*)(l1g + j * 512 + lane * 8 + 4);
                const f32x4 b0 = *(const f32x4*)(l1b + j * 512 + lane * 8), b1 = *(const f32x4*)(l1b + j * 512 + lane * 8 + 4);
                x[8 * j + 0] = (bflo(w.x) - mu) * rstd * g0.x + b0.x; x[8 * j + 1] = (bfhi(w.x) - mu) * rstd * g0.y + b0.y;
                x[8 * j + 2] = (bflo(w.y) - mu) * rstd * g0.z + b0.z; x[8 * j + 3] = (bfhi(w.y) - mu) * rstd * g0.w + b0.w;
                x[8 * j + 4] = (bflo(w.z) - mu) * rstd * g1.x + b1.x; x[8 * j + 5] = (bfhi(w.z) - mu) * rstd * g1.y + b1.y;
                x[8 * j + 6] = (bflo(w.w) - mu) * rstd * g1.z + b1.z; x[8 * j + 7] = (bfhi(w.w) - mu) * rstd * g1.w + b1.w;
            }
        }
#pragma unroll 1
        for (int e0 = 0; e0 < 128; e0 += 4) {
            v4u w[4][4];
#pragma unroll
            for (int k = 0; k < 4; ++k) { const int id = __builtin_amdgcn_readfirstlane(Ei[e0 + k]); const bf16* up = U + (size_t)id * D + lane * 8;
#pragma unroll
                for (int j = 0; j < 4; ++j) w[k][j] = *(const v4u*)(up + j * 512); }
            float s[4];
#pragma unroll
            for (int k = 0; k < 4; ++k) { float a = 0.f;
#pragma unroll
                for (int j = 0; j < 4; ++j) { const v4u t = w[k][j];
                    a += bflo(t.x) * x[8 * j] + bfhi(t.x) * x[8 * j + 1] + bflo(t.y) * x[8 * j + 2] + bfhi(t.y) * x[8 * j + 3] + bflo(t.z) * x[8 * j + 4] + bfhi(t.z) * x[8 * j + 5] + bflo(t.w) * x[8 * j + 6] + bfhi(t.w) * x[8 * j + 7]; }
                s[k] = wave_sum(a); }
            if (lane < 4) { const float a = (lane == 0) ? s[0] : (lane == 1) ? s[1] : (lane == 2) ? s[2] : s[3]; Eg[e0 + lane] = Eg[e0 + lane] * gelu_exact(a); }
        }
        LDS_WAIT();
        float o[32];
#pragma unroll
        for (int i = 0; i < 32; ++i) o[i] = 0.f;
#pragma unroll 1
        for (int e0 = 0; e0 < 128; e0 += 4) {
            v4u w[4][4]; float wt[4];
#pragma unroll
            for (int k = 0; k < 4; ++k) { const int id = __builtin_amdgcn_readfirstlane(Ei[e0 + k]); wt[k] = Eg[e0 + k]; const bf16* vp = VT + (size_t)id * D + lane * 8;
#pragma unroll
                for (int j = 0; j < 4; ++j) w[k][j] = *(const v4u*)(vp + j * 512); }
#pragma unroll
            for (int k = 0; k < 4; ++k)
#pragma unroll
                for (int j = 0; j < 4; ++j) { const v4u t = w[k][j];
                    o[8 * j] += wt[k] * bflo(t.x); o[8 * j + 1] += wt[k] * bfhi(t.x); o[8 * j + 2] += wt[k] * bflo(t.y); o[8 * j + 3] += wt[k] * bfhi(t.y);
                    o[8 * j + 4] += wt[k] * bflo(t.z); o[8 * j + 5] += wt[k] * bfhi(t.z); o[8 * j + 6] += wt[k] * bflo(t.w); o[8 * j + 7] += wt[k] * bfhi(t.w); }
        }
        float s1 = 0.f;
#pragma unroll
        for (int i = 0; i < 32; ++i) { o[i] = ALPHA * x[i] + (MK_DBG >= 1 ? 0.f : o[i]); s1 += o[i]; }
        const float mean = wave_sum(s1) * (1.f / D); float s2 = 0.f;
#pragma unroll
        for (int i = 0; i < 32; ++i) { o[i] -= mean; s2 += o[i] * o[i]; }
        const float rstd2 = 1.f / sqrtf(wave_sum(s2) * (1.f / D) + LN_EPS);
#pragma unroll
        for (int j = 0; j < 4; ++j) {
            const f32x4 g0 = *(const f32x4*)(l2g + j * 512 + lane * 8), g1 = *(const f32x4*)(l2g + j * 512 + lane * 8 + 4);
            const f32x4 b0 = *(const f32x4*)(l2b + j * 512 + lane * 8), b1 = *(const f32x4*)(l2b + j * 512 + lane * 8 + 4);
            f32x4 y0, y1;
            y0.x = o[8 * j] * rstd2 * g0.x + b0.x; y0.y = o[8 * j + 1] * rstd2 * g0.y + b0.y; y0.z = o[8 * j + 2] * rstd2 * g0.z + b0.z; y0.w = o[8 * j + 3] * rstd2 * g0.w + b0.w;
            y1.x = o[8 * j + 4] * rstd2 * g1.x + b1.x; y1.y = o[8 * j + 5] * rstd2 * g1.y + b1.y; y1.z = o[8 * j + 6] * rstd2 * g1.z + b1.z; y1.w = o[8 * j + 7] * rstd2 * g1.w + b1.w;
            float* op = p.out + (size_t)r * D + j * 512 + lane * 8;
            *(f32x4*)op = y0; *(f32x4*)(op + 4) = y1;
        }
    }
}

__device__ __forceinline__ void phase_gemm_in(const Params& p, LAS unsigned char* lds) {
    pg8::Gemm g{(const bf16*)(p.ws + WS_H0), (const bf16*)(p.ws + WS_BT_IN), MP, NINP, D};
    pg8::StaticOrder S; S.init(MP, NINP, gridDim.x, blockIdx.x);
    pg8::EpiInProj E{(bf16*)(p.ws + WS_CB), (bf16*)(p.ws + WS_Z), (bf16*)(p.ws + WS_Q), (bf16*)(p.ws + WS_K), (bf16*)(p.ws + WS_V), (bf16*)(p.ws + WS_SIGO),
                     (bf16*)(MK_DBG == 14 ? p.ws + 489 * MiB : (unsigned char*)p.out + OUT_SGA), (bf16*)((unsigned char*)p.out + OUT_SGB), (float*)(p.ws + WS_GIF)};
    pg8::gemm_phase<pg8::EpiInProj, pg8::StaticOrder, MK_ALIGN, MK_SP2>(lds, g, S, E);
}
__device__ __forceinline__ void phase_gemm_g2a(const Params& p, LAS unsigned char* lds) {
    pg8::Gemm g{(const bf16*)(p.ws + WS_CB), (const bf16*)(p.ws + WS_BT_PA), MX, D, D};
    pg8::StaticOrder S; S.init(MX, D, gridDim.x, blockIdx.x);
    pg8::EpiGate<false> E{(const bf16*)(MK_DBG == 16 ? p.ws + WS_H0 : MK_DBG == 14 ? p.ws + 489 * MiB : (unsigned char*)p.out + OUT_SGA), nullptr, (bf16*)(p.ws + WS_TMP)};
    pg8::gemm_phase<pg8::EpiGate<false>, pg8::StaticOrder, MK_ALIGN, MK_SP2>(lds, g, S, E);
}
__device__ __forceinline__ void phase_gemm_g2b(const Params& p, LAS unsigned char* lds) {
    pg8::Gemm g{(const bf16*)(p.ws + WS_V), (const bf16*)(p.ws + WS_BT_PB), MX, D, D};
    pg8::StaticOrder S; S.init(MX, D, gridDim.x, blockIdx.x);
    pg8::EpiGate<true> E{(const bf16*)((unsigned char*)p.out + OUT_SGB), (const bf16*)(p.ws + WS_TMP), (bf16*)(p.ws + WS_MERGED)};
    pg8::gemm_phase<pg8::EpiGate<true>, pg8::StaticOrder, MK_ALIGN, MK_SP2>(lds, g, S, E);
}
__device__ __forceinline__ void phase_gemm_g3(const Params& p, LAS unsigned char* lds) {
    pg8::Gemm g{(const bf16*)(p.ws + ((MK_DBG == 7 || MK_DBG == 8) ? WS_H0 : (MK_DBG == 10 || MK_DBG == 11) ? WS_CB : (MK_DBG == 12) ? WS_V : (MK_DBG == 13 || MK_DBG == 14 || MK_DBG == 16) ? WS_TMP : WS_MERGED)), (const bf16*)(p.ws + WS_BT_WO), MX, D, D};
    pg8::StaticOrder S; S.init(MX, D, gridDim.x, blockIdx.x);
    pg8::EpiResid E{(const bf16*)(p.ws + WS_H0), (bf16*)(p.ws + ((MK_DBG >= 10 && MK_DBG <= 12) ? WS_TMP : (MK_DBG == 13 || MK_DBG == 14 || MK_DBG == 16) ? WS_MERGED : WS_R))};
    pg8::gemm_phase<pg8::EpiResid, pg8::StaticOrder, MK_ALIGN, MK_SP2>(lds, g, S, E);
}
__device__ __forceinline__ void phase_gemm_pq(const Params& p, LAS unsigned char* lds) {
    pg8::Gemm g{(const bf16*)(p.ws + WS_R), (const bf16*)(p.ws + WS_BT_F), MX, D, D};
    pg8::StaticOrder S; S.init(MX, D, gridDim.x, blockIdx.x);
    pg8::EpiScores E{p.out};
    pg8::gemm_phase<pg8::EpiScores, pg8::StaticOrder, MK_ALIGN, MK_SP2>(lds, g, S, E);
}

#define MK_KERNEL(name, ...) __global__ void __launch_bounds__(512, 2) name(Params p) { extern __shared__ __attribute__((aligned(16))) unsigned char lds_raw[]; LAS unsigned char* lds = (LAS unsigned char*)lds_raw; (void)lds; __VA_ARGS__; }
MK_KERNEL(k_p0, phase0(p, lds))
MK_KERNEL(k_gemm_in, phase_gemm_in(p, lds))
MK_KERNEL(k_conv, phase_c1c0(p); phase_conv(p))
MK_KERNEL(k_mlstm, phase_mlstm_naive(p, lds))
MK_KERNEL(k_uv, phase_uvconv(p))
MK_KERNEL(k_g2a, phase_gemm_g2a(p, lds))
MK_KERNEL(k_g2b, phase_gemm_g2b(p, lds))
MK_KERNEL(k_g3, phase_gemm_g3(p, lds))
MK_KERNEL(k_pq, phase_gemm_pq(p, lds))
MK_KERNEL(k_peer, phase_peer(p, lds))
}

extern "C" void kernel_launch(void* const* d_in, const int* in_sizes, int n_in, void* d_out, int out_size, void* d_ws, size_t ws_size, hipStream_t stream) {
    using namespace mk;
    static int grid = 0;
    if (grid == 0) {
        if (n_in != 19 || ws_size < WS_END || out_size != MX * D) { fprintf(stderr, "kernel_launch: unexpected shapes (n_in %d, ws %zu, out %d)\n", n_in, ws_size, out_size); grid = -1; return; }
        const void* ks[] = {(const void*)k_p0, (const void*)k_gemm_in, (const void*)k_conv, (const void*)k_mlstm, (const void*)k_uv, (const void*)k_g2a, (const void*)k_g2b, (const void*)k_g3, (const void*)k_pq, (const void*)k_peer};
        for (auto k : ks) if (hipFuncSetAttribute(k, hipFuncAttributeMaxDynamicSharedMemorySize, LDS_BYTES) != hipSuccess) { fprintf(stderr, "kernel_launch: hipFuncSetAttribute failed\n"); grid = -1; return; }
        int dev = 0, cus = 0; hipGetDevice(&dev); hipDeviceGetAttribute(&cus, hipDeviceAttributeMultiprocessorCount, dev);
        grid = cus > 0 ? cus : 256;
    }
    if (grid < 0) return;
    Params p{};
    const float** pf = (const float**)&p;
    for (int i = 0; i < 19; ++i) pf[i] = (const float*)d_in[i];
    p.out = (float*)d_out; p.ws = (unsigned char*)d_ws;
    dim3 g(grid), b(512);
    hipLaunchKernelGGL(k_p0, g, b, LDS_BYTES, stream, p);
    hipLaunchKernelGGL(k_gemm_in, g, b, LDS_BYTES, stream, p);
    if (MK_DBG != 11 && MK_DBG != 12) hipLaunchKernelGGL(k_conv, g, b, LDS_BYTES, stream, p);
    if (MK_DBG < 10) hipLaunchKernelGGL(k_mlstm, g, b, LDS_BYTES, stream, p);
    hipLaunchKernelGGL(k_uv, g, b, LDS_BYTES, stream, p);
    if (MK_DBG < 10 || MK_DBG == 13 || MK_DBG == 14 || MK_DBG == 16) hipLaunchKernelGGL(k_g2a, g, b, LDS_BYTES, stream, p);
    if (MK_DBG < 10) hipLaunchKernelGGL(k_g2b, g, b, LDS_BYTES, stream, p);
    hipLaunchKernelGGL(k_g3, g, b, LDS_BYTES, stream, p);
    hipLaunchKernelGGL(k_pq, g, b, LDS_BYTES, stream, p);
    hipLaunchKernelGGL(k_peer, g, b, LDS_BYTES, stream, p);
}
```

```cpp
#include <hip/hip_runtime.h>
#include <hip/hip_cooperative_groups.h>
#include <cstdio>
#include <cstdint>
namespace pg8 {
__device__ __forceinline__ int ftid() { int t = threadIdx.x; asm volatile("" : "+v"(t)); return t; }
#define PG8_LAS __attribute__((address_space(3)))
typedef unsigned short bf16_t;
typedef short bf16x8 __attribute__((ext_vector_type(8)));
typedef float f32x4 __attribute__((ext_vector_type(4)));
typedef unsigned u32x4 __attribute__((ext_vector_type(4)));
constexpr int BM = 256, BK = 64, HALF = 128, HTB = HALF * BK * 2  , STAGE_BYTES = 8 * HTB, NXCD = 8, WGM = 8;

__host__ __device__ __forceinline__ int lds_byte(int r, int c) { const int st = (r >> 4) * 2 + (c >> 5), rr = r & 15, cc = c & 31, ob = rr * 64 + cc * 2; return st * 1024 + (ob ^ (((ob >> 9) & 1) << 5)); }
__host__ __device__ __forceinline__ void stage_rc(int b, int& R, int& C) { const int st = b / 1024, sb = b % 1024, swz = sb ^ (((sb >> 9) & 1) << 5); R = (st >> 1) * 16 + swz / 64; C = (st & 1) * 32 + (swz % 64) / 2; }
__host__ __device__ __forceinline__ int perm32(int rho) { const int n = rho >> 4, i = rho & 15; return 8 * (i >> 2) + 4 * n + (i & 3); }

struct Unit { int pm, pn; };
struct Gemm { const bf16_t* A; const bf16_t* Bt; int M, N, K; };

struct StaticOrder {
    int nM, nN, nwg, G, c, wgm;
    __host__ __device__ void init(int M, int N, int G_, int c_, int wgm_ = WGM) { nM = M / BM; nN = N / BM; nwg = nM * nN; G = G_; c = c_; wgm = wgm_; }
    __host__ __device__ bool next(int i, Unit& u) const {
        const long L = (long)i * G + c; if (L >= nwg) return false;
        int wgid = (int)L; { const int q = nwg / NXCD, r = nwg % NXCD, xcd = wgid % NXCD, off = wgid / NXCD; wgid = (xcd < r ? xcd * (q + 1) : r * (q + 1) + (xcd - r) * q) + off; }
        const int nig = wgm * nN, gid = wgid / nig, fm = gid * wgm, gsz = (nM - fm) < wgm ? (nM - fm) : wgm;
        u.pm = fm + ((wgid % nig) % gsz); u.pn = (wgid % nig) / gsz; return true;
    }
    __device__ __forceinline__ void a_ready(const Unit&) const {}
    __device__ __forceinline__ void done(const Unit&) const {}
};

typedef __bf16 bf16x2_t __attribute__((ext_vector_type(2)));
__device__ __forceinline__ unsigned cvt_pk_bf16(float lo, float hi) { bf16x2_t v; v[0] = (__bf16)lo; v[1] = (__bf16)hi; return __builtin_bit_cast(unsigned, v); }
typedef float f32x2 __attribute__((ext_vector_type(2)));
__device__ __forceinline__ f32x2 gelu_pk(f32x2 v) {
    const f32x2 av = __builtin_elementwise_abs(v), d = av * 0.2316418882f + 1.0f;
    f32x2 t; t.x = __builtin_amdgcn_rcpf(d.x); t.y = __builtin_amdgcn_rcpf(d.y);
    f32x2 q = t * 0.5307027145f + (-0.7265760135f); q = q * t + 0.7107068705f; q = q * t + (-0.142248368f); q = q * t + 0.127414796f; q = q * t;
    const f32x2 s = (v * v) * (-0.72134752044f);
    f32x2 e; e.x = __builtin_amdgcn_exp2f(s.x); e.y = __builtin_amdgcn_exp2f(s.y);
    const f32x2 m = v * (q * e), r = v - m;
    f32x2 o; o.x = v.x < 0.f ? m.x : r.x; o.y = v.y < 0.f ? m.y : r.y; return o;
}

template <int ACT  > struct EpiBf16 {
    static constexpr bool PERM = true, AFTER_DRAIN = false; static_assert(ACT == 0 || ACT == 1, "EpiBf16: ACT is 0 (none) or 1 (gelu_pk)");
    bf16_t* O; int ldc; const float* bias; int split_cols; size_t split_stride; float scale0;
    __device__ __forceinline__ void operator()(const f32x4 (&acc)[2][2][4][2], const Unit& u, int wr, int wc, int fr, int fq) const {
        const int row0 = u.pm * BM + wr * 64 + fr; int colt = u.pn * BM; bf16_t* base = O;
        float sc = 1.f; if (split_cols) { const int t = colt / split_cols; base += (size_t)t * split_stride; colt -= t * split_cols; if (t == 0) sc = scale0; }
        const int col0 = colt + wc * 32 + 8 * fq, bcol0 = u.pn * BM + wc * 32 + 8 * fq;
        f32x4 bv[2][2];
#pragma unroll
        for (int bj = 0; bj < 2; ++bj)
#pragma unroll
            for (int n = 0; n < 2; ++n) bv[bj][n] = bias ? *(const f32x4*)(bias + bcol0 + bj * HALF + 4 * n) : (f32x4){0.f, 0.f, 0.f, 0.f};
#pragma unroll
        for (int ai = 0; ai < 2; ++ai)
#pragma unroll
            for (int m = 0; m < 4; ++m) { bf16_t* rowp = base + (size_t)(row0 + ai * HALF + m * 16) * ldc + col0;
#pragma unroll
                for (int bj = 0; bj < 2; ++bj) { f32x4 v0 = acc[ai][bj][m][0] + bv[bj][0], v1 = acc[ai][bj][m][1] + bv[bj][1];
                    if (ACT == 1) { f32x2 a = gelu_pk((f32x2){v0[0], v0[1]}), b = gelu_pk((f32x2){v0[2], v0[3]}), c = gelu_pk((f32x2){v1[0], v1[1]}), d = gelu_pk((f32x2){v1[2], v1[3]});
                        v0 = (f32x4){a.x, a.y, b.x, b.y}; v1 = (f32x4){c.x, c.y, d.x, d.y}; }
                    v0 = v0 * sc; v1 = v1 * sc; u32x4 w; w.x = cvt_pk_bf16(v0[0], v0[1]); w.y = cvt_pk_bf16(v0[2], v0[3]); w.z = cvt_pk_bf16(v1[0], v1[1]); w.w = cvt_pk_bf16(v1[2], v1[3]);
                    *(u32x4*)(rowp + bj * HALF) = w; } }
    }
};
typedef int i32x4 __attribute__((ext_vector_type(4)));
__device__ __forceinline__ const char* sgpr_ptr(const char* p) { const unsigned long long u = (unsigned long long)p; const unsigned lo = __builtin_amdgcn_readfirstlane((unsigned)u), hi = __builtin_amdgcn_readfirstlane((unsigned)(u >> 32)); return (const char*)(((unsigned long long)hi << 32) | lo); }
typedef int i32x8 __attribute__((ext_vector_type(8)));
template <bool FP8> __device__ __forceinline__ f32x4 mma_step(const i32x8& b, const i32x8& a, f32x4 c) {
    if constexpr (FP8) {
        return __builtin_amdgcn_mfma_scale_f32_16x16x128_f8f6f4(b, a, c, 0, 0, 0, 0x79797979, 0, 0x7f7f7f7f);
    } else {
        const bf16x8 b0 = __builtin_bit_cast(bf16x8, (i32x4)__builtin_shufflevector(b, b, 0, 1, 2, 3)), b1 = __builtin_bit_cast(bf16x8, (i32x4)__builtin_shufflevector(b, b, 4, 5, 6, 7));
        const bf16x8 a0 = __builtin_bit_cast(bf16x8, (i32x4)__builtin_shufflevector(a, a, 0, 1, 2, 3)), a1 = __builtin_bit_cast(bf16x8, (i32x4)__builtin_shufflevector(a, a, 4, 5, 6, 7));
        c = __builtin_amdgcn_mfma_f32_16x16x32_bf16(b0, a0, c, 0, 0, 0);
        return __builtin_amdgcn_mfma_f32_16x16x32_bf16(b1, a1, c, 0, 0, 0);
    }
}
template <class Epi, class Sched, bool ALIGN_EPI = false, bool SP2 = false, bool FP8 = false>
__device__ __forceinline__ void gemm_phase(PG8_LAS unsigned char* lds, const Gemm g, const Sched& S, const Epi& E) {
    const int tid = ftid(), wid = __builtin_amdgcn_readfirstlane(tid >> 6), lane = tid & 63, wr = wid >> 2, wc = wid & 3, fr = lane & 15, fq = lane >> 4;
    const int K = g.K, nt = K / BK;
    unsigned voffA, voffB;
    { int R, C; stage_rc(tid * 16, R, C); const int Rb = Epi::PERM ? ((R & ~31) + perm32(R & 31)) : R; voffA = (unsigned)(R * K + C) * 2u; voffB = (unsigned)(Rb * K + C) * 2u; }
    const size_t pstep = (size_t)64 * K * 2;
    const size_t kstep = (size_t)(BK * 2);
    const size_t hstep = (size_t)HALF * K * 2;
    const size_t tstep = 2 * hstep;
    const unsigned ldsw = (unsigned)wid * 1024u;
    const int aoff = lds_byte(wr * 64 + fr, fq * 8), boff = lds_byte(wc * 32 + fr, fq * 8);
#define PG8_SA(b, h) (((b) * 2 + (h)) * HTB)
#define PG8_SB(b, h) ((4 + (b) * 2 + (h)) * HTB)
#define PG8_STAGE(bufoff, gbase, voff) do { _Pragma("unroll") for (int _i = 0; _i < 2; ++_i) { const char* gb_ = sgpr_ptr((const char*)(gbase) + _i * pstep); unsigned vo_ = (voff); asm volatile("" : "+v"(vo_)); \
        __builtin_amdgcn_global_load_lds((const unsigned*)(gb_ + vo_), (PG8_LAS unsigned*)(lds + (bufoff) + ldsw + _i * 8192), 16, 0, 0); } } while (0)
#define PG8_LDA(dst, b, h) do { _Pragma("unroll") for (int m = 0; m < 4; ++m) { const i32x4 lo_ = *(const PG8_LAS i32x4*)(lds + PG8_SA(b, h) + aoff + m * 2048), hi_ = *(const PG8_LAS i32x4*)(lds + PG8_SA(b, h) + aoff + m * 2048 + 1024); dst[m] = __builtin_shufflevector(lo_, hi_, 0, 1, 2, 3, 4, 5, 6, 7); } } while (0)
#define PG8_LDB(dst, b, h) do { _Pragma("unroll") for (int n = 0; n < 2; ++n) { const i32x4 lo_ = *(const PG8_LAS i32x4*)(lds + PG8_SB(b, h) + boff + n * 2048), hi_ = *(const PG8_LAS i32x4*)(lds + PG8_SB(b, h) + boff + n * 2048 + 1024); dst[n] = __builtin_shufflevector(lo_, hi_, 0, 1, 2, 3, 4, 5, 6, 7); } } while (0)
#define PG8_MMA(ai, bj, At, Bt) do { __builtin_amdgcn_s_setprio(1); _Pragma("unroll") for (int m = 0; m < 4; ++m) _Pragma("unroll") for (int n = 0; n < 2; ++n) \
        acc[ai][bj][m][n] = mma_step<FP8>(Bt[n], At[m], acc[ai][bj][m][n]); __builtin_amdgcn_s_setprio(0); } while (0)
#define PG8_WAIT_V(n) asm volatile("s_waitcnt vmcnt(" #n ")" ::: "memory")
#define PG8_WAIT_L(n) asm volatile("s_waitcnt lgkmcnt(" #n ")" ::: "memory")
#define PG8_BAR __builtin_amdgcn_s_barrier()
#define PG8_SCHED __builtin_amdgcn_sched_barrier(0)
    Unit cur, nxt; int ui = 0;
    if (!S.next(0, cur)) return;
    f32x4 acc[2][2][4][2];
#pragma unroll
    for (int a = 0; a < 2; ++a)
#pragma unroll
        for (int b = 0; b < 2; ++b)
#pragma unroll
            for (int m = 0; m < 4; ++m)
#pragma unroll
                for (int n = 0; n < 2; ++n) acc[a][b][m][n] = (f32x4){0.f, 0.f, 0.f, 0.f};
    i32x8 At[4], B0[2], B1[2];
    const char* cA = (const char*)g.A + (size_t)cur.pm * tstep; const char* cB = (const char*)g.Bt + (size_t)cur.pn * tstep;
    S.a_ready(cur);
    if constexpr (SP2) {
        PG8_STAGE(PG8_SB(0, 0), cB, voffB); PG8_STAGE(PG8_SB(0, 1), cB + hstep, voffB); PG8_STAGE(PG8_SA(0, 0), cA, voffA); PG8_STAGE(PG8_SA(0, 1), cA + hstep, voffA);
        if (wr == 1) PG8_BAR;
        PG8_WAIT_V(2); PG8_BAR;
        PG8_STAGE(PG8_SB(1, 0), cB + kstep, voffB); PG8_STAGE(PG8_SA(1, 0), cA + kstep, voffA); PG8_STAGE(PG8_SB(1, 1), cB + hstep + kstep, voffB);
        PG8_WAIT_V(6); PG8_BAR;
    } else {
        PG8_STAGE(PG8_SB(0, 0), cB, voffB); PG8_STAGE(PG8_SA(0, 0), cA, voffA); PG8_STAGE(PG8_SB(0, 1), cB + hstep, voffB); PG8_STAGE(PG8_SA(0, 1), cA + hstep, voffA);
        if (wr == 1) PG8_BAR;
        PG8_WAIT_V(4); PG8_BAR;
        PG8_STAGE(PG8_SB(1, 0), cB + kstep, voffB); PG8_STAGE(PG8_SA(1, 0), cA + kstep, voffA); PG8_STAGE(PG8_SB(1, 1), cB + hstep + kstep, voffB);
        PG8_WAIT_V(6); PG8_BAR;
    }
    for (;;) {
        const bool has_next = S.next(ui + 1, nxt);
        const char* nA = has_next ? (const char*)g.A + (size_t)nxt.pm * tstep : cA; const char* nB = has_next ? (const char*)g.Bt + (size_t)nxt.pn * tstep : cB;
        for (int t = 0; t < nt; t += 2) {
            const bool last = (t == nt - 2);
            const char* a1 = cA + (size_t)(t + 1) * kstep;
            const char* a2 = last ? nA : cA + (size_t)(t + 2) * kstep; const char* b2 = last ? nB : cB + (size_t)(t + 2) * kstep;
            const char* a3 = a2 + kstep; const char* b3 = b2 + kstep;
            if (last && has_next) S.a_ready(nxt);
            if constexpr (SP2) {
            PG8_LDB(B0, 0, 0); PG8_LDB(B1, 0, 1); PG8_SCHED; PG8_LDA(At, 0, 0); PG8_STAGE(PG8_SA(1, 1), a1 + hstep, voffA);
            PG8_WAIT_V(8); PG8_WAIT_L(0); PG8_BAR; PG8_MMA(0, 0, At, B0); PG8_MMA(0, 1, At, B1); PG8_BAR; PG8_SCHED;
            PG8_LDA(At, 0, 1); PG8_STAGE(PG8_SB(0, 0), b2, voffB); PG8_STAGE(PG8_SB(0, 1), b2 + hstep, voffB); PG8_STAGE(PG8_SA(0, 0), a2, voffA);
            PG8_WAIT_V(8); PG8_WAIT_L(0); PG8_BAR; PG8_MMA(1, 0, At, B0); PG8_MMA(1, 1, At, B1); PG8_BAR; PG8_SCHED;
            PG8_LDB(B0, 1, 0); PG8_LDB(B1, 1, 1); PG8_SCHED; PG8_LDA(At, 1, 0); PG8_STAGE(PG8_SA(0, 1), a2 + hstep, voffA);
            PG8_WAIT_V(8); PG8_WAIT_L(0); PG8_BAR; PG8_MMA(0, 0, At, B0); PG8_MMA(0, 1, At, B1); PG8_BAR; PG8_SCHED;
            PG8_LDA(At, 1, 1); PG8_STAGE(PG8_SB(1, 0), b3, voffB); PG8_STAGE(PG8_SB(1, 1), b3 + hstep, voffB); PG8_STAGE(PG8_SA(1, 0), a3, voffA);
            PG8_WAIT_V(8); PG8_WAIT_L(0); PG8_BAR; PG8_MMA(1, 0, At, B0); PG8_MMA(1, 1, At, B1); PG8_BAR; PG8_SCHED;
            } else {
            PG8_LDB(B0, 0, 0); PG8_SCHED; PG8_LDA(At, 0, 0); PG8_STAGE(PG8_SA(1, 1), a1 + hstep, voffA);
            PG8_WAIT_L(8); PG8_BAR; PG8_WAIT_L(0); PG8_MMA(0, 0, At, B0); PG8_BAR; PG8_SCHED;
            PG8_LDB(B1, 0, 1); PG8_STAGE(PG8_SB(0, 0), b2, voffB);
            PG8_BAR; PG8_WAIT_L(0); PG8_MMA(0, 1, At, B1); PG8_BAR;
            PG8_LDA(At, 0, 1); PG8_STAGE(PG8_SA(0, 0), a2, voffA);
            PG8_BAR; PG8_WAIT_L(0); PG8_MMA(1, 0, At, B0); PG8_BAR; PG8_SCHED;
            PG8_STAGE(PG8_SB(0, 1), b2 + hstep, voffB);
            PG8_WAIT_V(6); PG8_BAR; PG8_MMA(1, 1, At, B1); PG8_BAR;
            PG8_LDB(B0, 1, 0); PG8_SCHED; PG8_LDA(At, 1, 0); PG8_STAGE(PG8_SA(0, 1), a2 + hstep, voffA);
            PG8_WAIT_L(8); PG8_BAR; PG8_WAIT_L(0); PG8_MMA(0, 0, At, B0); PG8_BAR; PG8_SCHED;
            PG8_LDB(B1, 1, 1); PG8_STAGE(PG8_SB(1, 0), b3, voffB);
            PG8_BAR; PG8_WAIT_L(0); PG8_MMA(0, 1, At, B1); PG8_BAR;
            PG8_LDA(At, 1, 1); PG8_STAGE(PG8_SA(1, 0), a3, voffA);
            PG8_BAR; PG8_WAIT_L(0); PG8_MMA(1, 0, At, B0); PG8_BAR; PG8_SCHED;
            PG8_STAGE(PG8_SB(1, 1), b3 + hstep, voffB);
            PG8_WAIT_V(6); PG8_BAR; PG8_MMA(1, 1, At, B1); PG8_BAR;
            }
        }
        if constexpr (ALIGN_EPI) { if (wr == 0) PG8_BAR; }
        if constexpr (!Epi::AFTER_DRAIN) { E(acc, cur, wr, wc, fr, fq); S.done(cur); }
        if (!has_next) break;
#pragma unroll
        for (int a = 0; a < 2; ++a)
#pragma unroll
            for (int b = 0; b < 2; ++b)
#pragma unroll
                for (int m = 0; m < 4; ++m)
#pragma unroll
                    for (int n = 0; n < 2; ++n) acc[a][b][m][n] = (f32x4){0.f, 0.f, 0.f, 0.f};
        cur = nxt; cA = nA; cB = nB; ++ui;
        if constexpr (ALIGN_EPI) { if (wr == 1) PG8_BAR; }
    }
    PG8_WAIT_V(0);
    if constexpr (!ALIGN_EPI) { if (wr == 0) PG8_BAR; }
    PG8_BAR;
    if constexpr (Epi::AFTER_DRAIN) { E.fused(acc, cur, wr, wc, fr, fq, lds, wid, lane); S.done(cur); }
#undef PG8_SA
#undef PG8_SB
#undef PG8_STAGE
#undef PG8_LDA
#undef PG8_LDB
#undef PG8_MMA
#undef PG8_WAIT_V
#undef PG8_WAIT_L
#undef PG8_BAR
#undef PG8_SCHED
}
}

#ifndef MK_DBG
#define MK_DBG 0
#endif
#ifndef MK_PROBE
#define MK_PROBE 0
#endif
#ifndef MK_WGM_IN
#define MK_WGM_IN 7
#endif
#ifndef MK_WGM_SQ
#define MK_WGM_SQ 2
#endif
#ifndef MK_ALIGN
#define MK_ALIGN true
#endif
#ifndef MK_SP2
#define MK_SP2 true
#endif
namespace mk {
#define GAS __attribute__((address_space(1)))
#define LAS __attribute__((address_space(3)))
typedef unsigned short bf16;
typedef unsigned v4u __attribute__((ext_vector_type(4)));
typedef unsigned v2u __attribute__((ext_vector_type(2)));
typedef float f32x4 __attribute__((ext_vector_type(4)));
typedef float f32x2 __attribute__((ext_vector_type(2)));

constexpr int D = 2048, MX = 16384, MP = 16640, SEQ = 8192, NMETA = 16;
constexpr int NIN = 16400, NINP = 16640;
constexpr int NH = 8, DQK = 128, DV = 256;
constexpr int LSEQ = SEQ + NMETA;
constexpr float LN_EPS = 1e-5f;
constexpr float ALPHA = 1.189207115002721f;
constexpr float QSCALE = 0.08838834764831845f;

constexpr size_t MiB = 1u << 20;
constexpr size_t WS_CTL = 0, CTL_ZERO_BYTES = 512 * 1024;
constexpr size_t CTL_C1 = 256 * 1024;
constexpr size_t CTL_C0 = 264 * 1024;
constexpr size_t CTL_C1P = 512 * 1024, CTL_C0P = 1024 * 1024;
constexpr size_t WS_GIF = 2 * MiB;
constexpr size_t WS_BT_PA = 4 * MiB, WS_BT_PB = 12 * MiB, WS_BT_WO = 20 * MiB, WS_BT_F = 28 * MiB;
constexpr size_t WS_H0 = 36 * MiB;
constexpr size_t WS_BT_IN = 101 * MiB;
constexpr size_t WS_H0F8 = 101 * MiB;
constexpr size_t WS_BT_IN8 = 133 * MiB + 512 * 1024;
static_assert(WS_H0F8 + (size_t)16640 * 2048 <= WS_BT_IN8 && WS_BT_IN8 + (size_t)16640 * 2048 <= 166 * MiB, "fp8 operand copies");
constexpr size_t WS_UBF = 489 * MiB;
constexpr size_t WS_CB = 166 * MiB;
constexpr size_t WS_R = WS_CB;
constexpr size_t WS_Z = 230 * MiB;
constexpr size_t WS_VBF = 521 * MiB;
constexpr size_t WS_YA8 = WS_BT_IN8;
constexpr size_t WS_YB = WS_Z;
constexpr size_t WS_Q = 295 * MiB;
constexpr size_t WS_K = 327 * MiB;
constexpr size_t WS_TMP = WS_Q;
constexpr size_t WS_V = 360 * MiB;
constexpr size_t WS_SIGO = 425 * MiB;
constexpr size_t WS_MERGED = WS_SIGO;
constexpr size_t WS_END = 553 * MiB;
constexpr size_t OUT_SGA = 0, OUT_SGB = 64 * MiB;

constexpr int LDS_BYTES = 147456;

struct Params {
    const float *x, *meta, *ln0_g, *ln0_b, *w_in, *b_if, *conv_w, *mh_w, *p_a, *p_b, *w_o, *ln1_g, *ln1_b, *peer_wq, *peer_keys, *peer_u, *peer_v, *ln2_g, *ln2_b;
    float* out; unsigned char* ws;
};

__device__ __forceinline__ float bf2f(unsigned u) { return __uint_as_float(u << 16); }
__device__ __forceinline__ float bflo(unsigned w) { return __uint_as_float(w << 16); }
__device__ __forceinline__ float bfhi(unsigned w) { return __uint_as_float(w & 0xffff0000u); }
__device__ __forceinline__ unsigned pk2(float lo, float hi) { return pg8::cvt_pk_bf16(lo, hi); }
template <int CTRL> __device__ __forceinline__ float dpp_f(float v) { return __builtin_bit_cast(float, __builtin_amdgcn_update_dpp(0, __builtin_bit_cast(int, v), CTRL, 0xF, 0xF, true)); }
__device__ __forceinline__ float quad_sum(float v) { v += dpp_f<0xB1>(v); v += dpp_f<0x4E>(v); return v; }
__device__ __forceinline__ float oct_sum(float v) { v = quad_sum(v); v += dpp_f<0x141>(v); return v; }
__device__ __forceinline__ float row16_sum(float v) { v = oct_sum(v); v += dpp_f<0x140>(v); return v; }
__device__ __forceinline__ float wave_sum(float v) {
    v = row16_sum(v);
    const float a = __builtin_bit_cast(float, __builtin_amdgcn_readlane(__builtin_bit_cast(int, v), 0)), b = __builtin_bit_cast(float, __builtin_amdgcn_readlane(__builtin_bit_cast(int, v), 16));
    const float c = __builtin_bit_cast(float, __builtin_amdgcn_readlane(__builtin_bit_cast(int, v), 32)), d = __builtin_bit_cast(float, __builtin_amdgcn_readlane(__builtin_bit_cast(int, v), 48));
    return (a + b) + (c + d);
}
__device__ __forceinline__ float sigmoidf_(float x) { return __builtin_amdgcn_rcpf(1.0f + __expf(-x)); }
#define LDS_WAIT() asm volatile("s_waitcnt lgkmcnt(0)" ::: "memory")

__device__ __forceinline__ int in_dest_row(int n) {
    if (n < 2048) return n;
    if (n < 4096) { const int c = n - 2048; return (8 + (c >> 7)) * 256 + (c & 127); }
    if (n < 6144) { const int c = n - 4096; return (8 + (c >> 7)) * 256 + 128 + (c & 127); }
    if (n < 7168) return 24 * 256 + (n - 6144);
    if (n < 8192) return 28 * 256 + (n - 7168);
    if (n < 10240) return 32 * 256 + (n - 8192);
    if (n < 12288) return 40 * 256 + (n - 10240);
    if (n < 12304) return 64 * 256 + (n - 12288);
    if (n < 14352) return 48 * 256 + (n - 12304);
    return 56 * 256 + (n - 14352);
}
template <bool INMAP>
__device__ __forceinline__ void transpose_item(const float* W, int K, int N, bf16* WT, LAS float* scr, int item, int lane) {
    const int nblk = (N + 31) / 32, kb = item / nblk, nb = item % nblk, k0 = 64 * kb, n0 = 32 * nb;
    const int rr = lane >> 3, c4 = (lane & 7) * 4; const bool ok = (n0 + c4) < N;
    f32x4 v[8];
#pragma unroll
    for (int i = 0; i < 8; ++i) v[i] = ok ? *(const f32x4*)(W + (size_t)(k0 + 8 * i + rr) * N + n0 + c4) : (f32x4){0.f, 0.f, 0.f, 0.f};
#pragma unroll
    for (int i = 0; i < 8; ++i) { LAS float* d = scr + (8 * i + rr) * 33 + c4; d[0] = v[i].x; d[1] = v[i].y; d[2] = v[i].z; d[3] = v[i].w; }
    LDS_WAIT();
    const int c = lane & 7;
#pragma unroll
    for (int j = 0; j < 4; ++j) { const int nl = (lane >> 3) + 8 * j; const int n = n0 + nl; const LAS float* s = scr + (8 * c) * 33 + nl;
        v4u o; o.x = pk2(s[0 * 33], s[1 * 33]); o.y = pk2(s[2 * 33], s[3 * 33]); o.z = pk2(s[4 * 33], s[5 * 33]); o.w = pk2(s[6 * 33], s[7 * 33]);
        if (n < N) { const int dr = INMAP ? in_dest_row(n) : n; *(v4u*)(WT + (size_t)dr * K + k0 + 8 * c) = o; } }
    LDS_WAIT();
}
__device__ __forceinline__ unsigned pk4_fp8(float a, float b, float c, float d) { int w = 0; w = __builtin_amdgcn_cvt_pk_fp8_f32(a, b, w, false); w = __builtin_amdgcn_cvt_pk_fp8_f32(c, d, w, true); return (unsigned)w; }
template <bool INMAP>
__device__ __forceinline__ void transpose_item_fp8(const float* W, int K, int N, unsigned char* WT, LAS float* scr, int item, int lane) {
    const int nblk = (N + 31) / 32, kb = item / nblk, nb = item % nblk, k0 = 128 * kb, n0 = 32 * nb;
    const int rr = lane >> 3, c4 = (lane & 7) * 4; const bool ok = (n0 + c4) < N;
    f32x4 v[16];
#pragma unroll
    for (int i = 0; i < 16; ++i) v[i] = ok ? *(const f32x4*)(W + (size_t)(k0 + 8 * i + rr) * N + n0 + c4) : (f32x4){0.f, 0.f, 0.f, 0.f};
#pragma unroll
    for (int i = 0; i < 16; ++i) { LAS float* d = scr + (8 * i + rr) * 33 + c4; d[0] = v[i].x * 64.f; d[1] = v[i].y * 64.f; d[2] = v[i].z * 64.f; d[3] = v[i].w * 64.f; }
    LDS_WAIT();
    const int c = lane & 7;
#pragma unroll
    for (int j = 0; j < 4; ++j) { const int nl = (lane >> 3) + 8 * j; const int n = n0 + nl; const LAS float* s = scr + (16 * c) * 33 + nl;
        v4u o; o.x = pk4_fp8(s[0 * 33], s[1 * 33], s[2 * 33], s[3 * 33]); o.y = pk4_fp8(s[4 * 33], s[5 * 33], s[6 * 33], s[7 * 33]);
        o.z = pk4_fp8(s[8 * 33], s[9 * 33], s[10 * 33], s[11 * 33]); o.w = pk4_fp8(s[12 * 33], s[13 * 33], s[14 * 33], s[15 * 33]);
        if (n < N) *(v4u*)(WT + (size_t)(INMAP ? in_dest_row(n) : n) * K + k0 + 16 * c) = o; }
    LDS_WAIT();
}
__device__ __forceinline__ void ln0_load(const Params& p, int r, int lane, f32x4 (&v)[8]) {
    if (r >= MX + NMETA) {
#pragma unroll
        for (int j = 0; j < 8; ++j) v[j] = (f32x4){0.f, 0.f, 0.f, 0.f};
        return; }
    const float* src = (r < MX) ? p.x + (size_t)r * D : p.meta + (size_t)(r - MX) * D;
    const f32x4* xr = (const f32x4*)src + lane;
#pragma unroll
    for (int j = 0; j < 8; ++j) v[j] = xr[64 * j];
}
__device__ __forceinline__ void ln0_finish(const Params& p, int r, int lane, f32x4 (&v)[8]) {
    bf16* orow = (bf16*)(p.ws + WS_H0) + (size_t)r * D;
    unsigned long long* o8 = (unsigned long long*)orow + lane;
    unsigned* o4 = (unsigned*)(p.ws + WS_H0F8 + (size_t)r * D) + lane;
    if (r >= MX + NMETA) {
#pragma unroll
        for (int j = 0; j < 8; ++j) { o8[64 * j] = 0ull; o4[64 * j] = 0u; }
        return;
    }
    float s = 0.f;
#pragma unroll
    for (int j = 0; j < 8; ++j) s += (v[j].x + v[j].y) + (v[j].z + v[j].w);
    const float mean = wave_sum(s) * (1.f / D); float s2 = 0.f;
#pragma unroll
    for (int j = 0; j < 8; ++j) { v[j] = v[j] - mean; s2 += (v[j].x * v[j].x + v[j].y * v[j].y) + (v[j].z * v[j].z + v[j].w * v[j].w); }
    const float rstd = 1.f / sqrtf(wave_sum(s2) * (1.f / D) + LN_EPS);
#pragma unroll
    for (int j = 0; j < 8; ++j) {
        const f32x4 g = *((const f32x4*)p.ln0_g + lane + 64 * j), b = *((const f32x4*)p.ln0_b + lane + 64 * j);
        const f32x4 y = v[j] * rstd * g + b;
        o8[64 * j] = (unsigned long long)pk2(y.x, y.y) | ((unsigned long long)pk2(y.z, y.w) << 32);
        o4[64 * j] = pk4_fp8(y.x, y.y, y.z, y.w);
    }
}
typedef float f32x16_ __attribute__((ext_vector_type(16)));
__device__ __forceinline__ void wf_item(const Params& p, int item, int lane) {
    const int hp = item >> 8, dt = (item >> 2) & 63, nt = item & 3, d0 = 32 * dt, n0 = 32 * nt;
    const int i = lane & 31, kk = lane >> 5;
    const f32x4* arow = (const f32x4*)(p.peer_wq + (size_t)(d0 + i) * D + hp * 128);
    const f32x4* brow = (const f32x4*)(p.peer_keys + (size_t)hp * 16384 + (size_t)(n0 + i) * 128);
    f32x16_ acc;
#pragma unroll
    for (int g = 0; g < 16; ++g) acc[g] = 0.f;
#pragma unroll 8
    for (int q = 0; q < 32; ++q) {
        const f32x4 a = arow[q], bb = brow[q];
        acc = __builtin_amdgcn_mfma_f32_32x32x2f32(kk ? a.y : a.x, kk ? bb.y : bb.x, acc, 0, 0, 0);
        acc = __builtin_amdgcn_mfma_f32_32x32x2f32(kk ? a.w : a.z, kk ? bb.w : bb.z, acc, 0, 0, 0);
    }
    const int col = hp * 128 + n0 + i;
    bf16* dst = (bf16*)(p.ws + WS_BT_F) + (size_t)col * D + d0;
    float c1p = 0.f, c0p = 0.f;
#pragma unroll
    for (int gg = 0; gg < 4; ++gg) {
        const int dd = d0 + 8 * gg + 4 * kk;
        const f32x4 g1 = *(const f32x4*)(p.ln1_g + dd), b1 = *(const f32x4*)(p.ln1_b + dd);
        const unsigned lo = pk2(g1.x * acc[4 * gg], g1.y * acc[4 * gg + 1]), hi = pk2(g1.z * acc[4 * gg + 2], g1.w * acc[4 * gg + 3]);
        *(v2u*)(dst + 8 * gg + 4 * kk) = (v2u){lo, hi};
        c1p += (bflo(lo) + bfhi(lo)) + (bflo(hi) + bfhi(hi));
        c0p += (b1.x * acc[4 * gg] + b1.y * acc[4 * gg + 1]) + (b1.z * acc[4 * gg + 2] + b1.w * acc[4 * gg + 3]);
    }
    { const auto r1 = __builtin_amdgcn_permlane32_swap(__float_as_uint(c1p), __float_as_uint(c1p), false, false); c1p = __uint_as_float(r1[0]) + __uint_as_float(r1[1]);
      const auto r0 = __builtin_amdgcn_permlane32_swap(__float_as_uint(c0p), __float_as_uint(c0p), false, false); c0p = __uint_as_float(r0[0]) + __uint_as_float(r0[1]); }
    if (kk == 0) { ((float*)(p.ws + CTL_C1P))[dt * 2048 + col] = c1p; ((float*)(p.ws + CTL_C0P))[dt * 2048 + col] = c0p; }
}
__device__ __forceinline__ void phase0(const Params& p, LAS unsigned char* lds) {
    const int tid = pg8::ftid(), lane = tid & 63, wave = tid >> 6;
    const int gw = blockIdx.x * 8 + wave, NGW = gridDim.x * 8;
    LAS float* scr = (LAS float*)(lds + wave * 16896);
    if (!(wave & 1)) for (int it = gw; it < 4096; it += NGW) wf_item(p, it, lane);
    constexpr int I_IN = 16 * 513, I_SQ8 = 16 * 64;
    for (int rep12_ = 0; rep12_ < (((MK_PROBE) >> 12) & 1) + 1; ++rep12_)
    for (int it = gw; it < I_IN + 3 * I_SQ8; it += NGW) {
        int r = it;
        if (r < I_IN) { transpose_item_fp8<true>(p.w_in, D, NIN, p.ws + WS_BT_IN8, scr, r, lane); continue; } r -= I_IN;
        if (r < I_SQ8) { transpose_item_fp8<false>(p.p_a, D, D, p.ws + WS_BT_PA, scr, r, lane); continue; } r -= I_SQ8;
        if (r < I_SQ8) { transpose_item_fp8<false>(p.p_b, D, D, p.ws + WS_BT_PB, scr, r, lane); continue; } r -= I_SQ8;
        transpose_item_fp8<false>(p.w_o, D, D, p.ws + WS_BT_WO, scr, r, lane);
    }
    for (int r = gw; r < 240; r += NGW) { unsigned long long* o8 = (unsigned long long*)(p.ws + WS_BT_IN8 + (size_t)(64 * 256 + 16 + r) * D) + lane;
#pragma unroll
        for (int j = 0; j < 4; ++j) o8[64 * j] = 0ull; }
    for (int rep13_ = 0; rep13_ < (((MK_PROBE) >> 13) & 1) + 1; ++rep13_) {
        f32x4 va[8], vb[8], vc[8], vd[8];
        int r = gw;
        if (r < MP) ln0_load(p, r, lane, va);
        if (r + NGW < MP) ln0_load(p, r + NGW, lane, vb);
        if (r + 2 * NGW < MP) ln0_load(p, r + 2 * NGW, lane, vc);
        if (r + 3 * NGW < MP) ln0_load(p, r + 3 * NGW, lane, vd);
#pragma unroll 1
        for (; r < MP; r += 4 * NGW) {
            ln0_finish(p, r, lane, va); if (r + 4 * NGW < MP) ln0_load(p, r + 4 * NGW, lane, va);
            if (r + NGW < MP) { ln0_finish(p, r + NGW, lane, vb); if (r + 5 * NGW < MP) ln0_load(p, r + 5 * NGW, lane, vb); }
            if (r + 2 * NGW < MP) { ln0_finish(p, r + 2 * NGW, lane, vc); if (r + 6 * NGW < MP) ln0_load(p, r + 6 * NGW, lane, vc); }
            if (r + 3 * NGW < MP) { ln0_finish(p, r + 3 * NGW, lane, vd); if (r + 7 * NGW < MP) ln0_load(p, r + 7 * NGW, lane, vd); }
        }
    }
    for (int rep14_ = 0; rep14_ < (((MK_PROBE) >> 14) & 1) + 1; ++rep14_)
    if (wave & 1) for (int it = gw; it < 4096; it += NGW) wf_item(p, it, lane);
    (void)tid;
}
typedef float v32f __attribute__((ext_vector_type(32)));
typedef float v16f __attribute__((ext_vector_type(16)));
typedef unsigned v6u __attribute__((ext_vector_type(6)));
constexpr int ROW6 = 1536;
__device__ __forceinline__ void phase_uvconv(const Params& p) {
    const size_t units = (size_t)16384 * 64;
    const size_t gt = (size_t)blockIdx.x * 512 + pg8::ftid(), NT = (size_t)gridDim.x * 512;
    for (int t = 0; t < 2; ++t) {
        const float* src = t ? p.peer_v : p.peer_u; unsigned char* dst = p.ws + (t ? WS_VBF : WS_UBF); const float sc = t ? 2.f : 64.f;
        for (size_t i = gt; i < units; i += NT) {
            const size_t row = i >> 6; const int l = (int)(i & 63);
            const f32x4* s4 = (const f32x4*)(src + row * 2048 + l * 32);
            v16f x0, x1;
#pragma unroll
            for (int q = 0; q < 4; ++q) { const f32x4 a = s4[q] * sc, b = s4[4 + q] * sc; x0[4 * q] = a.x; x0[4 * q + 1] = a.y; x0[4 * q + 2] = a.z; x0[4 * q + 3] = a.w; x1[4 * q] = b.x; x1[4 * q + 1] = b.y; x1[4 * q + 2] = b.z; x1[4 * q + 3] = b.w; }
            const v6u w = __builtin_amdgcn_cvt_scalef32_2xpk16_fp6_f32(x0, x1, 1.0f);
            *(v4u*)(dst + row * ROW6 + l * 16) = (v4u){w[0], w[1], w[2], w[3]};
            *(v2u*)(dst + row * ROW6 + 1024 + l * 8) = (v2u){w[4], w[5]};
        }
    }
}
}

namespace pg8 {
struct EpiInProj {
    static constexpr bool PERM = true, AFTER_DRAIN = false;
    unsigned char* ws; unsigned char* outb;
    __device__ __forceinline__ void operator()(const f32x4 (&acc)[2][2][4][2], const Unit& u, int wr, int wc, int fr, int fq) const {
        bf16_t* const CB = (bf16_t*)(ws + mk::WS_CB); bf16_t* const Z = (bf16_t*)(ws + mk::WS_Z); bf16_t* const Q = (bf16_t*)(ws + mk::WS_Q); bf16_t* const K = (bf16_t*)(ws + mk::WS_K); bf16_t* const V = (bf16_t*)(ws + mk::WS_V);
        bf16_t* const SIGO = (bf16_t*)(ws + mk::WS_SIGO); bf16_t* const SGA = (bf16_t*)(outb + mk::OUT_SGA); bf16_t* const SGB = (bf16_t*)(outb + mk::OUT_SGB); float* const GIF = (float*)(ws + mk::WS_GIF);
        const int pn = u.pn, pm = u.pm; const bool meta = (pm >= 64);
        int row0 = pm * BM + wr * 64 + fr, cl = wc * 32 + 8 * fq;
        asm volatile("" : "+v"(row0), "+v"(cl));
        if (pn >= 8 && pn < 24) {
            bf16_t* base = Z + (size_t)(pn - 8) * 128 + cl;
#pragma unroll
            for (int ai = 0; ai < 2; ++ai)
#pragma unroll
                for (int m = 0; m < 4; ++m) { const f32x4 z0 = acc[ai][0][m][0] * acc[ai][1][m][0], z1 = acc[ai][0][m][1] * acc[ai][1][m][1];
                    u32x4 w; w.x = cvt_pk_bf16(z0[0], z0[1]); w.y = cvt_pk_bf16(z0[2], z0[3]); w.z = cvt_pk_bf16(z1[0], z1[1]); w.w = cvt_pk_bf16(z1[2], z1[3]);
                    *(u32x4*)(base + (size_t)(row0 + ai * HALF + m * 16) * 2048) = w; }
            return;
        }
        if (pn >= 64) {
            if (wc == 0 && fq < 2) {
#pragma unroll
                for (int ai = 0; ai < 2; ++ai)
#pragma unroll
                    for (int m = 0; m < 4; ++m) { float* g = GIF + (size_t)((row0 + ai * HALF + m * 16) * 16 + (cl & 31));     *(f32x4*)g = acc[ai][0][m][0]; *(f32x4*)(g + 4) = acc[ai][0][m][1]; }
            }
            return;
        }
        if (pn < 8) { if (!meta) store<0>(acc, CB, 2048, pn, row0, cl); }
        else if (pn < 28) { if (!meta) store_heads<2, 128>(acc, Q, nullptr, pn - 24, pm, row0, cl); }
        else if (pn < 32) store_heads<0, 128>(acc, K, K + (size_t)16 * 8192 * 128, pn - 28, pm, row0, cl);
        else if (pn < 40) store_heads<0, 256>(acc, V, V + (size_t)16 * 8192 * 256, pn - 32, pm, row0, cl);
        else if (meta) return;
        else if (pn < 48) store_heads<1, 256>(acc, SIGO, nullptr, pn - 40, pm, row0, cl);
        else if (pn < 56) store<1>(acc, SGA, 2048, pn - 48, row0, cl);
        else store<1>(acc, SGB, 2048, pn - 56, row0, cl);
    }
    template <int ACT, int HW> __device__ __forceinline__ void store_heads(const f32x4 (&acc)[2][2][4][2], bf16_t* X, bf16_t* MT, int colt, int pm, int row0, int cl) const {
        const bool meta = pm >= 64; const int b = pm >> 5;
#pragma unroll
        for (int ai = 0; ai < 2; ++ai)
#pragma unroll
            for (int m = 0; m < 4; ++m) { const int row = row0 + ai * HALF + m * 16; const int s = row & 8191, j = row - 16384;
                if (meta && j >= 16) continue;
#pragma unroll
                for (int bj = 0; bj < 2; ++bj) { f32x4 v0 = acc[ai][bj][m][0], v1 = acc[ai][bj][m][1];
                    const int h = (HW == 128) ? 2 * colt + bj : colt, c = (HW == 128) ? cl : bj * HALF + cl;
                    bf16_t* dst = meta ? MT + (size_t)(h * 16 + j) * HW + c : X + ((size_t)(b * 8 + h) * 8192 + s) * HW + c;
                    if (ACT == 1) { asm volatile("" : "+v"(v0), "+v"(v1));
#pragma unroll
                        for (int e = 0; e < 4; ++e) { v0[e] = mk::sigmoidf_(v0[e]); v1[e] = mk::sigmoidf_(v1[e]); } }
                    else if (ACT == 2) { v0 = v0 * mk::QSCALE; v1 = v1 * mk::QSCALE; }
                    u32x4 w; w.x = cvt_pk_bf16(v0[0], v0[1]); w.y = cvt_pk_bf16(v0[2], v0[3]); w.z = cvt_pk_bf16(v1[0], v1[1]); w.w = cvt_pk_bf16(v1[2], v1[3]);
                    *(u32x4*)dst = w;
                    if (ACT == 1) asm volatile("" ::: "memory"); }
                asm volatile("" ::: "memory"); }
    }
    template <int ACT> __device__ __forceinline__ void store(const f32x4 (&acc)[2][2][4][2], bf16_t* base, int ld, int colt, int row0, int cl) const {
        base += (size_t)colt * 256 + cl;
#pragma unroll
        for (int ai = 0; ai < 2; ++ai)
#pragma unroll
            for (int m = 0; m < 4; ++m) { bf16_t* rowp = base + (size_t)(row0 + ai * HALF + m * 16) * ld;
#pragma unroll
                for (int bj = 0; bj < 2; ++bj) { f32x4 v0 = acc[ai][bj][m][0], v1 = acc[ai][bj][m][1];
                    if (ACT == 1) { asm volatile("" : "+v"(v0), "+v"(v1));
#pragma unroll
                        for (int e = 0; e < 4; ++e) { v0[e] = mk::sigmoidf_(v0[e]); v1[e] = mk::sigmoidf_(v1[e]); } }
                    else if (ACT == 2) { v0 = v0 * mk::QSCALE; v1 = v1 * mk::QSCALE; }
                    u32x4 w; w.x = cvt_pk_bf16(v0[0], v0[1]); w.y = cvt_pk_bf16(v0[2], v0[3]); w.z = cvt_pk_bf16(v1[0], v1[1]); w.w = cvt_pk_bf16(v1[2], v1[3]);
                    *(u32x4*)(rowp + bj * HALF) = w;
                    if (ACT == 1) asm volatile("" ::: "memory"); }
                asm volatile("" ::: "memory"); }
    }
};
template <bool SECOND> struct EpiGate {
    static constexpr bool PERM = true, AFTER_DRAIN = false;
    const bf16_t* G; const bf16_t* T; bf16_t* O;
    __device__ __forceinline__ void operator()(const f32x4 (&acc)[2][2][4][2], const Unit& u, int wr, int wc, int fr, int fq) const {
        const int row0 = u.pm * BM + wr * 64 + fr, col0 = u.pn * BM + wc * 32 + 8 * fq;
#pragma unroll
        for (int ai = 0; ai < 2; ++ai)
#pragma unroll
            for (int m = 0; m < 4; ++m) { const size_t ro = (size_t)(row0 + ai * HALF + m * 16) * 2048 + col0;
#pragma unroll
                for (int bj = 0; bj < 2; ++bj) { const size_t off = ro + bj * HALF;
                    const u32x4 g = *(const u32x4*)(G + off); u32x4 t = (u32x4){0u, 0u, 0u, 0u}; if (SECOND) t = *(const u32x4*)(T + off);
                    f32x4 v0 = acc[ai][bj][m][0], v1 = acc[ai][bj][m][1]; float o[8];
                    if ((MK_DBG == 3 && SECOND) || (MK_DBG == 4 && !SECOND)) { v0 = v0 * 0.f; v1 = v1 * 0.f; }
                    o[0] = mk::bflo(g.x) * v0[0] + mk::bflo(t.x); o[1] = mk::bfhi(g.x) * v0[1] + mk::bfhi(t.x);
                    o[2] = mk::bflo(g.y) * v0[2] + mk::bflo(t.y); o[3] = mk::bfhi(g.y) * v0[3] + mk::bfhi(t.y);
                    o[4] = mk::bflo(g.z) * v1[0] + mk::bflo(t.z); o[5] = mk::bfhi(g.z) * v1[1] + mk::bfhi(t.z);
                    o[6] = mk::bflo(g.w) * v1[2] + mk::bflo(t.w); o[7] = mk::bfhi(g.w) * v1[3] + mk::bfhi(t.w);
                    if (SECOND) {
                        typedef unsigned u32x2_ __attribute__((ext_vector_type(2)));
                        *(u32x2_*)((unsigned char*)O + off) = (u32x2_){mk::pk4_fp8(o[0], o[1], o[2], o[3]), mk::pk4_fp8(o[4], o[5], o[6], o[7])};
                    } else {
                        u32x4 w; w.x = cvt_pk_bf16(o[0], o[1]); w.y = cvt_pk_bf16(o[2], o[3]); w.z = cvt_pk_bf16(o[4], o[5]); w.w = cvt_pk_bf16(o[6], o[7]);
                        *(u32x4*)(O + off) = w; } } }
    }
};
struct EpiResid {
    static constexpr bool PERM = true, AFTER_DRAIN = false;
    const bf16_t* H0; bf16_t* R;
    __device__ __forceinline__ void operator()(const f32x4 (&acc)[2][2][4][2], const Unit& u, int wr, int wc, int fr, int fq) const {
        const int row0 = u.pm * BM + wr * 64 + fr, col0 = u.pn * BM + wc * 32 + 8 * fq;
#pragma unroll
        for (int ai = 0; ai < 2; ++ai)
#pragma unroll
            for (int m = 0; m < 4; ++m) { const int row = row0 + ai * HALF + m * 16; const size_t ro = (size_t)row * 2048 + col0;
#pragma unroll
                for (int bj = 0; bj < 2; ++bj) { const size_t off = ro + bj * HALF;
                    const u32x4 h = *(const u32x4*)(H0 + off);
                    f32x4 v0 = acc[ai][bj][m][0], v1 = acc[ai][bj][m][1]; float o[8];
                    if (MK_DBG == 5) { v0 = v0 * 0.f; v1 = v1 * 0.f; }
                    o[0] = mk::ALPHA * mk::bflo(h.x) + v0[0]; o[1] = mk::ALPHA * mk::bfhi(h.x) + v0[1];
                    o[2] = mk::ALPHA * mk::bflo(h.y) + v0[2]; o[3] = mk::ALPHA * mk::bfhi(h.y) + v0[3];
                    o[4] = mk::ALPHA * mk::bflo(h.z) + v1[0]; o[5] = mk::ALPHA * mk::bfhi(h.z) + v1[1];
                    o[6] = mk::ALPHA * mk::bflo(h.w) + v1[2]; o[7] = mk::ALPHA * mk::bfhi(h.w) + v1[3];
                    u32x4 w; w.x = cvt_pk_bf16(o[0], o[1]); w.y = cvt_pk_bf16(o[2], o[3]); w.z = cvt_pk_bf16(o[4], o[5]); w.w = cvt_pk_bf16(o[6], o[7]);
                    *(u32x4*)(R + off) = w; } }
    }
};
struct EpiScores {
    static constexpr bool PERM = false, AFTER_DRAIN = false;
    float* S;
    __device__ __forceinline__ void operator()(const f32x4 (&acc)[2][2][4][2], const Unit& u, int wr, int wc, int fr, int fq) const {
        const int row0 = u.pm * BM + wr * 64 + fr, col0 = u.pn * BM + wc * 32 + 4 * fq;
#pragma unroll
        for (int ai = 0; ai < 2; ++ai)
#pragma unroll
            for (int m = 0; m < 4; ++m) { float* rowp = S + (size_t)(row0 + ai * HALF + m * 16) * 2048 + col0;
#pragma unroll
                for (int bj = 0; bj < 2; ++bj)
#pragma unroll
                    for (int n = 0; n < 2; ++n) *(f32x4*)(rowp + bj * HALF + n * 16) = acc[ai][bj][m][n]; }
    }
};
}

namespace mk {
__device__ __forceinline__ void phase_c1c0(const Params& p) {
    const int gt = blockIdx.x * 512 + pg8::ftid();
    if (gt < 4096) { const int col = gt & 2047; const float* src = (const float*)(p.ws + (gt < 2048 ? CTL_C1P : CTL_C0P)); float a = 0.f;
        for (int i = 0; i < 64; ++i) a += src[i * 2048 + col];
        ((float*)(p.ws + (gt < 2048 ? CTL_C1 : CTL_C0)))[col] = a; }
}
__device__ __forceinline__ void phase_conv(const Params& p) {
    bf16* CB = (bf16*)(p.ws + WS_CB); const bf16* Z = (const bf16*)(p.ws + WS_Z);
    const int gt = blockIdx.x * 512 + pg8::ftid(), NT = gridDim.x * 512;
    for (int it = gt; it < 1024 * 256; it += NT) {
        const int cg = it & 255, rb = it >> 8, c0 = cg * 8, r0 = rb * 16;
        float w0[8], w1[8], w2[8];
#pragma unroll
        for (int e = 0; e < 8; ++e) { w0[e] = p.conv_w[c0 + e]; w1[e] = p.conv_w[2048 + c0 + e]; w2[e] = p.conv_w[4096 + c0 + e]; }
        const bool first = (r0 & (SEQ - 1)) == 0;
        v4u zm2 = *(const v4u*)(Z + (size_t)(first ? MX + 14 : r0 - 2) * D + c0);
        v4u zm1 = *(const v4u*)(Z + (size_t)(first ? MX + 15 : r0 - 1) * D + c0);
#pragma unroll 4
        for (int i = 0; i < 16; ++i) {
            const size_t off = (size_t)(r0 + i) * D + c0;
            const v4u z = *(const v4u*)(Z + off), cb = *(const v4u*)(CB + off);
            float y[8];
            y[0] = bflo(cb.x) * (w0[0] * bflo(zm2.x) + w1[0] * bflo(zm1.x) + w2[0] * bflo(z.x)); y[1] = bfhi(cb.x) * (w0[1] * bfhi(zm2.x) + w1[1] * bfhi(zm1.x) + w2[1] * bfhi(z.x));
            y[2] = bflo(cb.y) * (w0[2] * bflo(zm2.y) + w1[2] * bflo(zm1.y) + w2[2] * bflo(z.y)); y[3] = bfhi(cb.y) * (w0[3] * bfhi(zm2.y) + w1[3] * bfhi(zm1.y) + w2[3] * bfhi(z.y));
            y[4] = bflo(cb.z) * (w0[4] * bflo(zm2.z) + w1[4] * bflo(zm1.z) + w2[4] * bflo(z.z)); y[5] = bfhi(cb.z) * (w0[5] * bfhi(zm2.z) + w1[5] * bfhi(zm1.z) + w2[5] * bfhi(z.z));
            y[6] = bflo(cb.w) * (w0[6] * bflo(zm2.w) + w1[6] * bflo(zm1.w) + w2[6] * bflo(z.w)); y[7] = bfhi(cb.w) * (w0[7] * bfhi(zm2.w) + w1[7] * bfhi(zm1.w) + w2[7] * bfhi(z.w));
            *(v2u*)(p.ws + WS_YA8 + off) = (v2u){pk4_fp8(y[0], y[1], y[2], y[3]), pk4_fp8(y[4], y[5], y[6], y[7])};
            zm2 = zm1; zm1 = z;
        }
    }
}

constexpr float U_SCALE = 64.f, V_SCALE = 2.f;
#ifndef MK_FP6_ORDER
#define MK_FP6_ORDER 1
#endif
__device__ __forceinline__ float gelu_exact(float a) { return 0.5f * a * (1.f + erff(a * 0.70710678118654752f)); }
__device__ __forceinline__ void ce_desc(unsigned& a, unsigned& b) { const unsigned hi = a > b ? a : b, lo = a > b ? b : a; a = hi; b = lo; }
__device__ __forceinline__ void merge16_desc(unsigned (&v)[16]) {
#pragma unroll
    for (int j = 8; j > 0; j >>= 1)
#pragma unroll
        for (int i = 0; i < 16; ++i) { const int l = i ^ j; if (l > i) ce_desc(v[i], v[l]); }
}
__device__ __forceinline__ void sort16_desc(unsigned (&v)[16]) {
#pragma unroll
    for (int k = 2; k <= 16; k <<= 1)
#pragma unroll
        for (int j = k >> 1; j > 0; j >>= 1)
#pragma unroll
            for (int i = 0; i < 16; ++i) { const int l = i ^ j; if (l > i) { if ((i & k) == 0) ce_desc(v[i], v[l]); else ce_desc(v[l], v[i]); } }
}
__device__ __forceinline__ float key_val(unsigned k) { const unsigned m = k & 0xFFFFFF80u; return __uint_as_float((m & 0x80000000u) ? (m & 0x7FFFFFFFu) : ~m); }
__device__ __forceinline__ void phase_peer(const Params& p, LAS unsigned char* lds) {
    const int tid = pg8::ftid(), lane0 = tid & 63, wave = tid >> 6;
    LAS unsigned* K1 = (LAS unsigned*)(lds + wave * 4096);
    LAS unsigned* K2 = (LAS unsigned*)(lds + wave * 4096 + 1024);
    LAS int* Ei = (LAS int*)(lds + wave * 4096 + 3072);
    LAS float* Eg = (LAS float*)(lds + wave * 4096 + 3584);
    LAS float* PAR = (LAS float*)(lds + 32768);
    {
        const float* C1g = (const float*)(p.ws + CTL_C1); const float* C0g = (const float*)(p.ws + CTL_C0);
        for (int i = tid; i < 2048; i += 512) { PAR[i] = p.ln1_g[i]; PAR[2048 + i] = p.ln1_b[i]; PAR[4096 + i] = p.ln2_g[i]; PAR[6144 + i] = p.ln2_b[i]; PAR[8192 + i] = C1g[i]; PAR[10240 + i] = C0g[i]; }
    }
    __syncthreads();
    unsigned ciw = 0u, cjw = 0u;
    { const int sub0 = lane0 & 7; int c = 0; for (int i = 0; i < 16; ++i) { const int nj = 16 / (i + 1); for (int j = 0; j < nj; ++j) { if ((c & 7) == sub0) { ciw |= (unsigned)i << (4 * (c >> 3)); cjw |= (unsigned)j << (4 * (c >> 3)); } ++c; } } }
    const bf16* R = (const bf16*)(p.ws + WS_R);
    const unsigned char* U6 = p.ws + WS_UBF; const unsigned char* V6 = p.ws + WS_VBF;
    float* SC = p.out;
    const int gw = blockIdx.x * 8 + wave, NGW = gridDim.x * 8;
#pragma unroll 1
    for (int r = gw; r < MX; r += NGW) {
        int lane = lane0; asm volatile("" : "+v"(lane));
        const int qd = lane & 3, qbase = lane & ~3;
        float mu, rstd;
        v4u rw_[4];
        {
            v4u (&w)[4] = rw_; float s1 = 0.f;
#pragma unroll
            for (int q = 0; q < 4; ++q) { w[q] = *(const v4u*)(R + (size_t)r * D + lane * 32 + q * 8);
                s1 += ((bflo(w[q].x) + bfhi(w[q].x)) + (bflo(w[q].y) + bfhi(w[q].y))) + ((bflo(w[q].z) + bfhi(w[q].z)) + (bflo(w[q].w) + bfhi(w[q].w))); }
            mu = wave_sum(s1) * (1.f / D); float s2 = 0.f;
#pragma unroll
            for (int q = 0; q < 4; ++q) { const float d0 = bflo(w[q].x) - mu, d1 = bfhi(w[q].x) - mu, d2 = bflo(w[q].y) - mu, d3 = bfhi(w[q].y) - mu, d4 = bflo(w[q].z) - mu, d5 = bfhi(w[q].z) - mu, d6 = bflo(w[q].w) - mu, d7 = bfhi(w[q].w) - mu;
                s2 += ((d0 * d0 + d1 * d1) + (d2 * d2 + d3 * d3)) + ((d4 * d4 + d5 * d5) + (d6 * d6 + d7 * d7)); }
            rstd = 1.f / sqrtf(wave_sum(s2) * (1.f / D) + LN_EPS);
        }
        for (int rep11_ = 0; rep11_ < (((MK_PROBE) >> 11) & 1) + 1; ++rep11_) {
        {
            unsigned v[32];
#pragma unroll
            for (int i = 0; i < 8; ++i) { const f32x4 t = *(const f32x4*)(SC + (size_t)r * D + lane * 32 + 4 * i);
                const f32x4 a1 = *(const LAS f32x4*)(PAR + 8192 + lane * 32 + 4 * i), a0 = *(const LAS f32x4*)(PAR + 10240 + lane * 32 + 4 * i);
                const f32x4 y = (t - a1 * mu) * rstd + a0;
#pragma unroll
                for (int c = 0; c < 4; ++c) { const unsigned u = __float_as_uint(y[c]); const unsigned mono = (u & 0x80000000u) ? ~u : (u | 0x80000000u);
                    v[4 * i + c] = (mono & 0xFFFFFF80u) | (unsigned)(127 - (qd * 32 + 4 * i + c)); } }
            unsigned A[16], B[16];
#pragma unroll
            for (int i = 0; i < 16; ++i) { A[i] = v[i]; B[i] = v[16 + i]; }
            sort16_desc(A); sort16_desc(B);
#pragma unroll
            for (int i = 0; i < 16; ++i) A[i] = A[i] > B[15 - i] ? A[i] : B[15 - i];
            merge16_desc(A);
#pragma unroll
            for (int i = 0; i < 16; ++i) B[i] = (unsigned)__builtin_amdgcn_update_dpp(0, (int)A[15 - i], 0xB1, 0xF, 0xF, true);
#pragma unroll
            for (int i = 0; i < 16; ++i) A[i] = A[i] > B[i] ? A[i] : B[i];
            merge16_desc(A);
#pragma unroll
            for (int i = 0; i < 16; ++i) B[i] = (unsigned)__builtin_amdgcn_update_dpp(0, (int)A[15 - i], 0x4E, 0xF, 0xF, true);
#pragma unroll
            for (int i = 0; i < 16; ++i) A[i] = A[i] > B[i] ? A[i] : B[i];
            merge16_desc(A);
            const int g = lane >> 2;
            const unsigned w0 = qd == 0 ? A[0] : qd == 1 ? A[4] : qd == 2 ? A[8] : A[12], w1 = qd == 0 ? A[1] : qd == 1 ? A[5] : qd == 2 ? A[9] : A[13];
            const unsigned w2 = qd == 0 ? A[2] : qd == 1 ? A[6] : qd == 2 ? A[10] : A[14], w3 = qd == 0 ? A[3] : qd == 1 ? A[7] : qd == 2 ? A[11] : A[15];
            *(LAS v4u*)(K1 + g * 16 + 4 * qd) = (v4u){w0, w1, w2, w3};
        }
        LDS_WAIT();
        {
            const int hh = lane >> 3, sub = lane & 7;
            float sa[7]; int ea[7]; unsigned ka[7];
#pragma unroll
            for (int a = 0; a < 7; ++a) { const int ci_ = (ciw >> (4 * a)) & 15, cj_ = (cjw >> (4 * a)) & 15; const bool ok = (sub + 8 * a) < 50;
                const unsigned k0 = K1[(2 * hh) * 16 + ci_], k1 = K1[(2 * hh + 1) * 16 + cj_];
                const float s = key_val(k0) + key_val(k1);
                sa[a] = s; ea[a] = (127 - (int)(k0 & 127u)) * 128 + (127 - (int)(k1 & 127u));
                const unsigned u = __float_as_uint(s); const unsigned mono = (u & 0x80000000u) ? ~u : (u | 0x80000000u);
                ka[a] = ok ? ((mono & 0xFFFFFFC0u) | (unsigned)(63 - (sub + 8 * a))) : 0u;
                K2[hh * 64 + sub + 8 * a] = ka[a]; }
            if (sub == 0) K2[hh * 64 + 56] = 0u;
            LDS_WAIT();
            int rk[7];
#pragma unroll
            for (int a = 0; a < 7; ++a) rk[a] = 0;
#pragma unroll
            for (int q = 0; q < 14; ++q) { const v4u kb = *(const LAS v4u*)(K2 + hh * 64 + 4 * q);
#pragma unroll
                for (int a = 0; a < 7; ++a) rk[a] += (kb.x > ka[a] ? 1 : 0) + (kb.y > ka[a] ? 1 : 0) + (kb.z > ka[a] ? 1 : 0) + (kb.w > ka[a] ? 1 : 0); }
            const float smax = key_val(K1[(2 * hh) * 16]) + key_val(K1[(2 * hh + 1) * 16]);
            float ex[7]; float part = 0.f;
#pragma unroll
            for (int a = 0; a < 7; ++a) { const bool sel = ka[a] != 0u && rk[a] < 16; ex[a] = sel ? __expf(sa[a] - smax) : 0.f; part += ex[a]; }
            part += __builtin_bit_cast(float, __builtin_amdgcn_update_dpp(0, __builtin_bit_cast(int, part), 0xB1, 0xF, 0xF, true));
            part += __builtin_bit_cast(float, __builtin_amdgcn_update_dpp(0, __builtin_bit_cast(int, part), 0x4E, 0xF, 0xF, true));
            part += __builtin_bit_cast(float, __builtin_amdgcn_update_dpp(0, __builtin_bit_cast(int, part), 0x141, 0xF, 0xF, true));
            const float inv = 1.f / part;
#pragma unroll
            for (int a = 0; a < 7; ++a) if (ka[a] != 0u && rk[a] < 16) { Ei[hh * 16 + rk[a]] = ea[a]; Eg[hh * 16 + rk[a]] = ex[a] * inv; }
        }
        LDS_WAIT();
        }
        v32f x;
        {
            float xl[32];
#pragma unroll
            for (int q = 0; q < 4; ++q) {
                const int e0 = lane * 32 + q * 8;
                const v4u w = rw_[q];
                const f32x4 g0 = *(const LAS f32x4*)(PAR + e0), g1 = *(const LAS f32x4*)(PAR + e0 + 4), b0 = *(const LAS f32x4*)(PAR + 2048 + e0), b1 = *(const LAS f32x4*)(PAR + 2048 + e0 + 4);
                xl[8 * q + 0] = (bflo(w.x) - mu) * rstd * g0.x + b0.x; xl[8 * q + 1] = (bfhi(w.x) - mu) * rstd * g0.y + b0.y;
                xl[8 * q + 2] = (bflo(w.y) - mu) * rstd * g0.z + b0.z; xl[8 * q + 3] = (bfhi(w.y) - mu) * rstd * g0.w + b0.w;
                xl[8 * q + 4] = (bflo(w.z) - mu) * rstd * g1.x + b1.x; xl[8 * q + 5] = (bfhi(w.z) - mu) * rstd * g1.y + b1.y;
                xl[8 * q + 6] = (bflo(w.w) - mu) * rstd * g1.z + b1.z; xl[8 * q + 7] = (bfhi(w.w) - mu) * rstd * g1.w + b1.w;
            }
#pragma unroll
            for (int i = 0; i < 32; ++i) x[MK_FP6_ORDER ? ((i & 15) * 2 + (i >> 4)) : i] = xl[i];
        }
        {
            auto loadu = [&](v6u (&w)[4], int e0) {
#pragma unroll
                for (int k = 0; k < 4; ++k) { const int id = __builtin_amdgcn_readfirstlane(Ei[e0 + k]) & 16383; const unsigned char* up = U6 + (size_t)id * ROW6;
                    const v4u a = *(const v4u*)(up + lane * 16); const v2u b = *(const v2u*)(up + 1024 + lane * 8); w[k] = (v6u){a.x, a.y, a.z, a.w, b.x, b.y}; }
            };
            auto compu = [&](const v6u (&w)[4], int e0) {
                float s[4];
#pragma unroll
                for (int k = 0; k < 4; ++k) { const v32f y = __builtin_amdgcn_cvt_scalef32_pk32_f32_fp6(w[k], 1.0f); f32x2 a = (f32x2){0.f, 0.f};
#pragma unroll
                    for (int i = 0; i < 16; ++i) a += (f32x2){y[2 * i], y[2 * i + 1]} * (f32x2){x[2 * i], x[2 * i + 1]};
                    s[k] = a.x + a.y; }
                float u1;
                { const auto r02 = __builtin_amdgcn_permlane32_swap(__float_as_uint(s[0]), __float_as_uint(s[2]), false, false);
                  const auto r13 = __builtin_amdgcn_permlane32_swap(__float_as_uint(s[1]), __float_as_uint(s[3]), false, false);
                  const float a02 = __uint_as_float(r02[0]) + __uint_as_float(r02[1]), a13 = __uint_as_float(r13[0]) + __uint_as_float(r13[1]);
                  const auto rr = __builtin_amdgcn_permlane16_swap(__float_as_uint(a02), __float_as_uint(a13), false, false);
                  u1 = row16_sum(__uint_as_float(rr[0]) + __uint_as_float(rr[1])); }
                if ((lane & 15) == 0) { const int k = lane >> 4; Eg[e0 + k] = Eg[e0 + k] * gelu_exact(u1 * (1.f / U_SCALE)) * (1.f / V_SCALE); }
            };
            v6u wa[4], wb[4], wc[4];
            loadu(wa, 0); loadu(wb, 4);
#pragma unroll 1
            for (int e0 = 0; e0 < 120; e0 += 12) {
                loadu(wc, e0 + 8);
                compu(wa, e0);
                loadu(wa, e0 + 12);
                compu(wb, e0 + 4);
                loadu(wb, e0 + 16);
                compu(wc, e0 + 8);
            }
            compu(wa, 120); compu(wb, 124);
        }
        LDS_WAIT();
        v32f o;
#pragma unroll
        for (int i = 0; i < 32; ++i) o[i] = 0.f;
        {
            auto loadv = [&](v6u (&w)[4], int e0) {
#pragma unroll
                for (int k = 0; k < 4; ++k) { const int id = __builtin_amdgcn_readfirstlane(Ei[e0 + k]) & 16383; const unsigned char* vp = V6 + (size_t)id * ROW6;
                    const v4u a = *(const v4u*)(vp + lane * 16); const v2u b = *(const v2u*)(vp + 1024 + lane * 8); w[k] = (v6u){a.x, a.y, a.z, a.w, b.x, b.y}; }
            };
            auto compv = [&](const v6u (&w)[4], int e0) {
#pragma unroll
                for (int k = 0; k < 4; ++k) { const float wt = Eg[e0 + k]; const v32f y = __builtin_amdgcn_cvt_scalef32_pk32_f32_fp6(w[k], 1.0f); o += y * wt; }
            };
            v6u wa[4], wb[4], wc[4];
            loadv(wa, 0); loadv(wb, 4);
#pragma unroll 1
            for (int e0 = 0; e0 < 120; e0 += 12) {
                loadv(wc, e0 + 8);
                compv(wa, e0);
                loadv(wa, e0 + 12);
                compv(wb, e0 + 4);
                loadv(wb, e0 + 16);
                compv(wc, e0 + 8);
            }
            compv(wa, 120); compv(wb, 124);
        }
        float s1 = 0.f;
#pragma unroll
        for (int i = 0; i < 32; ++i) { o[i] = x[i] * ALPHA + o[i]; s1 += o[i]; }
        const float mean = wave_sum(s1) * (1.f / D); float s2 = 0.f;
#pragma unroll
        for (int i = 0; i < 32; ++i) { o[i] = o[i] - mean; s2 += o[i] * o[i]; }
        const float rstd2 = 1.f / sqrtf(wave_sum(s2) * (1.f / D) + LN_EPS);
#pragma unroll
        for (int q = 0; q < 8; ++q) {
            const int e0 = lane * 32 + q * 4;
            const f32x4 g = *(const LAS f32x4*)(PAR + 4096 + e0), bb = *(const LAS f32x4*)(PAR + 6144 + e0);
            float oo[4];
#pragma unroll
            for (int c = 0; c < 4; ++c) { const int i = q * 4 + c; oo[c] = o[MK_FP6_ORDER ? ((i & 15) * 2 + (i >> 4)) : i]; }
            f32x4 y; y.x = oo[0] * rstd2 * g.x + bb.x; y.y = oo[1] * rstd2 * g.y + bb.y; y.z = oo[2] * rstd2 * g.z + bb.z; y.w = oo[3] * rstd2 * g.w + bb.w;
            *(f32x4*)(p.out + (size_t)r * D + e0) = y;
        }
    }
}

__device__ __forceinline__ void phase_gemm_in(const Params& p, LAS unsigned char* lds) {
    pg8::Gemm g{(const bf16*)(p.ws + WS_H0F8), (const bf16*)(p.ws + WS_BT_IN8), MP, NINP, D / 2};
    pg8::StaticOrder S; S.init(MP, NINP, gridDim.x, blockIdx.x, MK_WGM_IN);
    pg8::EpiInProj E{p.ws, (unsigned char*)p.out};
    pg8::gemm_phase<pg8::EpiInProj, pg8::StaticOrder, true, true, true>(lds, g, S, E);
}
__device__ __forceinline__ void phase_gemm_g2a(const Params& p, LAS unsigned char* lds) {
    pg8::Gemm g{(const bf16*)(p.ws + WS_YA8), (const bf16*)(p.ws + WS_BT_PA), MX, D, D / 2};
    pg8::StaticOrder S; S.init(MX, D, gridDim.x, blockIdx.x, MK_WGM_SQ);
    pg8::EpiGate<false> E{(const bf16*)(MK_DBG == 16 ? p.ws + WS_H0 : MK_DBG == 14 ? p.ws + 489 * MiB : (unsigned char*)p.out + OUT_SGA), nullptr, (bf16*)(p.ws + WS_TMP)};
    pg8::gemm_phase<pg8::EpiGate<false>, pg8::StaticOrder, MK_ALIGN, MK_SP2, true>(lds, g, S, E);
}
__device__ __forceinline__ void phase_gemm_g2b(const Params& p, LAS unsigned char* lds) {
    pg8::Gemm g{(const bf16*)(p.ws + WS_YB), (const bf16*)(p.ws + WS_BT_PB), MX, D, D / 2};
    pg8::StaticOrder S; S.init(MX, D, gridDim.x, blockIdx.x, MK_WGM_SQ);
    pg8::EpiGate<true> E{(const bf16*)((unsigned char*)p.out + OUT_SGB), (const bf16*)(p.ws + WS_TMP), (bf16*)(p.ws + WS_MERGED)};
    pg8::gemm_phase<pg8::EpiGate<true>, pg8::StaticOrder, MK_ALIGN, MK_SP2, true>(lds, g, S, E);
}
__device__ __forceinline__ void phase_gemm_g3(const Params& p, LAS unsigned char* lds) {
    pg8::Gemm g{(const bf16*)(p.ws + WS_MERGED), (const bf16*)(p.ws + WS_BT_WO), MX, D, D / 2};
    pg8::StaticOrder S; S.init(MX, D, gridDim.x, blockIdx.x, MK_WGM_SQ);
    pg8::EpiResid E{(const bf16*)(p.ws + WS_H0), (bf16*)(p.ws + WS_R)};
    pg8::gemm_phase<pg8::EpiResid, pg8::StaticOrder, MK_ALIGN, MK_SP2, true>(lds, g, S, E);
}
__device__ __forceinline__ void phase_gemm_pq(const Params& p, LAS unsigned char* lds) {
    pg8::Gemm g{(const bf16*)(p.ws + WS_R), (const bf16*)(p.ws + WS_BT_F), MX, D, D};
    pg8::StaticOrder S; S.init(MX, D, gridDim.x, blockIdx.x, MK_WGM_SQ);
    pg8::EpiScores E{p.out};
    pg8::gemm_phase<pg8::EpiScores, pg8::StaticOrder, MK_ALIGN, MK_SP2>(lds, g, S, E);
}


namespace ml {
typedef short s16x4 __attribute__((ext_vector_type(4)));
typedef short bf16x8 __attribute__((ext_vector_type(8)));
typedef float f32x16 __attribute__((ext_vector_type(16)));
using mk::v4u; using mk::f32x4; using mk::bf16; using mk::Params;
constexpr int QROW = 272, KROW = 320, VROW = 576, PROW = 144, HROW = 528;
constexpr int L_QS = 0, L_QS2 = L_QS + 64 * QROW, L_KS = L_QS2 + 64 * QROW, L_VS = L_KS + 64 * KROW, L_PS = L_VS + 64 * VROW, L_HS = L_PS + 64 * PROW;
constexpr int L_VEC = L_HS + 64 * HROW;
constexpr int VECSET = 6 * 256;
constexpr int L_NS = L_VEC + 2 * VECSET;
constexpr int L_DEN = L_NS + 1024;
constexpr int L_TAB = L_DEN + 256;
constexpr int L_END = L_TAB + 1088;
static_assert(L_END <= mk::LDS_BYTES, "mLSTM LDS map");
constexpr size_t STATE_F = 32768 + 128;
constexpr size_t WS_STATE = mk::WS_BT_IN;
constexpr size_t WS_DT = mk::WS_BT_IN + 16 * 16 * STATE_F * 4;
static_assert(WS_DT + 1024 <= mk::WS_CB, "state region");

__device__ __forceinline__ int crow(int reg, int h) { return (reg & 3) + 8 * (reg >> 2) + 4 * h; }
__device__ __forceinline__ float scan_add(float v, int lane) {
#pragma unroll
    for (int o = 1; o < 64; o <<= 1) { const float t = __shfl_up(v, o); if (lane >= o) v += t; }
    return v;
}
__device__ __forceinline__ float scan_max(float v, int lane) {
#pragma unroll
    for (int o = 1; o < 64; o <<= 1) { const float t = __shfl_up(v, o); if (lane >= o) v = fmaxf(v, t); }
    return v;
}
__device__ __forceinline__ float wave_max(float v) {
#pragma unroll
    for (int o = 1; o < 64; o <<= 1) v = fmaxf(v, __shfl_xor(v, o));
    return v;
}
__device__ __forceinline__ void gate_load(const Params& p, int b, int hd, int ci, int lane, float& ip, float& fp) {
    const float* GIF = (const float*)(p.ws + mk::WS_GIF);
    const int row = (ci == 0) ? mk::MX + (lane & 15) : b * mk::SEQ + (ci - 1) * 64 + lane;
    ip = GIF[(size_t)row * 16 + hd]; fp = GIF[(size_t)row * 16 + 8 + hd];
}
__device__ __forceinline__ void gate_math(const Params& p, int hd, int ci, int lane, float ip, float fp, float& li, float& lf) {
    const bool pad = (ci == 0) && lane >= 16;
    ip += p.b_if[hd]; fp += p.b_if[8 + hd];
    li = pad ? -1e30f : ip;
    lf = pad ? 0.f : (fminf(fp, 0.f) - log1pf(__expf(-fabsf(fp))));
}
__device__ __forceinline__ bf16x8 tr_frag(LAS unsigned char* tile, int rowstride, int k0, int n0, int lane) {
    const int h = lane >> 5, blk = (lane >> 4) & 1, q = (lane & 15) >> 2, pp = lane & 3;
    LAS unsigned char* a = tile + (k0 + 8 * h + q) * rowstride + 2 * (n0 + 16 * blk + 4 * pp);
    const s16x4 lo = __builtin_amdgcn_ds_read_tr16_b64_v4i16((LAS s16x4*)a);
    const s16x4 hi = __builtin_amdgcn_ds_read_tr16_b64_v4i16((LAS s16x4*)(a + 4 * rowstride));
    return __builtin_shufflevector(lo, hi, 0, 1, 2, 3, 4, 5, 6, 7);
}
#define ML_MFMA32(a, b, c) __builtin_amdgcn_mfma_f32_32x32x16_bf16((a), (b), (c), 0, 0, 0)
#define ML_MFMA16(a, b, c) __builtin_amdgcn_mfma_f32_16x16x32_bf16((a), (b), (c), 0, 0, 0)

template <bool FULL>
__device__ __forceinline__ void mlstm_pass(const Params& p, LAS unsigned char* lds) {
    const int tid = pg8::ftid(), lane = tid & 63, w = __builtin_amdgcn_readfirstlane(tid >> 6);
    const int r = lane & 31, h5 = lane >> 5;
    const bf16* Qg = (const bf16*)(p.ws + mk::WS_Q); const bf16* Kg = (const bf16*)(p.ws + mk::WS_K); bf16* Vg = (bf16*)(p.ws + mk::WS_V);
    const bf16* SOg = (const bf16*)(p.ws + mk::WS_SIGO);
    float* STATE = (float*)(p.ws + WS_STATE); float* MU = (float*)(p.ws + WS_DT); float* BLS = MU + 256; const float* MSTART = MU + 512;
    LAS float* DEN = (LAS float*)(lds + L_DEN);
    for (int item = blockIdx.x; item < 256; item += gridDim.x) {
        const int bh = item >> 4, j = item & 15, b = bh >> 3, hd = bh & 7;
        const int nchunks = (j == 0) ? 9 : 8, ci0 = (j == 0) ? 0 : 8 * j + 1;
        float m_prev = FULL ? MSTART[bh * 16 + j] : -INFINITY;
        float blsum = 0.f;
        f32x16 Cacc[4];
        if (FULL && j > 0) {
            const float* src = STATE + ((size_t)bh * 16 + (j - 1)) * STATE_F;
#pragma unroll
            for (int i = 0; i < 4; ++i)
#pragma unroll
                for (int g = 0; g < 16; ++g) Cacc[i][g] = src[((w * 4 + i) * 16 + g) * 64 + lane];
            if (tid < 128) ((LAS float*)(lds + L_NS))[tid] = src[32768 + tid];
        } else {
#pragma unroll
            for (int i = 0; i < 4; ++i)
#pragma unroll
                for (int g = 0; g < 16; ++g) Cacc[i][g] = 0.f;
            if (tid < 128) ((LAS float*)(lds + L_NS))[tid] = 0.f;
        }
        v4u pq[2], pk[2], pv[4];
        auto issue_loads = [&](int ci, int tl) {
            const bool meta = (ci == 0);
            const bf16* kb = meta ? Kg + (size_t)16 * 8192 * 128 + (size_t)hd * 16 * 128 : Kg + ((size_t)bh * 8192 + (ci - 1) * 64) * 128;
            const bf16* vb = meta ? Vg + (size_t)16 * 8192 * 256 + (size_t)hd * 16 * 256 : Vg + ((size_t)bh * 8192 + (ci - 1) * 64) * 256;
            const bf16* qb = Qg + ((size_t)bh * 8192 + (meta ? 0 : (ci - 1) * 64)) * 128;
#pragma unroll
            for (int u = 0; u < 2; ++u) { const int id = tl + 512 * u, rr = id >> 4;
                const bool ok = !meta || rr < 16;
                pk[u] = ok ? *(const v4u*)(kb + (size_t)id * 8) : (v4u){0u, 0u, 0u, 0u};
                if (FULL) pq[u] = !meta ? *(const v4u*)(qb + (size_t)id * 8) : (v4u){0u, 0u, 0u, 0u}; }
#pragma unroll
            for (int u = 0; u < 4; ++u) { const int id = tl + 512 * u, rr = id >> 5;
                const bool ok = !meta || rr < 16;
                pv[u] = ok ? *(const v4u*)(vb + (size_t)id * 8) : (v4u){0u, 0u, 0u, 0u}; }
        };
        { int tl = tid; asm volatile("" : "+v"(tl)); issue_loads(ci0, tl); }
        float gip = 0.f, gfp = 0.f; if (w == 7) gate_load(p, b, hd, ci0, lane, gip, gfp);
        auto make_vec = [&](int kk) {
            const int cix = ci0 + kk;
            LAS float* VS_ = (LAS float*)(lds + L_VEC + (kk & 1) * VECSET);
            float li, lf; gate_math(p, hd, cix, lane, gip, gfp, li, lf);
            if (kk + 1 < nchunks) gate_load(p, b, hd, cix + 1, lane, gip, gfp);
            const float bb = scan_add(lf, lane); const float g = li - bb; const float G = fmaxf(m_prev, scan_max(g, lane));
            const float Gend = __shfl(G, 63), bl = __shfl(bb, 63);
            VS_[lane] = g; VS_[64 + lane] = G; VS_[128 + lane] = __expf(m_prev - G); VS_[192 + lane] = __expf(g - Gend); VS_[256 + lane] = __expf(-(bb + G));
            const float decay = __expf(m_prev - Gend);
            if (lane == 0) VS_[320] = decay;
            blsum += bl; m_prev = bl + Gend;
        };
        if (w == 7) make_vec(0);
#pragma unroll 1
        for (int k = 0; k < nchunks; ++k) {
            const int ci = ci0 + k; const bool meta = (ci == 0); const bool outp = FULL && !meta;
            int tl = tid; asm volatile("" : "+v"(tl));
            const int row0 = meta ? mk::MX : b * mk::SEQ + (ci - 1) * 64;
            LAS float* VEC = (LAS float*)(lds + L_VEC + (k & 1) * VECSET);
            LAS float* NScur = (LAS float*)(lds + L_NS + (k & 1) * 512); LAS float* NSnxt = (LAS float*)(lds + L_NS + ((k + 1) & 1) * 512);
#pragma unroll
            for (int u = 0; u < 2; ++u) { const int id = tid + 512 * u, rr = id >> 4, cp = id & 15;
                *(LAS v4u*)(lds + L_KS + rr * KROW + 16 * cp) = pk[u];
                if (FULL) *(LAS v4u*)(lds + L_QS + rr * QROW + 16 * cp) = pq[u]; }
#pragma unroll
            for (int u = 0; u < 4; ++u) { const int id = tid + 512 * u, rr = id >> 5, cp = id & 31; *(LAS v4u*)(lds + L_VS + rr * VROW + 16 * cp) = pv[u]; }
            __syncthreads();
            if (!FULL && k + 1 < nchunks) issue_loads(ci + 1, tl);
            if (outp) {
#pragma unroll
                for (int u = 0; u < 2; ++u) { const int id = tid + 512 * u, rr = id >> 4, cp = id & 15; const float s = VEC[128 + rr]; const v4u q = pq[u];
                    v4u o; o.x = mk::pk2(mk::bflo(q.x) * s, mk::bfhi(q.x) * s); o.y = mk::pk2(mk::bflo(q.y) * s, mk::bfhi(q.y) * s); o.z = mk::pk2(mk::bflo(q.z) * s, mk::bfhi(q.z) * s); o.w = mk::pk2(mk::bflo(q.w) * s, mk::bfhi(q.w) * s);
                    *(LAS v4u*)(lds + L_QS2 + rr * QROW + 16 * cp) = o; }
            }
            if (outp) {
                const int ti = w >> 1, fr = lane & 15, fq = lane >> 4;
#pragma unroll
                for (int tt = 0; tt < 2; ++tt) { const int tj = 2 * (w & 1) + tt;
                    f32x4 sacc = (f32x4){0.f, 0.f, 0.f, 0.f};
                    if (tj <= ti) {
#pragma unroll
                        for (int kk = 0; kk < 4; ++kk) {
                            const bf16x8 a = *(const LAS bf16x8*)(lds + L_QS + (16 * ti + fr) * QROW + 2 * (32 * kk + 8 * fq));
                            const bf16x8 bb = *(const LAS bf16x8*)(lds + L_KS + (16 * tj + fr) * KROW + 2 * (32 * kk + 8 * fq));
                            sacc = ML_MFMA16(a, bb, sacc);
                        }
                    }
                    const int s = 16 * tj + fr; const float gs = VEC[s];
#pragma unroll
                    for (int i = 0; i < 4; ++i) { const int t = 16 * ti + 4 * fq + i; const float Gt = VEC[64 + t];
                        const float wgt = (s <= t) ? __expf(gs - Gt) : 0.f; const float pv_ = sacc[i] * wgt;
                        *(LAS unsigned short*)(lds + L_PS + t * PROW + 2 * s) = (unsigned short)(mk::pk2(pv_, 0.f) & 0xffffu); }
                }
            }
            __syncthreads();
            if (w == 7 && k + 1 < nchunks) make_vec(k + 1);
            v4u po[4];
            if (outp) {
#pragma unroll
                for (int u = 0; u < 4; ++u) po[u] = *(const v4u*)(SOg + ((size_t)bh * 8192 + (ci - 1) * 64 + (tl >> 3)) * 256 + 32 * (tl & 7) + 8 * u);
            }
            bf16x8 vf[4];
#pragma unroll
            for (int ks = 0; ks < 4; ++ks) vf[ks] = tr_frag(lds + L_VS, VROW, 16 * ks, 32 * w, lane);
            f32x16 Hacc[2];
            if (outp) {
#pragma unroll
                for (int ti = 0; ti < 2; ++ti) {
#pragma unroll
                    for (int g = 0; g < 16; ++g) Hacc[ti][g] = 0.f;
#pragma unroll
                    for (int ks = 0; ks < 4; ++ks) { const bf16x8 a = *(const LAS bf16x8*)(lds + L_PS + (32 * ti + r) * PROW + 2 * (16 * ks + 8 * h5)); Hacc[ti] = ML_MFMA32(a, vf[ks], Hacc[ti]); }
                    asm volatile("" ::: "memory");
                }
#pragma unroll
                for (int i = 0; i < 4; ++i)
#pragma unroll
                    for (int s = 0; s < 2; ++s) {
                        v4u cb; cb.x = mk::pk2(Cacc[i][8 * s], Cacc[i][8 * s + 1]); cb.y = mk::pk2(Cacc[i][8 * s + 2], Cacc[i][8 * s + 3]); cb.z = mk::pk2(Cacc[i][8 * s + 4], Cacc[i][8 * s + 5]); cb.w = mk::pk2(Cacc[i][8 * s + 6], Cacc[i][8 * s + 7]);
                        const bf16x8 bfrag = __builtin_bit_cast(bf16x8, cb);
#pragma unroll
                        for (int ti = 0; ti < 2; ++ti) {
                            const LAS unsigned char* qa = lds + L_QS2 + (32 * ti + r) * QROW + 2 * (32 * i + 16 * s + 4 * h5);
                            const s16x4 lo = *(const LAS s16x4*)qa, hi = *(const LAS s16x4*)(qa + 16);
                            Hacc[ti] = ML_MFMA32(__builtin_shufflevector(lo, hi, 0, 1, 2, 3, 4, 5, 6, 7), bfrag, Hacc[ti]);
                        }
                        asm volatile("" ::: "memory");
                    }
                { const int t = tid >> 3, part = tid & 7;
                  const v4u pr = *(const LAS v4u*)(lds + L_PS + t * PROW + 16 * part);
                  float d = ((mk::bflo(pr.x) + mk::bfhi(pr.x)) + (mk::bflo(pr.y) + mk::bfhi(pr.y))) + ((mk::bflo(pr.z) + mk::bfhi(pr.z)) + (mk::bflo(pr.w) + mk::bfhi(pr.w)));
#pragma unroll
                  for (int u = 0; u < 2; ++u) { const v4u qv = *(const LAS v4u*)(lds + L_QS2 + t * QROW + 32 * part + 16 * u); const LAS float* nn = NScur + 16 * part + 8 * u;
                      d += mk::bflo(qv.x) * nn[0] + mk::bfhi(qv.x) * nn[1] + mk::bflo(qv.y) * nn[2] + mk::bfhi(qv.y) * nn[3] + mk::bflo(qv.z) * nn[4] + mk::bfhi(qv.z) * nn[5] + mk::bflo(qv.w) * nn[6] + mk::bfhi(qv.w) * nn[7]; }
                  d = mk::oct_sum(d);
                  if (part == 0) DEN[t] = d; }
            }
            if (outp) {
#pragma unroll
                for (int ti = 0; ti < 2; ++ti)
#pragma unroll
                    for (int g = 0; g < 16; ++g) *(LAS unsigned short*)(lds + L_HS + (32 * ti + crow(g, h5)) * HROW + 2 * (32 * w + r)) = (unsigned short)(mk::pk2(Hacc[ti][g], 0.f) & 0xffffu);
            }
            if (FULL && k + 1 < nchunks) issue_loads(ci + 1, tl);
            {
                const float decay = VEC[320];
#pragma unroll
                for (int ks = 0; ks < 4; ++ks) { const f32x4 w0 = *(const LAS f32x4*)(VEC + 192 + 16 * ks + 8 * h5), w1 = *(const LAS f32x4*)(VEC + 192 + 16 * ks + 8 * h5 + 4);
                    const v4u x = __builtin_bit_cast(v4u, vf[ks]); v4u o;
                    o.x = mk::pk2(mk::bflo(x.x) * w0.x, mk::bfhi(x.x) * w0.y); o.y = mk::pk2(mk::bflo(x.y) * w0.z, mk::bfhi(x.y) * w0.w);
                    o.z = mk::pk2(mk::bflo(x.z) * w1.x, mk::bfhi(x.z) * w1.y); o.w = mk::pk2(mk::bflo(x.w) * w1.z, mk::bfhi(x.w) * w1.w);
                    vf[ks] = __builtin_bit_cast(bf16x8, o); }
#pragma unroll
                for (int i = 0; i < 4; ++i) {
#pragma unroll
                    for (int g = 0; g < 16; ++g) Cacc[i][g] *= decay;
#pragma unroll
                    for (int ks = 0; ks < 4; ++ks) { const bf16x8 a = tr_frag(lds + L_KS, KROW, 16 * ks, 32 * i, lane); Cacc[i] = ML_MFMA32(a, vf[ks], Cacc[i]); }
                    asm volatile("" ::: "memory");
                }
                if (tid < 128) { float a = decay * NScur[tid];
#pragma unroll 8
                    for (int s = 0; s < 64; ++s) a += VEC[192 + s] * mk::bf2f(*(const LAS unsigned short*)(lds + L_KS + s * KROW + 2 * tid));
                    NSnxt[tid] = a; }
            }
            __syncthreads();
            if (outp) {
                const int t = tl >> 3, part = tl & 7;
                v4u hv[4]; float ss = 0.f;
#pragma unroll
                for (int u = 0; u < 4; ++u) { hv[u] = *(const LAS v4u*)(lds + L_HS + t * HROW + 2 * (32 * part + 8 * u));
                    const float a0 = mk::bflo(hv[u].x), a1 = mk::bfhi(hv[u].x), a2 = mk::bflo(hv[u].y), a3 = mk::bfhi(hv[u].y), a4 = mk::bflo(hv[u].z), a5 = mk::bfhi(hv[u].z), a6 = mk::bflo(hv[u].w), a7 = mk::bfhi(hv[u].w);
                    ss += ((a0 * a0 + a1 * a1) + (a2 * a2 + a3 * a3)) + ((a4 * a4 + a5 * a5) + (a6 * a6 + a7 * a7)); }
                ss = mk::oct_sum(ss);
                const float inv = 1.f / fmaxf(fabsf(DEN[t]), VEC[256 + t]);
                const float sc = inv / sqrtf(inv * inv * ss * (1.f / 256.f) + mk::LN_EPS);
                const float* nw = p.mh_w + hd * 256 + 32 * part; asm volatile("" : "+v"(nw));
                unsigned char* dst = p.ws + mk::WS_YB + (size_t)(row0 + t) * 2048 + hd * 256 + 32 * part;
                unsigned o8[8];
#pragma unroll
                for (int u = 0; u < 4; ++u) { const f32x4 n0 = *(const f32x4*)(nw + 8 * u), n1 = *(const f32x4*)(nw + 8 * u + 4); const v4u so = po[u], hh = hv[u];
                    o8[2 * u] = mk::pk4_fp8(mk::bflo(so.x) * n0.x * sc * mk::bflo(hh.x), mk::bfhi(so.x) * n0.y * sc * mk::bfhi(hh.x), mk::bflo(so.y) * n0.z * sc * mk::bflo(hh.y), mk::bfhi(so.y) * n0.w * sc * mk::bfhi(hh.y));
                    o8[2 * u + 1] = mk::pk4_fp8(mk::bflo(so.z) * n1.x * sc * mk::bflo(hh.z), mk::bfhi(so.z) * n1.y * sc * mk::bfhi(hh.z), mk::bflo(so.w) * n1.z * sc * mk::bflo(hh.w), mk::bfhi(so.w) * n1.w * sc * mk::bfhi(hh.w)); }
                *(v4u*)dst = (v4u){o8[0], o8[1], o8[2], o8[3]}; *(v4u*)(dst + 16) = (v4u){o8[4], o8[5], o8[6], o8[7]};
            }
        }
        if (!FULL) {
            float* dst = STATE + ((size_t)bh * 16 + j) * STATE_F;
#pragma unroll
            for (int i = 0; i < 4; ++i)
#pragma unroll
                for (int g = 0; g < 16; ++g) dst[((w * 4 + i) * 16 + g) * 64 + lane] = Cacc[i][g];
            if (tid < 128) dst[32768 + tid] = ((LAS float*)(lds + L_NS + (nchunks & 1) * 512))[tid];
            if (tid == 448) { MU[bh * 16 + j] = m_prev; BLS[bh * 16 + j] = blsum; }
        }
        __syncthreads();
    }
}
__device__ __forceinline__ void mlstm_combine(const Params& p) {
    float* STATE = (float*)(p.ws + WS_STATE); const float* MU = (const float*)(p.ws + WS_DT); const float* BLS = MU + 256; float* MSTART = (float*)(p.ws + WS_DT) + 512;
    const size_t total = 16 * STATE_F;
    for (size_t e = (size_t)blockIdx.x * 512 + pg8::ftid(); e < total; e += (size_t)gridDim.x * 512) {
        const int bh = (int)(e / STATE_F); const size_t el = e % STATE_F; float c = 0.f, mm = 0.f;
        if (el == 0) MSTART[bh * 16] = 0.f;
        for (int j = 0; j < 15; ++j) {
            const float mu = MU[bh * 16 + j], bls = BLS[bh * 16 + j];
            const float mn = bls + fmaxf(mm, mu - bls);
            const float dj = __expf(mm + bls - mn), sa = __expf(mu - mn);
            float* s = STATE + ((size_t)bh * 16 + j) * STATE_F + el; c = dj * c + sa * (*s); *s = c; mm = mn;
            if (el == 0) MSTART[bh * 16 + j + 1] = mn;
        }
    }
}
}
typedef GAS unsigned gu32;
#define XB_TMO      128
#define XB_XCNT(j)  (256  + 64 * (j))
#define XB_XSUB(j)  (1280 + 64 * (j))
#define XB_XGEN(j)  (2304 + 64 * (j))
#define XB_TOP      3328
#define XB_TOPGEN   3392
#define XCD_BAR_WORDS 3456
#define XB_SPIN_CAP (1u << 18)

__device__ __forceinline__ unsigned xb_ld(unsigned* p)              { return __hip_atomic_load(p, __ATOMIC_RELAXED, __HIP_MEMORY_SCOPE_AGENT); }
__device__ __forceinline__ unsigned xb_add(unsigned* p, unsigned v) { return __hip_atomic_fetch_add(p, v, __ATOMIC_RELAXED, __HIP_MEMORY_SCOPE_AGENT); }
__device__ __forceinline__ unsigned xb_xcc_id() { return (unsigned)__builtin_amdgcn_s_getreg((3 << 11) | 20) & 0xFu; }
#define XB_SPIN(cond, bar) do { unsigned _sp = 0; while (cond) { __builtin_amdgcn_s_sleep(1); \
    if ((++_sp & 255u) == 0u) { if (xb_ld(&(bar)[XB_TMO])) break; if (_sp > XB_SPIN_CAP) { atomicAdd(&(bar)[XB_TMO], 1u); break; } } } } while (0)

struct XcdBarrier {
    unsigned* bar; unsigned x;
    volatile LAS unsigned* st;
};

__device__ __forceinline__ XcdBarrier xcd_barrier_post(unsigned* bar, volatile LAS unsigned* st) {
    XcdBarrier b; b.bar = bar; b.x = xb_xcc_id(); b.st = st;
    if (threadIdx.x == 0) (void)xb_add(&bar[XB_XCNT(b.x)], 1u);
    return b;
}
__device__ __forceinline__ void xcd_barrier_complete(unsigned* bar, unsigned x, unsigned& nloc, unsigned& nx) {
    const unsigned G = gridDim.x * gridDim.y * gridDim.z;
    unsigned sum, cnt, mine, sp = 0u;
    for (;;) {
        sum = 0u; cnt = 0u; mine = 0u;
#pragma unroll 1
        for (unsigned j = 0; j < 16; ++j) { const unsigned c = xb_ld(&bar[XB_XCNT(j)]); sum += c; cnt += (c > 0u) ? 1u : 0u; mine = (j == x) ? c : mine; }
        if (sum == G) break;
        __builtin_amdgcn_s_sleep(1);
        if ((++sp & 255u) == 0u) { if (xb_ld(&bar[XB_TMO])) break; if (sp > XB_SPIN_CAP) { atomicAdd(&bar[XB_TMO], 1u); break; } }
    }
    nloc = mine > 0u ? mine : 1u; nx = cnt > 0u ? cnt : 1u;
}

__device__ __forceinline__ void xcd_barrier(const XcdBarrier& b) {
    asm volatile("s_waitcnt vmcnt(0)" ::: "memory");
    __syncthreads();
    if (threadIdx.x == 0) {
        unsigned* bar = b.bar;
        __builtin_amdgcn_s_waitcnt(0);
        unsigned nloc = b.st[0], nx = b.st[1];
        if (nloc == 0u) { xcd_barrier_complete(bar, b.x, nloc, nx); b.st[0] = nloc; b.st[1] = nx; }
        const unsigned old = xb_add(&bar[XB_XSUB(b.x)], 1u);
        const unsigned gen = old / nloc;
        if (old + 1u == (gen + 1u) * nloc) {
            __builtin_amdgcn_fence(__ATOMIC_RELEASE, "agent");
            asm volatile("s_waitcnt vmcnt(0)" ::: "memory");
            const unsigned og = xb_add(&bar[XB_TOP], 1u);
            const unsigned tg = og / nx;
            if (og + 1u == (tg + 1u) * nx) xb_add(&bar[XB_TOPGEN], 1u);
            else XB_SPIN(xb_ld(&bar[XB_TOPGEN]) == tg, bar);
            __builtin_amdgcn_fence(__ATOMIC_ACQUIRE, "agent");
            xb_add(&bar[XB_XGEN(b.x)], 1u);
            asm volatile("s_waitcnt vmcnt(0)" ::: "memory");
        } else {
            XB_SPIN(xb_ld(&bar[XB_XGEN(b.x)]) == gen, bar);
            __builtin_amdgcn_fence(__ATOMIC_ACQUIRE, "agent");
            asm volatile("s_waitcnt vmcnt(0)" ::: "memory");
        }
    }
    __syncthreads();
}

constexpr int CW_BAR = 4096;
constexpr int LDS_BARST = LDS_BYTES - 64;
static_assert((CW_BAR + XCD_BAR_WORDS) * 4 <= 65536, "barrier words inside the memset region");
__global__ void __launch_bounds__(512, 2) k_fused(Params p) {
    extern __shared__ __attribute__((aligned(16))) unsigned char lds_raw[]; LAS unsigned char* lds = (LAS unsigned char*)lds_raw;
    if (pg8::ftid() < 16) ((LAS unsigned*)(lds + LDS_BARST))[pg8::ftid()] = 0u;
    __syncthreads();
    (void)xcd_barrier_post((unsigned*)(p.ws + WS_CTL) + CW_BAR, (volatile LAS unsigned*)(lds + LDS_BARST));
#define GRID_SYNC() do { XcdBarrier b_; b_.bar = (unsigned*)(p.ws + WS_CTL) + CW_BAR; b_.x = xb_xcc_id(); b_.st = (volatile LAS unsigned*)(lds + LDS_BARST); xcd_barrier(b_); } while (0)
#define MK_REP(bit) for (int rep_ = 0; rep_ < (((MK_PROBE) >> (bit)) & 1) + 1; ++rep_)
    MK_REP(0) { phase0(p, lds); GRID_SYNC(); }
    MK_REP(1) { phase_gemm_in(p, lds); GRID_SYNC(); }
    MK_REP(2) { ml::mlstm_pass<false>(p, lds); } phase_c1c0(p); phase_conv(p); GRID_SYNC();
    ml::mlstm_combine(p); GRID_SYNC();
    MK_REP(8) { ml::mlstm_pass<true>(p, lds); } GRID_SYNC();
    MK_REP(3) { phase_uvconv(p); }
    MK_REP(4) { phase_gemm_g2a(p, lds); phase_gemm_g2b(p, lds); } GRID_SYNC();
    MK_REP(5) { phase_gemm_g3(p, lds); GRID_SYNC(); }
    MK_REP(6) { phase_gemm_pq(p, lds); GRID_SYNC(); }
    if ((MK_PROBE >> 7) & 1) { for (int i = 0; i < 8; ++i) GRID_SYNC(); }
    phase_peer(p, lds);
}
}

extern "C" void kernel_launch(void* const* d_in, const int* in_sizes, int n_in, void* d_out, int out_size, void* d_ws, size_t ws_size, hipStream_t stream) {
    using namespace mk;
    static int grid = 0;
    if (grid == 0) {
        if (n_in != 19 || ws_size < WS_END || out_size != MX * D) { fprintf(stderr, "kernel_launch: unexpected shapes (n_in %d, ws %zu, out %d)\n", n_in, ws_size, out_size); grid = -1; return; }
        if (hipFuncSetAttribute((const void*)k_fused, hipFuncAttributeMaxDynamicSharedMemorySize, LDS_BYTES) != hipSuccess) { fprintf(stderr, "kernel_launch: hipFuncSetAttribute failed\n"); grid = -1; return; }
        int dev = 0, cus = 0, per_cu = 0; (void)hipGetDevice(&dev); (void)hipDeviceGetAttribute(&cus, hipDeviceAttributeMultiprocessorCount, dev);
        if (hipOccupancyMaxActiveBlocksPerMultiprocessor(&per_cu, (const void*)k_fused, 512, LDS_BYTES) != hipSuccess || per_cu < 1) { fprintf(stderr, "kernel_launch: occupancy query says %d blocks per CU\n", per_cu); grid = -1; return; }
        grid = cus;
    }
    if (grid < 0) return;
    Params p{};
    const float** pf = (const float**)&p;
    for (int i = 0; i < 19; ++i) pf[i] = (const float*)d_in[i];
    p.out = (float*)d_out; p.ws = (unsigned char*)d_ws;
    if (hipMemsetAsync((char*)d_ws + WS_CTL, 0, 65536, stream) != hipSuccess) { fprintf(stderr, "kernel_launch: hipMemsetAsync of the barrier words failed\n"); return; }
    hipLaunchKernelGGL(k_fused, dim3(grid), dim3(512), LDS_BYTES, stream, p);
}
```

```cpp
#include <hip/hip_runtime.h>
#include <hip/hip_cooperative_groups.h>
#include <cstdio>
#include <cstdint>
namespace pg8 {
__device__ __forceinline__ int ftid() { int t = threadIdx.x; asm volatile("" : "+v"(t)); return t; }
#define PG8_LAS __attribute__((address_space(3)))
typedef unsigned short bf16_t;
typedef short bf16x8 __attribute__((ext_vector_type(8)));
typedef float f32x4 __attribute__((ext_vector_type(4)));
typedef unsigned u32x4 __attribute__((ext_vector_type(4)));
constexpr int BM = 256, BK = 64, HALF = 128, HTB = HALF * BK * 2  , STAGE_BYTES = 8 * HTB, NXCD = 8, WGM = 8;

__host__ __device__ __forceinline__ int lds_byte(int r, int c) { const int st = (r >> 4) * 2 + (c >> 5), rr = r & 15, cc = c & 31, ob = rr * 64 + cc * 2; return st * 1024 + (ob ^ (((ob >> 9) & 1) << 5)); }
__host__ __device__ __forceinline__ void stage_rc(int b, int& R, int& C) { const int st = b / 1024, sb = b % 1024, swz = sb ^ (((sb >> 9) & 1) << 5); R = (st >> 1) * 16 + swz / 64; C = (st & 1) * 32 + (swz % 64) / 2; }
__host__ __device__ __forceinline__ int perm32(int rho) { const int n = rho >> 4, i = rho & 15; return 8 * (i >> 2) + 4 * n + (i & 3); }

struct Unit { int pm, pn; };
struct Gemm { const bf16_t* A; const bf16_t* Bt; int M, N, K; };

struct StaticOrder {
    int nM, nN, nwg, G, c, wgm;
    __host__ __device__ void init(int M, int N, int G_, int c_, int wgm_ = WGM) { nM = M / BM; nN = N / BM; nwg = nM * nN; G = G_; c = c_; wgm = wgm_; }
    __host__ __device__ bool next(int i, Unit& u) const {
        const long L = (long)i * G + c; if (L >= nwg) return false;
        int wgid = (int)L; { const int q = nwg / NXCD, r = nwg % NXCD, xcd = wgid % NXCD, off = wgid / NXCD; wgid = (xcd < r ? xcd * (q + 1) : r * (q + 1) + (xcd - r) * q) + off; }
        const int nig = wgm * nN, gid = wgid / nig, fm = gid * wgm, gsz = (nM - fm) < wgm ? (nM - fm) : wgm;
        u.pm = fm + ((wgid % nig) % gsz); u.pn = (wgid % nig) / gsz; return true;
    }
    __device__ __forceinline__ void a_ready(const Unit&) const {}
    __device__ __forceinline__ void done(const Unit&) const {}
};

typedef __bf16 bf16x2_t __attribute__((ext_vector_type(2)));
__device__ __forceinline__ unsigned cvt_pk_bf16(float lo, float hi) { bf16x2_t v; v[0] = (__bf16)lo; v[1] = (__bf16)hi; return __builtin_bit_cast(unsigned, v); }
typedef float f32x2 __attribute__((ext_vector_type(2)));
__device__ __forceinline__ f32x2 gelu_pk(f32x2 v) {
    const f32x2 av = __builtin_elementwise_abs(v), d = av * 0.2316418882f + 1.0f;
    f32x2 t; t.x = __builtin_amdgcn_rcpf(d.x); t.y = __builtin_amdgcn_rcpf(d.y);
    f32x2 q = t * 0.5307027145f + (-0.7265760135f); q = q * t + 0.7107068705f; q = q * t + (-0.142248368f); q = q * t + 0.127414796f; q = q * t;
    const f32x2 s = (v * v) * (-0.72134752044f);
    f32x2 e; e.x = __builtin_amdgcn_exp2f(s.x); e.y = __builtin_amdgcn_exp2f(s.y);
    const f32x2 m = v * (q * e), r = v - m;
    f32x2 o; o.x = v.x < 0.f ? m.x : r.x; o.y = v.y < 0.f ? m.y : r.y; return o;
}

template <int ACT  > struct EpiBf16 {
    static constexpr bool PERM = true, AFTER_DRAIN = false; static_assert(ACT == 0 || ACT == 1, "EpiBf16: ACT is 0 (none) or 1 (gelu_pk)");
    bf16_t* O; int ldc; const float* bias; int split_cols; size_t split_stride; float scale0;
    __device__ __forceinline__ void operator()(const f32x4 (&acc)[2][2][4][2], const Unit& u, int wr, int wc, int fr, int fq) const {
        const int row0 = u.pm * BM + wr * 64 + fr; int colt = u.pn * BM; bf16_t* base = O;
        float sc = 1.f; if (split_cols) { const int t = colt / split_cols; base += (size_t)t * split_stride; colt -= t * split_cols; if (t == 0) sc = scale0; }
        const int col0 = colt + wc * 32 + 8 * fq, bcol0 = u.pn * BM + wc * 32 + 8 * fq;
        f32x4 bv[2][2];
#pragma unroll
        for (int bj = 0; bj < 2; ++bj)
#pragma unroll
            for (int n = 0; n < 2; ++n) bv[bj][n] = bias ? *(const f32x4*)(bias + bcol0 + bj * HALF + 4 * n) : (f32x4){0.f, 0.f, 0.f, 0.f};
#pragma unroll
        for (int ai = 0; ai < 2; ++ai)
#pragma unroll
            for (int m = 0; m < 4; ++m) { bf16_t* rowp = base + (size_t)(row0 + ai * HALF + m * 16) * ldc + col0;
#pragma unroll
                for (int bj = 0; bj < 2; ++bj) { f32x4 v0 = acc[ai][bj][m][0] + bv[bj][0], v1 = acc[ai][bj][m][1] + bv[bj][1];
                    if (ACT == 1) { f32x2 a = gelu_pk((f32x2){v0[0], v0[1]}), b = gelu_pk((f32x2){v0[2], v0[3]}), c = gelu_pk((f32x2){v1[0], v1[1]}), d = gelu_pk((f32x2){v1[2], v1[3]});
                        v0 = (f32x4){a.x, a.y, b.x, b.y}; v1 = (f32x4){c.x, c.y, d.x, d.y}; }
                    v0 = v0 * sc; v1 = v1 * sc; u32x4 w; w.x = cvt_pk_bf16(v0[0], v0[1]); w.y = cvt_pk_bf16(v0[2], v0[3]); w.z = cvt_pk_bf16(v1[0], v1[1]); w.w = cvt_pk_bf16(v1[2], v1[3]);
                    *(u32x4*)(rowp + bj * HALF) = w; } }
    }
};
typedef int i32x4 __attribute__((ext_vector_type(4)));
__device__ __forceinline__ const char* sgpr_ptr(const char* p) { const unsigned long long u = (unsigned long long)p; const unsigned lo = __builtin_amdgcn_readfirstlane((unsigned)u), hi = __builtin_amdgcn_readfirstlane((unsigned)(u >> 32)); return (const char*)(((unsigned long long)hi << 32) | lo); }
typedef int i32x8 __attribute__((ext_vector_type(8)));
template <bool FP8> __device__ __forceinline__ f32x4 mma_step(const i32x8& b, const i32x8& a, f32x4 c) {
    if constexpr (FP8) {
        return __builtin_amdgcn_mfma_scale_f32_16x16x128_f8f6f4(b, a, c, 0, 0, 0, 0x79797979, 0, 0x7f7f7f7f);
    } else {
        const bf16x8 b0 = __builtin_bit_cast(bf16x8, (i32x4)__builtin_shufflevector(b, b, 0, 1, 2, 3)), b1 = __builtin_bit_cast(bf16x8, (i32x4)__builtin_shufflevector(b, b, 4, 5, 6, 7));
        const bf16x8 a0 = __builtin_bit_cast(bf16x8, (i32x4)__builtin_shufflevector(a, a, 0, 1, 2, 3)), a1 = __builtin_bit_cast(bf16x8, (i32x4)__builtin_shufflevector(a, a, 4, 5, 6, 7));
        c = __builtin_amdgcn_mfma_f32_16x16x32_bf16(b0, a0, c, 0, 0, 0);
        return __builtin_amdgcn_mfma_f32_16x16x32_bf16(b1, a1, c, 0, 0, 0);
    }
}
template <class Epi, class Sched, bool ALIGN_EPI = false, bool SP2 = false, bool FP8 = false>
__device__ __forceinline__ void gemm_phase(PG8_LAS unsigned char* lds, const Gemm g, const Sched& S, const Epi& E) {
    const int tid = ftid(), wid = __builtin_amdgcn_readfirstlane(tid >> 6), lane = tid & 63, wr = wid >> 2, wc = wid & 3, fr = lane & 15, fq = lane >> 4;
    const int K = g.K, nt = K / BK;
    unsigned voffA, voffB;
    { int R, C; stage_rc(tid * 16, R, C); const int Rb = Epi::PERM ? ((R & ~31) + perm32(R & 31)) : R; voffA = (unsigned)(R * K + C) * 2u; voffB = (unsigned)(Rb * K + C) * 2u; }
    const size_t pstep = (size_t)64 * K * 2;
    const size_t kstep = (size_t)(BK * 2);
    const size_t hstep = (size_t)HALF * K * 2;
    const size_t tstep = 2 * hstep;
    const unsigned ldsw = (unsigned)wid * 1024u;
    const int aoff = lds_byte(wr * 64 + fr, fq * 8), boff = lds_byte(wc * 32 + fr, fq * 8);
#define PG8_SA(b, h) (((b) * 2 + (h)) * HTB)
#define PG8_SB(b, h) ((4 + (b) * 2 + (h)) * HTB)
#define PG8_STAGE(bufoff, gbase, voff) do { _Pragma("unroll") for (int _i = 0; _i < 2; ++_i) { const char* gb_ = sgpr_ptr((const char*)(gbase) + _i * pstep); unsigned vo_ = (voff); asm volatile("" : "+v"(vo_)); \
        __builtin_amdgcn_global_load_lds((const unsigned*)(gb_ + vo_), (PG8_LAS unsigned*)(lds + (bufoff) + ldsw + _i * 8192), 16, 0, 0); } } while (0)
#define PG8_LDA(dst, b, h) do { _Pragma("unroll") for (int m = 0; m < 4; ++m) { const i32x4 lo_ = *(const PG8_LAS i32x4*)(lds + PG8_SA(b, h) + aoff + m * 2048), hi_ = *(const PG8_LAS i32x4*)(lds + PG8_SA(b, h) + aoff + m * 2048 + 1024); dst[m] = __builtin_shufflevector(lo_, hi_, 0, 1, 2, 3, 4, 5, 6, 7); } } while (0)
#define PG8_LDB(dst, b, h) do { _Pragma("unroll") for (int n = 0; n < 2; ++n) { const i32x4 lo_ = *(const PG8_LAS i32x4*)(lds + PG8_SB(b, h) + boff + n * 2048), hi_ = *(const PG8_LAS i32x4*)(lds + PG8_SB(b, h) + boff + n * 2048 + 1024); dst[n] = __builtin_shufflevector(lo_, hi_, 0, 1, 2, 3, 4, 5, 6, 7); } } while (0)
#define PG8_MMA(ai, bj, At, Bt) do { __builtin_amdgcn_s_setprio(1); _Pragma("unroll") for (int m = 0; m < 4; ++m) _Pragma("unroll") for (int n = 0; n < 2; ++n) \
        acc[ai][bj][m][n] = mma_step<FP8>(Bt[n], At[m], acc[ai][bj][m][n]); __builtin_amdgcn_s_setprio(0); } while (0)
#define PG8_WAIT_V(n) asm volatile("s_waitcnt vmcnt(" #n ")" ::: "memory")
#define PG8_WAIT_L(n) asm volatile("s_waitcnt lgkmcnt(" #n ")" ::: "memory")
#define PG8_BAR __builtin_amdgcn_s_barrier()
#define PG8_SCHED __builtin_amdgcn_sched_barrier(0)
    Unit cur, nxt; int ui = 0;
    if (!S.next(0, cur)) return;
    f32x4 acc[2][2][4][2];
#pragma unroll
    for (int a = 0; a < 2; ++a)
#pragma unroll
        for (int b = 0; b < 2; ++b)
#pragma unroll
            for (int m = 0; m < 4; ++m)
#pragma unroll
                for (int n = 0; n < 2; ++n) acc[a][b][m][n] = (f32x4){0.f, 0.f, 0.f, 0.f};
    i32x8 At[4], B0[2], B1[2];
    const char* cA = (const char*)g.A + (size_t)cur.pm * tstep; const char* cB = (const char*)g.Bt + (size_t)cur.pn * tstep;
    S.a_ready(cur);
    if constexpr (SP2) {
        PG8_STAGE(PG8_SB(0, 0), cB, voffB); PG8_STAGE(PG8_SB(0, 1), cB + hstep, voffB); PG8_STAGE(PG8_SA(0, 0), cA, voffA); PG8_STAGE(PG8_SA(0, 1), cA + hstep, voffA);
        if (wr == 1) PG8_BAR;
        PG8_WAIT_V(2); PG8_BAR;
        PG8_STAGE(PG8_SB(1, 0), cB + kstep, voffB); PG8_STAGE(PG8_SA(1, 0), cA + kstep, voffA); PG8_STAGE(PG8_SB(1, 1), cB + hstep + kstep, voffB);
        PG8_WAIT_V(6); PG8_BAR;
    } else {
        PG8_STAGE(PG8_SB(0, 0), cB, voffB); PG8_STAGE(PG8_SA(0, 0), cA, voffA); PG8_STAGE(PG8_SB(0, 1), cB + hstep, voffB); PG8_STAGE(PG8_SA(0, 1), cA + hstep, voffA);
        if (wr == 1) PG8_BAR;
        PG8_WAIT_V(4); PG8_BAR;
        PG8_STAGE(PG8_SB(1, 0), cB + kstep, voffB); PG8_STAGE(PG8_SA(1, 0), cA + kstep, voffA); PG8_STAGE(PG8_SB(1, 1), cB + hstep + kstep, voffB);
        PG8_WAIT_V(6); PG8_BAR;
    }
    for (;;) {
        const bool has_next = S.next(ui + 1, nxt);
        const char* nA = has_next ? (const char*)g.A + (size_t)nxt.pm * tstep : cA; const char* nB = has_next ? (const char*)g.Bt + (size_t)nxt.pn * tstep : cB;
        for (int t = 0; t < nt; t += 2) {
            const bool last = (t == nt - 2);
            const char* a1 = cA + (size_t)(t + 1) * kstep;
            const char* a2 = last ? nA : cA + (size_t)(t + 2) * kstep; const char* b2 = last ? nB : cB + (size_t)(t + 2) * kstep;
            const char* a3 = a2 + kstep; const char* b3 = b2 + kstep;
            if (last && has_next) S.a_ready(nxt);
            if constexpr (SP2) {
            PG8_LDB(B0, 0, 0); PG8_LDB(B1, 0, 1); PG8_SCHED; PG8_LDA(At, 0, 0); PG8_STAGE(PG8_SA(1, 1), a1 + hstep, voffA);
            PG8_WAIT_V(8); PG8_WAIT_L(0); PG8_BAR; PG8_MMA(0, 0, At, B0); PG8_MMA(0, 1, At, B1); PG8_BAR; PG8_SCHED;
            PG8_LDA(At, 0, 1); PG8_STAGE(PG8_SB(0, 0), b2, voffB); PG8_STAGE(PG8_SB(0, 1), b2 + hstep, voffB); PG8_STAGE(PG8_SA(0, 0), a2, voffA);
            PG8_WAIT_V(8); PG8_WAIT_L(0); PG8_BAR; PG8_MMA(1, 0, At, B0); PG8_MMA(1, 1, At, B1); PG8_BAR; PG8_SCHED;
            PG8_LDB(B0, 1, 0); PG8_LDB(B1, 1, 1); PG8_SCHED; PG8_LDA(At, 1, 0); PG8_STAGE(PG8_SA(0, 1), a2 + hstep, voffA);
            PG8_WAIT_V(8); PG8_WAIT_L(0); PG8_BAR; PG8_MMA(0, 0, At, B0); PG8_MMA(0, 1, At, B1); PG8_BAR; PG8_SCHED;
            PG8_LDA(At, 1, 1); PG8_STAGE(PG8_SB(1, 0), b3, voffB); PG8_STAGE(PG8_SB(1, 1), b3 + hstep, voffB); PG8_STAGE(PG8_SA(1, 0), a3, voffA);
            PG8_WAIT_V(8); PG8_WAIT_L(0); PG8_BAR; PG8_MMA(1, 0, At, B0); PG8_MMA(1, 1, At, B1); PG8_BAR; PG8_SCHED;
            } else {
            PG8_LDB(B0, 0, 0); PG8_SCHED; PG8_LDA(At, 0, 0); PG8_STAGE(PG8_SA(1, 1), a1 + hstep, voffA);
            PG8_WAIT_L(8); PG8_BAR; PG8_WAIT_L(0); PG8_MMA(0, 0, At, B0); PG8_BAR; PG8_SCHED;
            PG8_LDB(B1, 0, 1); PG8_STAGE(PG8_SB(0, 0), b2, voffB);
            PG8_BAR; PG8_WAIT_L(0); PG8_MMA(0, 1, At, B1); PG8_BAR;
            PG8_LDA(At, 0, 1); PG8_STAGE(PG8_SA(0, 0), a2, voffA);
            PG8_BAR; PG8_WAIT_L(0); PG8_MMA(1, 0, At, B0); PG8_BAR; PG8_SCHED;
            PG8_STAGE(PG8_SB(0, 1), b2 + hstep, voffB);
            PG8_WAIT_V(6); PG8_BAR; PG8_MMA(1, 1, At, B1); PG8_BAR;
            PG8_LDB(B0, 1, 0); PG8_SCHED; PG8_LDA(At, 1, 0); PG8_STAGE(PG8_SA(0, 1), a2 + hstep, voffA);
            PG8_WAIT_L(8); PG8_BAR; PG8_WAIT_L(0); PG8_MMA(0, 0, At, B0); PG8_BAR; PG8_SCHED;
            PG8_LDB(B1, 1, 1); PG8_STAGE(PG8_SB(1, 0), b3, voffB);
            PG8_BAR; PG8_WAIT_L(0); PG8_MMA(0, 1, At, B1); PG8_BAR;
            PG8_LDA(At, 1, 1); PG8_STAGE(PG8_SA(1, 0), a3, voffA);
            PG8_BAR; PG8_WAIT_L(0); PG8_MMA(1, 0, At, B0); PG8_BAR; PG8_SCHED;
            PG8_STAGE(PG8_SB(1, 1), b3 + hstep, voffB);
            PG8_WAIT_V(6); PG8_BAR; PG8_MMA(1, 1, At, B1); PG8_BAR;
            }
        }
        if constexpr (ALIGN_EPI) { if (wr == 0) PG8_BAR; }
        if constexpr (!Epi::AFTER_DRAIN) { E(acc, cur, wr, wc, fr, fq); S.done(cur); }
        if (!has_next) break;
#pragma unroll
        for (int a = 0; a < 2; ++a)
#pragma unroll
            for (int b = 0; b < 2; ++b)
#pragma unroll
                for (int m = 0; m < 4; ++m)
#pragma unroll
                    for (int n = 0; n < 2; ++n) acc[a][b][m][n] = (f32x4){0.f, 0.f, 0.f, 0.f};
        cur = nxt; cA = nA; cB = nB; ++ui;
        if constexpr (ALIGN_EPI) { if (wr == 1) PG8_BAR; }
    }
    PG8_WAIT_V(0);
    if constexpr (!ALIGN_EPI) { if (wr == 0) PG8_BAR; }
    PG8_BAR;
    if constexpr (Epi::AFTER_DRAIN) { E.fused(acc, cur, wr, wc, fr, fq, lds, wid, lane); S.done(cur); }
#undef PG8_SA
#undef PG8_SB
#undef PG8_STAGE
#undef PG8_LDA
#undef PG8_LDB
#undef PG8_MMA
#undef PG8_WAIT_V
#undef PG8_WAIT_L
#undef PG8_BAR
#undef PG8_SCHED
}
}

#ifndef MK_DBG
#define MK_DBG 0
#endif
#ifndef MK_PROBE
#define MK_PROBE 0
#endif
#ifndef MK_WGM_IN
#define MK_WGM_IN 7
#endif
#ifndef MK_WGM_SQ
#define MK_WGM_SQ 2
#endif
#ifndef MK_ALIGN
#define MK_ALIGN true
#endif
#ifndef MK_SP2
#define MK_SP2 true
#endif
namespace mk {
#define GAS __attribute__((address_space(1)))
#define LAS __attribute__((address_space(3)))
typedef unsigned short bf16;
typedef unsigned v4u __attribute__((ext_vector_type(4)));
typedef unsigned v2u __attribute__((ext_vector_type(2)));
typedef float f32x4 __attribute__((ext_vector_type(4)));
typedef float f32x2 __attribute__((ext_vector_type(2)));

constexpr int D = 2048, MX = 16384, MP = 16640, SEQ = 8192, NMETA = 16;
constexpr int NIN = 16400, NINP = 16640;
constexpr int NH = 8, DQK = 128, DV = 256;
constexpr int LSEQ = SEQ + NMETA;
constexpr float LN_EPS = 1e-5f;
constexpr float ALPHA = 1.189207115002721f;
constexpr float QSCALE = 0.08838834764831845f;

constexpr size_t MiB = 1u << 20;
constexpr size_t WS_CTL = 0, CTL_ZERO_BYTES = 512 * 1024;
constexpr size_t CTL_C1 = 256 * 1024;
constexpr size_t CTL_C0 = 264 * 1024;
constexpr size_t CTL_C1P = 512 * 1024, CTL_C0P = 1024 * 1024;
constexpr size_t WS_GIF = 2 * MiB;
constexpr size_t WS_BT_PA = 4 * MiB, WS_BT_PB = 12 * MiB, WS_BT_WO = 20 * MiB, WS_BT_F = 28 * MiB;
constexpr size_t WS_H0 = 36 * MiB;
constexpr size_t WS_BT_IN = 101 * MiB;
constexpr size_t WS_H0F8 = 101 * MiB;
constexpr size_t WS_BT_IN8 = 133 * MiB + 512 * 1024;
static_assert(WS_H0F8 + (size_t)16640 * 2048 <= WS_BT_IN8 && WS_BT_IN8 + (size_t)16640 * 2048 <= 166 * MiB, "fp8 operand copies");
constexpr size_t WS_UBF = 489 * MiB;
constexpr size_t WS_CB = 166 * MiB;
constexpr size_t WS_R = WS_CB;
constexpr size_t WS_Z = 230 * MiB;
constexpr size_t WS_VBF = 521 * MiB;
constexpr size_t WS_YA8 = WS_BT_IN8;
constexpr size_t WS_YB = WS_Z;
constexpr size_t WS_Q = 295 * MiB;
constexpr size_t WS_K = 327 * MiB;
constexpr size_t WS_TMP = WS_Q;
constexpr size_t WS_V = 360 * MiB;
constexpr size_t WS_SIGO = 425 * MiB;
constexpr size_t WS_MERGED = WS_SIGO;
constexpr size_t WS_END = 553 * MiB;
constexpr size_t OUT_SGA = 0, OUT_SGB = 64 * MiB;

constexpr int LDS_BYTES = 147456;

struct Params {
    const float *x, *meta, *ln0_g, *ln0_b, *w_in, *b_if, *conv_w, *mh_w, *p_a, *p_b, *w_o, *ln1_g, *ln1_b, *peer_wq, *peer_keys, *peer_u, *peer_v, *ln2_g, *ln2_b;
    float* out; unsigned char* ws;
};

__device__ __forceinline__ float bf2f(unsigned u) { return __uint_as_float(u << 16); }
__device__ __forceinline__ float bflo(unsigned w) { return __uint_as_float(w << 16); }
__device__ __forceinline__ float bfhi(unsigned w) { return __uint_as_float(w & 0xffff0000u); }
__device__ __forceinline__ unsigned pk2(float lo, float hi) { return pg8::cvt_pk_bf16(lo, hi); }
template <int CTRL> __device__ __forceinline__ float dpp_f(float v) { return __builtin_bit_cast(float, __builtin_amdgcn_update_dpp(0, __builtin_bit_cast(int, v), CTRL, 0xF, 0xF, true)); }
__device__ __forceinline__ float quad_sum(float v) { v += dpp_f<0xB1>(v); v += dpp_f<0x4E>(v); return v; }
__device__ __forceinline__ float oct_sum(float v) { v = quad_sum(v); v += dpp_f<0x141>(v); return v; }
__device__ __forceinline__ float row16_sum(float v) { v = oct_sum(v); v += dpp_f<0x140>(v); return v; }
__device__ __forceinline__ float wave_sum(float v) {
    v = row16_sum(v);
    const float a = __builtin_bit_cast(float, __builtin_amdgcn_readlane(__builtin_bit_cast(int, v), 0)), b = __builtin_bit_cast(float, __builtin_amdgcn_readlane(__builtin_bit_cast(int, v), 16));
    const float c = __builtin_bit_cast(float, __builtin_amdgcn_readlane(__builtin_bit_cast(int, v), 32)), d = __builtin_bit_cast(float, __builtin_amdgcn_readlane(__builtin_bit_cast(int, v), 48));
    return (a + b) + (c + d);
}
__device__ __forceinline__ float sigmoidf_(float x) { return __builtin_amdgcn_rcpf(1.0f + __expf(-x)); }
#define LDS_WAIT() asm volatile("s_waitcnt lgkmcnt(0)" ::: "memory")

__device__ __forceinline__ int in_dest_row(int n) {
    if (n < 2048) return n;
    if (n < 4096) { const int c = n - 2048; return (8 + (c >> 7)) * 256 + (c & 127); }
    if (n < 6144) { const int c = n - 4096; return (8 + (c >> 7)) * 256 + 128 + (c & 127); }
    if (n < 7168) return 24 * 256 + (n - 6144);
    if (n < 8192) return 28 * 256 + (n - 7168);
    if (n < 10240) return 32 * 256 + (n - 8192);
    if (n < 12288) return 40 * 256 + (n - 10240);
    if (n < 12304) return 64 * 256 + (n - 12288);
    if (n < 14352) return 48 * 256 + (n - 12304);
    return 56 * 256 + (n - 14352);
}
template <bool INMAP>
__device__ __forceinline__ void transpose_item(const float* W, int K, int N, bf16* WT, LAS float* scr, int item, int lane) {
    const int nblk = (N + 31) / 32, kb = item / nblk, nb = item % nblk, k0 = 64 * kb, n0 = 32 * nb;
    const int rr = lane >> 3, c4 = (lane & 7) * 4; const bool ok = (n0 + c4) < N;
    f32x4 v[8];
#pragma unroll
    for (int i = 0; i < 8; ++i) v[i] = ok ? *(const f32x4*)(W + (size_t)(k0 + 8 * i + rr) * N + n0 + c4) : (f32x4){0.f, 0.f, 0.f, 0.f};
#pragma unroll
    for (int i = 0; i < 8; ++i) { LAS float* d = scr + (8 * i + rr) * 33 + c4; d[0] = v[i].x; d[1] = v[i].y; d[2] = v[i].z; d[3] = v[i].w; }
    LDS_WAIT();
    const int c = lane & 7;
#pragma unroll
    for (int j = 0; j < 4; ++j) { const int nl = (lane >> 3) + 8 * j; const int n = n0 + nl; const LAS float* s = scr + (8 * c) * 33 + nl;
        v4u o; o.x = pk2(s[0 * 33], s[1 * 33]); o.y = pk2(s[2 * 33], s[3 * 33]); o.z = pk2(s[4 * 33], s[5 * 33]); o.w = pk2(s[6 * 33], s[7 * 33]);
        if (n < N) { const int dr = INMAP ? in_dest_row(n) : n; *(v4u*)(WT + (size_t)dr * K + k0 + 8 * c) = o; } }
    LDS_WAIT();
}
__device__ __forceinline__ unsigned pk4_fp8(float a, float b, float c, float d) { int w = 0; w = __builtin_amdgcn_cvt_pk_fp8_f32(a, b, w, false); w = __builtin_amdgcn_cvt_pk_fp8_f32(c, d, w, true); return (unsigned)w; }
template <bool INMAP>
__device__ __forceinline__ void transpose_item_fp8(const float* W, int K, int N, unsigned char* WT, LAS float* scr, int item, int lane) {
    const int nblk = (N + 31) / 32, kb = item / nblk, nb = item % nblk, k0 = 128 * kb, n0 = 32 * nb;
    const int rr = lane >> 3, c4 = (lane & 7) * 4; const bool ok = (n0 + c4) < N;
    f32x4 v[16];
#pragma unroll
    for (int i = 0; i < 16; ++i) v[i] = ok ? *(const f32x4*)(W + (size_t)(k0 + 8 * i + rr) * N + n0 + c4) : (f32x4){0.f, 0.f, 0.f, 0.f};
#pragma unroll
    for (int i = 0; i < 16; ++i) { LAS float* d = scr + (8 * i + rr) * 33 + c4; d[0] = v[i].x * 64.f; d[1] = v[i].y * 64.f; d[2] = v[i].z * 64.f; d[3] = v[i].w * 64.f; }
    LDS_WAIT();
    const int c = lane & 7;
#pragma unroll
    for (int j = 0; j < 4; ++j) { const int nl = (lane >> 3) + 8 * j; const int n = n0 + nl; const LAS float* s = scr + (16 * c) * 33 + nl;
        v4u o; o.x = pk4_fp8(s[0 * 33], s[1 * 33], s[2 * 33], s[3 * 33]); o.y = pk4_fp8(s[4 * 33], s[5 * 33], s[6 * 33], s[7 * 33]);
        o.z = pk4_fp8(s[8 * 33], s[9 * 33], s[10 * 33], s[11 * 33]); o.w = pk4_fp8(s[12 * 33], s[13 * 33], s[14 * 33], s[15 * 33]);
        if (n < N) *(v4u*)(WT + (size_t)(INMAP ? in_dest_row(n) : n) * K + k0 + 16 * c) = o; }
    LDS_WAIT();
}
__device__ __forceinline__ void ln0_load(const Params& p, int r, int lane, f32x4 (&v)[8]) {
    if (r >= MX + NMETA) {
#pragma unroll
        for (int j = 0; j < 8; ++j) v[j] = (f32x4){0.f, 0.f, 0.f, 0.f};
        return; }
    const float* src = (r < MX) ? p.x + (size_t)r * D : p.meta + (size_t)(r - MX) * D;
    const f32x4* xr = (const f32x4*)src + lane;
#pragma unroll
    for (int j = 0; j < 8; ++j) v[j] = xr[64 * j];
}
__device__ __forceinline__ void ln0_finish(const Params& p, int r, int lane, f32x4 (&v)[8]) {
    bf16* orow = (bf16*)(p.ws + WS_H0) + (size_t)r * D;
    unsigned long long* o8 = (unsigned long long*)orow + lane;
    unsigned* o4 = (unsigned*)(p.ws + WS_H0F8 + (size_t)r * D) + lane;
    if (r >= MX + NMETA) {
#pragma unroll
        for (int j = 0; j < 8; ++j) { o8[64 * j] = 0ull; o4[64 * j] = 0u; }
        return;
    }
    float s = 0.f;
#pragma unroll
    for (int j = 0; j < 8; ++j) s += (v[j].x + v[j].y) + (v[j].z + v[j].w);
    const float mean = wave_sum(s) * (1.f / D); float s2 = 0.f;
#pragma unroll
    for (int j = 0; j < 8; ++j) { v[j] = v[j] - mean; s2 += (v[j].x * v[j].x + v[j].y * v[j].y) + (v[j].z * v[j].z + v[j].w * v[j].w); }
    const float rstd = 1.f / sqrtf(wave_sum(s2) * (1.f / D) + LN_EPS);
#pragma unroll
    for (int j = 0; j < 8; ++j) {
        const f32x4 g = *((const f32x4*)p.ln0_g + lane + 64 * j), b = *((const f32x4*)p.ln0_b + lane + 64 * j);
        const f32x4 y = v[j] * rstd * g + b;
        o8[64 * j] = (unsigned long long)pk2(y.x, y.y) | ((unsigned long long)pk2(y.z, y.w) << 32);
        o4[64 * j] = pk4_fp8(y.x, y.y, y.z, y.w);
    }
}
typedef float f32x16_ __attribute__((ext_vector_type(16)));
__device__ __forceinline__ void wf_item(const Params& p, int item, int lane) {
    const int hp = item >> 8, dt = (item >> 2) & 63, nt = item & 3, d0 = 32 * dt, n0 = 32 * nt;
    const int i = lane & 31, kk = lane >> 5;
    const f32x4* arow = (const f32x4*)(p.peer_wq + (size_t)(d0 + i) * D + hp * 128);
    const f32x4* brow = (const f32x4*)(p.peer_keys + (size_t)hp * 16384 + (size_t)(n0 + i) * 128);
    f32x16_ acc;
#pragma unroll
    for (int g = 0; g < 16; ++g) acc[g] = 0.f;
#pragma unroll 8
    for (int q = 0; q < 32; ++q) {
        const f32x4 a = arow[q], bb = brow[q];
        acc = __builtin_amdgcn_mfma_f32_32x32x2f32(kk ? a.y : a.x, kk ? bb.y : bb.x, acc, 0, 0, 0);
        acc = __builtin_amdgcn_mfma_f32_32x32x2f32(kk ? a.w : a.z, kk ? bb.w : bb.z, acc, 0, 0, 0);
    }
    const int col = hp * 128 + n0 + i;
    bf16* dst = (bf16*)(p.ws + WS_BT_F) + (size_t)col * D + d0;
    float c1p = 0.f, c0p = 0.f;
#pragma unroll
    for (int gg = 0; gg < 4; ++gg) {
        const int dd = d0 + 8 * gg + 4 * kk;
        const f32x4 g1 = *(const f32x4*)(p.ln1_g + dd), b1 = *(const f32x4*)(p.ln1_b + dd);
        const unsigned lo = pk2(g1.x * acc[4 * gg], g1.y * acc[4 * gg + 1]), hi = pk2(g1.z * acc[4 * gg + 2], g1.w * acc[4 * gg + 3]);
        *(v2u*)(dst + 8 * gg + 4 * kk) = (v2u){lo, hi};
        c1p += (bflo(lo) + bfhi(lo)) + (bflo(hi) + bfhi(hi));
        c0p += (b1.x * acc[4 * gg] + b1.y * acc[4 * gg + 1]) + (b1.z * acc[4 * gg + 2] + b1.w * acc[4 * gg + 3]);
    }
    { const auto r1 = __builtin_amdgcn_permlane32_swap(__float_as_uint(c1p), __float_as_uint(c1p), false, false); c1p = __uint_as_float(r1[0]) + __uint_as_float(r1[1]);
      const auto r0 = __builtin_amdgcn_permlane32_swap(__float_as_uint(c0p), __float_as_uint(c0p), false, false); c0p = __uint_as_float(r0[0]) + __uint_as_float(r0[1]); }
    if (kk == 0) { ((float*)(p.ws + CTL_C1P))[dt * 2048 + col] = c1p; ((float*)(p.ws + CTL_C0P))[dt * 2048 + col] = c0p; }
}
__device__ __forceinline__ void phase0(const Params& p, LAS unsigned char* lds) {
    const int tid = pg8::ftid(), lane = tid & 63, wave = tid >> 6;
    const int gw = blockIdx.x * 8 + wave, NGW = gridDim.x * 8;
    LAS float* scr = (LAS float*)(lds + wave * 16896);
    if (!(wave & 1)) for (int it = gw; it < 4096; it += NGW) wf_item(p, it, lane);
    constexpr int I_IN = 16 * 513, I_SQ8 = 16 * 64;
    for (int rep12_ = 0; rep12_ < (((MK_PROBE) >> 12) & 1) + 1; ++rep12_)
    for (int it = gw; it < I_IN + 3 * I_SQ8; it += NGW) {
        int r = it;
        if (r < I_IN) { transpose_item_fp8<true>(p.w_in, D, NIN, p.ws + WS_BT_IN8, scr, r, lane); continue; } r -= I_IN;
        if (r < I_SQ8) { transpose_item_fp8<false>(p.p_a, D, D, p.ws + WS_BT_PA, scr, r, lane); continue; } r -= I_SQ8;
        if (r < I_SQ8) { transpose_item_fp8<false>(p.p_b, D, D, p.ws + WS_BT_PB, scr, r, lane); continue; } r -= I_SQ8;
        transpose_item_fp8<false>(p.w_o, D, D, p.ws + WS_BT_WO, scr, r, lane);
    }
    for (int r = gw; r < 240; r += NGW) { unsigned long long* o8 = (unsigned long long*)(p.ws + WS_BT_IN8 + (size_t)(64 * 256 + 16 + r) * D) + lane;
#pragma unroll
        for (int j = 0; j < 4; ++j) o8[64 * j] = 0ull; }
    for (int rep13_ = 0; rep13_ < (((MK_PROBE) >> 13) & 1) + 1; ++rep13_) {
        f32x4 va[8], vb[8], vc[8], vd[8];
        int r = gw;
        if (r < MP) ln0_load(p, r, lane, va);
        if (r + NGW < MP) ln0_load(p, r + NGW, lane, vb);
        if (r + 2 * NGW < MP) ln0_load(p, r + 2 * NGW, lane, vc);
        if (r + 3 * NGW < MP) ln0_load(p, r + 3 * NGW, lane, vd);
#pragma unroll 1
        for (; r < MP; r += 4 * NGW) {
            ln0_finish(p, r, lane, va); if (r + 4 * NGW < MP) ln0_load(p, r + 4 * NGW, lane, va);
            if (r + NGW < MP) { ln0_finish(p, r + NGW, lane, vb); if (r + 5 * NGW < MP) ln0_load(p, r + 5 * NGW, lane, vb); }
            if (r + 2 * NGW < MP) { ln0_finish(p, r + 2 * NGW, lane, vc); if (r + 6 * NGW < MP) ln0_load(p, r + 6 * NGW, lane, vc); }
            if (r + 3 * NGW < MP) { ln0_finish(p, r + 3 * NGW, lane, vd); if (r + 7 * NGW < MP) ln0_load(p, r + 7 * NGW, lane, vd); }
        }
    }
    for (int rep14_ = 0; rep14_ < (((MK_PROBE) >> 14) & 1) + 1; ++rep14_)
    if (wave & 1) for (int it = gw; it < 4096; it += NGW) wf_item(p, it, lane);
    (void)tid;
}
typedef float v32f __attribute__((ext_vector_type(32)));
typedef float v16f __attribute__((ext_vector_type(16)));
typedef unsigned v6u __attribute__((ext_vector_type(6)));
constexpr int ROW6 = 1536;
__device__ __forceinline__ void phase_uvconv(const Params& p) {
    const size_t units = (size_t)16384 * 64;
    const size_t gt = (size_t)blockIdx.x * 512 + pg8::ftid(), NT = (size_t)gridDim.x * 512;
    for (int t = 0; t < 2; ++t) {
        const float* src = t ? p.peer_v : p.peer_u; unsigned char* dst = p.ws + (t ? WS_VBF : WS_UBF); const float sc = t ? 2.f : 64.f;
        for (size_t i = gt; i < units; i += NT) {
            const size_t row = i >> 6; const int l = (int)(i & 63);
            const f32x4* s4 = (const f32x4*)(src + row * 2048 + l * 32);
            v16f x0, x1;
#pragma unroll
            for (int q = 0; q < 4; ++q) { const f32x4 a = s4[q] * sc, b = s4[4 + q] * sc; x0[4 * q] = a.x; x0[4 * q + 1] = a.y; x0[4 * q + 2] = a.z; x0[4 * q + 3] = a.w; x1[4 * q] = b.x; x1[4 * q + 1] = b.y; x1[4 * q + 2] = b.z; x1[4 * q + 3] = b.w; }
            const v6u w = __builtin_amdgcn_cvt_scalef32_2xpk16_fp6_f32(x0, x1, 1.0f);
            *(v4u*)(dst + row * ROW6 + l * 16) = (v4u){w[0], w[1], w[2], w[3]};
            *(v2u*)(dst + row * ROW6 + 1024 + l * 8) = (v2u){w[4], w[5]};
        }
    }
}
}

namespace pg8 {
struct EpiInProj {
    static constexpr bool PERM = true, AFTER_DRAIN = false;
    unsigned char* ws; unsigned char* outb;
    __device__ __forceinline__ void operator()(const f32x4 (&acc)[2][2][4][2], const Unit& u, int wr, int wc, int fr, int fq) const {
        bf16_t* const CB = (bf16_t*)(ws + mk::WS_CB); bf16_t* const Z = (bf16_t*)(ws + mk::WS_Z); bf16_t* const Q = (bf16_t*)(ws + mk::WS_Q); bf16_t* const K = (bf16_t*)(ws + mk::WS_K); bf16_t* const V = (bf16_t*)(ws + mk::WS_V);
        bf16_t* const SIGO = (bf16_t*)(ws + mk::WS_SIGO); bf16_t* const SGA = (bf16_t*)(outb + mk::OUT_SGA); bf16_t* const SGB = (bf16_t*)(outb + mk::OUT_SGB); float* const GIF = (float*)(ws + mk::WS_GIF);
        const int pn = u.pn, pm = u.pm; const bool meta = (pm >= 64);
        int row0 = pm * BM + wr * 64 + fr, cl = wc * 32 + 8 * fq;
        asm volatile("" : "+v"(row0), "+v"(cl));
        if (pn >= 8 && pn < 24) {
            bf16_t* base = Z + (size_t)(pn - 8) * 128 + cl;
#pragma unroll
            for (int ai = 0; ai < 2; ++ai)
#pragma unroll
                for (int m = 0; m < 4; ++m) { const f32x4 z0 = acc[ai][0][m][0] * acc[ai][1][m][0], z1 = acc[ai][0][m][1] * acc[ai][1][m][1];
                    u32x4 w; w.x = cvt_pk_bf16(z0[0], z0[1]); w.y = cvt_pk_bf16(z0[2], z0[3]); w.z = cvt_pk_bf16(z1[0], z1[1]); w.w = cvt_pk_bf16(z1[2], z1[3]);
                    *(u32x4*)(base + (size_t)(row0 + ai * HALF + m * 16) * 2048) = w; }
            return;
        }
        if (pn >= 64) {
            if (wc == 0 && fq < 2) {
#pragma unroll
                for (int ai = 0; ai < 2; ++ai)
#pragma unroll
                    for (int m = 0; m < 4; ++m) { float* g = GIF + (size_t)((row0 + ai * HALF + m * 16) * 16 + (cl & 31));     *(f32x4*)g = acc[ai][0][m][0]; *(f32x4*)(g + 4) = acc[ai][0][m][1]; }
            }
            return;
        }
        if (pn < 8) { if (!meta) store<0>(acc, CB, 2048, pn, row0, cl); }
        else if (pn < 28) { if (!meta) store_heads<2, 128>(acc, Q, nullptr, pn - 24, pm, row0, cl); }
        else if (pn < 32) store_heads<0, 128>(acc, K, K + (size_t)16 * 8192 * 128, pn - 28, pm, row0, cl);
        else if (pn < 40) store_heads<0, 256>(acc, V, V + (size_t)16 * 8192 * 256, pn - 32, pm, row0, cl);
        else if (meta) return;
        else if (pn < 48) store_heads<1, 256>(acc, SIGO, nullptr, pn - 40, pm, row0, cl);
        else if (pn < 56) store<1>(acc, SGA, 2048, pn - 48, row0, cl);
        else store<1>(acc, SGB, 2048, pn - 56, row0, cl);
    }
    template <int ACT, int HW> __device__ __forceinline__ void store_heads(const f32x4 (&acc)[2][2][4][2], bf16_t* X, bf16_t* MT, int colt, int pm, int row0, int cl) const {
        const bool meta = pm >= 64; const int b = pm >> 5;
#pragma unroll
        for (int ai = 0; ai < 2; ++ai)
#pragma unroll
            for (int m = 0; m < 4; ++m) { const int row = row0 + ai * HALF + m * 16; const int s = row & 8191, j = row - 16384;
                if (meta && j >= 16) continue;
#pragma unroll
                for (int bj = 0; bj < 2; ++bj) { f32x4 v0 = acc[ai][bj][m][0], v1 = acc[ai][bj][m][1];
                    const int h = (HW == 128) ? 2 * colt + bj : colt, c = (HW == 128) ? cl : bj * HALF + cl;
                    bf16_t* dst = meta ? MT + (size_t)(h * 16 + j) * HW + c : X + ((size_t)(b * 8 + h) * 8192 + s) * HW + c;
                    if (ACT == 1) { asm volatile("" : "+v"(v0), "+v"(v1));
#pragma unroll
                        for (int e = 0; e < 4; ++e) { v0[e] = mk::sigmoidf_(v0[e]); v1[e] = mk::sigmoidf_(v1[e]); } }
                    else if (ACT == 2) { v0 = v0 * mk::QSCALE; v1 = v1 * mk::QSCALE; }
                    u32x4 w; w.x = cvt_pk_bf16(v0[0], v0[1]); w.y = cvt_pk_bf16(v0[2], v0[3]); w.z = cvt_pk_bf16(v1[0], v1[1]); w.w = cvt_pk_bf16(v1[2], v1[3]);
                    *(u32x4*)dst = w;
                    if (ACT == 1) asm volatile("" ::: "memory"); }
                asm volatile("" ::: "memory"); }
    }
    template <int ACT> __device__ __forceinline__ void store(const f32x4 (&acc)[2][2][4][2], bf16_t* base, int ld, int colt, int row0, int cl) const {
        base += (size_t)colt * 256 + cl;
#pragma unroll
        for (int ai = 0; ai < 2; ++ai)
#pragma unroll
            for (int m = 0; m < 4; ++m) { bf16_t* rowp = base + (size_t)(row0 + ai * HALF + m * 16) * ld;
#pragma unroll
                for (int bj = 0; bj < 2; ++bj) { f32x4 v0 = acc[ai][bj][m][0], v1 = acc[ai][bj][m][1];
                    if (ACT == 1) { asm volatile("" : "+v"(v0), "+v"(v1));
#pragma unroll
                        for (int e = 0; e < 4; ++e) { v0[e] = mk::sigmoidf_(v0[e]); v1[e] = mk::sigmoidf_(v1[e]); } }
                    else if (ACT == 2) { v0 = v0 * mk::QSCALE; v1 = v1 * mk::QSCALE; }
                    u32x4 w; w.x = cvt_pk_bf16(v0[0], v0[1]); w.y = cvt_pk_bf16(v0[2], v0[3]); w.z = cvt_pk_bf16(v1[0], v1[1]); w.w = cvt_pk_bf16(v1[2], v1[3]);
                    *(u32x4*)(rowp + bj * HALF) = w;
                    if (ACT == 1) asm volatile("" ::: "memory"); }
                asm volatile("" ::: "memory"); }
    }
};
template <bool SECOND> struct EpiGate {
    static constexpr bool PERM = true, AFTER_DRAIN = false;
    const bf16_t* G; const bf16_t* T; bf16_t* O;
    __device__ __forceinline__ void operator()(const f32x4 (&acc)[2][2][4][2], const Unit& u, int wr, int wc, int fr, int fq) const {
        const int row0 = u.pm * BM + wr * 64 + fr, col0 = u.pn * BM + wc * 32 + 8 * fq;
#pragma unroll
        for (int ai = 0; ai < 2; ++ai)
#pragma unroll
            for (int m = 0; m < 4; ++m) { const size_t ro = (size_t)(row0 + ai * HALF + m * 16) * 2048 + col0;
#pragma unroll
                for (int bj = 0; bj < 2; ++bj) { const size_t off = ro + bj * HALF;
                    const u32x4 g = *(const u32x4*)(G + off); u32x4 t = (u32x4){0u, 0u, 0u, 0u}; if (SECOND) t = *(const u32x4*)(T + off);
                    f32x4 v0 = acc[ai][bj][m][0], v1 = acc[ai][bj][m][1]; float o[8];
                    if ((MK_DBG == 3 && SECOND) || (MK_DBG == 4 && !SECOND)) { v0 = v0 * 0.f; v1 = v1 * 0.f; }
                    o[0] = mk::bflo(g.x) * v0[0] + mk::bflo(t.x); o[1] = mk::bfhi(g.x) * v0[1] + mk::bfhi(t.x);
                    o[2] = mk::bflo(g.y) * v0[2] + mk::bflo(t.y); o[3] = mk::bfhi(g.y) * v0[3] + mk::bfhi(t.y);
                    o[4] = mk::bflo(g.z) * v1[0] + mk::bflo(t.z); o[5] = mk::bfhi(g.z) * v1[1] + mk::bfhi(t.z);
                    o[6] = mk::bflo(g.w) * v1[2] + mk::bflo(t.w); o[7] = mk::bfhi(g.w) * v1[3] + mk::bfhi(t.w);
                    if (SECOND) {
                        typedef unsigned u32x2_ __attribute__((ext_vector_type(2)));
                        *(u32x2_*)((unsigned char*)O + off) = (u32x2_){mk::pk4_fp8(o[0], o[1], o[2], o[3]), mk::pk4_fp8(o[4], o[5], o[6], o[7])};
                    } else {
                        u32x4 w; w.x = cvt_pk_bf16(o[0], o[1]); w.y = cvt_pk_bf16(o[2], o[3]); w.z = cvt_pk_bf16(o[4], o[5]); w.w = cvt_pk_bf16(o[6], o[7]);
                        *(u32x4*)(O + off) = w; } } }
    }
};
struct EpiResid {
    static constexpr bool PERM = true, AFTER_DRAIN = false;
    const bf16_t* H0; bf16_t* R;
    __device__ __forceinline__ void operator()(const f32x4 (&acc)[2][2][4][2], const Unit& u, int wr, int wc, int fr, int fq) const {
        const int row0 = u.pm * BM + wr * 64 + fr, col0 = u.pn * BM + wc * 32 + 8 * fq;
#pragma unroll
        for (int ai = 0; ai < 2; ++ai)
#pragma unroll
            for (int m = 0; m < 4; ++m) { const int row = row0 + ai * HALF + m * 16; const size_t ro = (size_t)row * 2048 + col0;
#pragma unroll
                for (int bj = 0; bj < 2; ++bj) { const size_t off = ro + bj * HALF;
                    const u32x4 h = *(const u32x4*)(H0 + off);
                    f32x4 v0 = acc[ai][bj][m][0], v1 = acc[ai][bj][m][1]; float o[8];
                    if (MK_DBG == 5) { v0 = v0 * 0.f; v1 = v1 * 0.f; }
                    o[0] = mk::ALPHA * mk::bflo(h.x) + v0[0]; o[1] = mk::ALPHA * mk::bfhi(h.x) + v0[1];
                    o[2] = mk::ALPHA * mk::bflo(h.y) + v0[2]; o[3] = mk::ALPHA * mk::bfhi(h.y) + v0[3];
                    o[4] = mk::ALPHA * mk::bflo(h.z) + v1[0]; o[5] = mk::ALPHA * mk::bfhi(h.z) + v1[1];
                    o[6] = mk::ALPHA * mk::bflo(h.w) + v1[2]; o[7] = mk::ALPHA * mk::bfhi(h.w) + v1[3];
                    u32x4 w; w.x = cvt_pk_bf16(o[0], o[1]); w.y = cvt_pk_bf16(o[2], o[3]); w.z = cvt_pk_bf16(o[4], o[5]); w.w = cvt_pk_bf16(o[6], o[7]);
                    *(u32x4*)(R + off) = w; } }
    }
};
struct EpiScores {
    static constexpr bool PERM = false, AFTER_DRAIN = false;
    float* S;
    __device__ __forceinline__ void operator()(const f32x4 (&acc)[2][2][4][2], const Unit& u, int wr, int wc, int fr, int fq) const {
        const int row0 = u.pm * BM + wr * 64 + fr, col0 = u.pn * BM + wc * 32 + 4 * fq;
#pragma unroll
        for (int ai = 0; ai < 2; ++ai)
#pragma unroll
            for (int m = 0; m < 4; ++m) { float* rowp = S + (size_t)(row0 + ai * HALF + m * 16) * 2048 + col0;
#pragma unroll
                for (int bj = 0; bj < 2; ++bj)
#pragma unroll
                    for (int n = 0; n < 2; ++n) *(f32x4*)(rowp + bj * HALF + n * 16) = acc[ai][bj][m][n]; }
    }
};
}

namespace mk {
__device__ __forceinline__ void phase_c1c0(const Params& p) {
    const int gt = blockIdx.x * 512 + pg8::ftid();
    if (gt < 4096) { const int col = gt & 2047; const float* src = (const float*)(p.ws + (gt < 2048 ? CTL_C1P : CTL_C0P)); float a = 0.f;
        for (int i = 0; i < 64; ++i) a += src[i * 2048 + col];
        ((float*)(p.ws + (gt < 2048 ? CTL_C1 : CTL_C0)))[col] = a; }
}
constexpr int CONV_SLICES = 1024 * 256 * 4;
__device__ __forceinline__ void conv_issue(const Params& p, int s, v4u& zm2, v4u& zm1, v4u (&z)[4], v4u (&cb)[4]) {
    const bf16* CB = (const bf16*)(p.ws + WS_CB); const bf16* Z = (const bf16*)(p.ws + WS_Z);
    const int it = s & 262143, qq = s >> 18, c0 = (it & 255) * 8, r0 = (it >> 8) * 16 + 4 * qq;
    const bool first = (r0 & (SEQ - 1)) == 0;
    zm2 = *(const v4u*)(Z + (size_t)(first ? MX + 14 : r0 - 2) * D + c0);
    zm1 = *(const v4u*)(Z + (size_t)(first ? MX + 15 : r0 - 1) * D + c0);
#pragma unroll
    for (int i = 0; i < 4; ++i) { const size_t off = (size_t)(r0 + i) * D + c0; z[i] = *(const v4u*)(Z + off); cb[i] = *(const v4u*)(CB + off); }
}
__device__ __forceinline__ void conv_finish(const Params& p, int s, v4u zm2, v4u zm1, const v4u (&zz)[4], const v4u (&cbb)[4]) {
    const int it = s & 262143, qq = s >> 18, c0 = (it & 255) * 8, r0 = (it >> 8) * 16 + 4 * qq;
    const float* cw = p.conv_w + c0; asm volatile("" : "+v"(cw));
    float w0[8], w1[8], w2[8];
    { const f32x4 a0 = *(const f32x4*)cw, a1 = *(const f32x4*)(cw + 4), b0 = *(const f32x4*)(cw + 2048), b1 = *(const f32x4*)(cw + 2052), d0 = *(const f32x4*)(cw + 4096), d1 = *(const f32x4*)(cw + 4100);
#pragma unroll
      for (int e = 0; e < 4; ++e) { w0[e] = a0[e]; w0[4 + e] = a1[e]; w1[e] = b0[e]; w1[4 + e] = b1[e]; w2[e] = d0[e]; w2[4 + e] = d1[e]; } }
#pragma unroll
    for (int i = 0; i < 4; ++i) {
        const size_t off = (size_t)(r0 + i) * D + c0;
        const v4u z = zz[i], cb = cbb[i];
        float y[8];
        y[0] = bflo(cb.x) * (w0[0] * bflo(zm2.x) + w1[0] * bflo(zm1.x) + w2[0] * bflo(z.x)); y[1] = bfhi(cb.x) * (w0[1] * bfhi(zm2.x) + w1[1] * bfhi(zm1.x) + w2[1] * bfhi(z.x));
        y[2] = bflo(cb.y) * (w0[2] * bflo(zm2.y) + w1[2] * bflo(zm1.y) + w2[2] * bflo(z.y)); y[3] = bfhi(cb.y) * (w0[3] * bfhi(zm2.y) + w1[3] * bfhi(zm1.y) + w2[3] * bfhi(z.y));
        y[4] = bflo(cb.z) * (w0[4] * bflo(zm2.z) + w1[4] * bflo(zm1.z) + w2[4] * bflo(z.z)); y[5] = bfhi(cb.z) * (w0[5] * bfhi(zm2.z) + w1[5] * bfhi(zm1.z) + w2[5] * bfhi(z.z));
        y[6] = bflo(cb.w) * (w0[6] * bflo(zm2.w) + w1[6] * bflo(zm1.w) + w2[6] * bflo(z.w)); y[7] = bfhi(cb.w) * (w0[7] * bfhi(zm2.w) + w1[7] * bfhi(zm1.w) + w2[7] * bfhi(z.w));
        *(v2u*)(p.ws + WS_YA8 + off) = (v2u){pk4_fp8(y[0], y[1], y[2], y[3]), pk4_fp8(y[4], y[5], y[6], y[7])};
        zm2 = zm1; zm1 = z;
    }
}
__device__ __forceinline__ void phase_conv(const Params& p) {
    bf16* CB = (bf16*)(p.ws + WS_CB); const bf16* Z = (const bf16*)(p.ws + WS_Z);
    const int gt = blockIdx.x * 512 + pg8::ftid(), NT = gridDim.x * 512;
    for (int it = gt; it < 1024 * 256; it += NT) {
        const int cg = it & 255, rb = it >> 8, c0 = cg * 8, r0 = rb * 16;
        float w0[8], w1[8], w2[8];
#pragma unroll
        for (int e = 0; e < 8; ++e) { w0[e] = p.conv_w[c0 + e]; w1[e] = p.conv_w[2048 + c0 + e]; w2[e] = p.conv_w[4096 + c0 + e]; }
        const bool first = (r0 & (SEQ - 1)) == 0;
        v4u zm2 = *(const v4u*)(Z + (size_t)(first ? MX + 14 : r0 - 2) * D + c0);
        v4u zm1 = *(const v4u*)(Z + (size_t)(first ? MX + 15 : r0 - 1) * D + c0);
#pragma unroll 4
        for (int i = 0; i < 16; ++i) {
            const size_t off = (size_t)(r0 + i) * D + c0;
            const v4u z = *(const v4u*)(Z + off), cb = *(const v4u*)(CB + off);
            float y[8];
            y[0] = bflo(cb.x) * (w0[0] * bflo(zm2.x) + w1[0] * bflo(zm1.x) + w2[0] * bflo(z.x)); y[1] = bfhi(cb.x) * (w0[1] * bfhi(zm2.x) + w1[1] * bfhi(zm1.x) + w2[1] * bfhi(z.x));
            y[2] = bflo(cb.y) * (w0[2] * bflo(zm2.y) + w1[2] * bflo(zm1.y) + w2[2] * bflo(z.y)); y[3] = bfhi(cb.y) * (w0[3] * bfhi(zm2.y) + w1[3] * bfhi(zm1.y) + w2[3] * bfhi(z.y));
            y[4] = bflo(cb.z) * (w0[4] * bflo(zm2.z) + w1[4] * bflo(zm1.z) + w2[4] * bflo(z.z)); y[5] = bfhi(cb.z) * (w0[5] * bfhi(zm2.z) + w1[5] * bfhi(zm1.z) + w2[5] * bfhi(z.z));
            y[6] = bflo(cb.w) * (w0[6] * bflo(zm2.w) + w1[6] * bflo(zm1.w) + w2[6] * bflo(z.w)); y[7] = bfhi(cb.w) * (w0[7] * bfhi(zm2.w) + w1[7] * bfhi(zm1.w) + w2[7] * bfhi(z.w));
            *(v2u*)(p.ws + WS_YA8 + off) = (v2u){pk4_fp8(y[0], y[1], y[2], y[3]), pk4_fp8(y[4], y[5], y[6], y[7])};
            zm2 = zm1; zm1 = z;
        }
    }
}

constexpr float U_SCALE = 64.f, V_SCALE = 2.f;
#ifndef MK_FP6_ORDER
#define MK_FP6_ORDER 1
#endif
__device__ __forceinline__ float gelu_exact(float a) { return 0.5f * a * (1.f + erff(a * 0.70710678118654752f)); }
__device__ __forceinline__ void ce_desc(unsigned& a, unsigned& b) { const unsigned hi = a > b ? a : b, lo = a > b ? b : a; a = hi; b = lo; }
__device__ __forceinline__ void merge16_desc(unsigned (&v)[16]) {
#pragma unroll
    for (int j = 8; j > 0; j >>= 1)
#pragma unroll
        for (int i = 0; i < 16; ++i) { const int l = i ^ j; if (l > i) ce_desc(v[i], v[l]); }
}
__device__ __forceinline__ void sort16_desc(unsigned (&v)[16]) {
#pragma unroll
    for (int k = 2; k <= 16; k <<= 1)
#pragma unroll
        for (int j = k >> 1; j > 0; j >>= 1)
#pragma unroll
            for (int i = 0; i < 16; ++i) { const int l = i ^ j; if (l > i) { if ((i & k) == 0) ce_desc(v[i], v[l]); else ce_desc(v[l], v[i]); } }
}
__device__ __forceinline__ float key_val(unsigned k) { const unsigned m = k & 0xFFFFFF80u; return __uint_as_float((m & 0x80000000u) ? (m & 0x7FFFFFFFu) : ~m); }
__device__ __forceinline__ void phase_peer(const Params& p, LAS unsigned char* lds) {
    const int tid = pg8::ftid(), lane0 = tid & 63, wave = tid >> 6;
    LAS unsigned* K1 = (LAS unsigned*)(lds + wave * 4096);
    LAS unsigned* K2 = (LAS unsigned*)(lds + wave * 4096 + 1024);
    LAS int* Ei = (LAS int*)(lds + wave * 4096 + 3072);
    LAS float* Eg = (LAS float*)(lds + wave * 4096 + 3584);
    LAS float* PAR = (LAS float*)(lds + 32768);
    {
        const float* C1g = (const float*)(p.ws + CTL_C1); const float* C0g = (const float*)(p.ws + CTL_C0);
        for (int i = tid; i < 2048; i += 512) { PAR[i] = p.ln1_g[i]; PAR[2048 + i] = p.ln1_b[i]; PAR[4096 + i] = p.ln2_g[i]; PAR[6144 + i] = p.ln2_b[i]; PAR[8192 + i] = C1g[i]; PAR[10240 + i] = C0g[i]; }
    }
    __syncthreads();
    unsigned ciw = 0u, cjw = 0u;
    { const int sub0 = lane0 & 7; int c = 0; for (int i = 0; i < 16; ++i) { const int nj = 16 / (i + 1); for (int j = 0; j < nj; ++j) { if ((c & 7) == sub0) { ciw |= (unsigned)i << (4 * (c >> 3)); cjw |= (unsigned)j << (4 * (c >> 3)); } ++c; } } }
    const bf16* R = (const bf16*)(p.ws + WS_R);
    const unsigned char* U6 = p.ws + WS_UBF; const unsigned char* V6 = p.ws + WS_VBF;
    float* SC = p.out;
    const int gw = blockIdx.x * 8 + wave, NGW = gridDim.x * 8;
#pragma unroll 1
    for (int r = gw; r < MX; r += NGW) {
        int lane = lane0; asm volatile("" : "+v"(lane));
        const int qd = lane & 3, qbase = lane & ~3;
        float mu, rstd;
        v4u rw_[4];
        {
            v4u (&w)[4] = rw_; float s1 = 0.f;
#pragma unroll
            for (int q = 0; q < 4; ++q) { w[q] = *(const v4u*)(R + (size_t)r * D + lane * 32 + q * 8);
                s1 += ((bflo(w[q].x) + bfhi(w[q].x)) + (bflo(w[q].y) + bfhi(w[q].y))) + ((bflo(w[q].z) + bfhi(w[q].z)) + (bflo(w[q].w) + bfhi(w[q].w))); }
            mu = wave_sum(s1) * (1.f / D); float s2 = 0.f;
#pragma unroll
            for (int q = 0; q < 4; ++q) { const float d0 = bflo(w[q].x) - mu, d1 = bfhi(w[q].x) - mu, d2 = bflo(w[q].y) - mu, d3 = bfhi(w[q].y) - mu, d4 = bflo(w[q].z) - mu, d5 = bfhi(w[q].z) - mu, d6 = bflo(w[q].w) - mu, d7 = bfhi(w[q].w) - mu;
                s2 += ((d0 * d0 + d1 * d1) + (d2 * d2 + d3 * d3)) + ((d4 * d4 + d5 * d5) + (d6 * d6 + d7 * d7)); }
            rstd = 1.f / sqrtf(wave_sum(s2) * (1.f / D) + LN_EPS);
        }
        for (int rep11_ = 0; rep11_ < (((MK_PROBE) >> 11) & 1) + 1; ++rep11_) {
        {
            unsigned v[32];
#pragma unroll
            for (int i = 0; i < 8; ++i) { const f32x4 t = *(const f32x4*)(SC + (size_t)r * D + lane * 32 + 4 * i);
                const f32x4 a1 = *(const LAS f32x4*)(PAR + 8192 + lane * 32 + 4 * i), a0 = *(const LAS f32x4*)(PAR + 10240 + lane * 32 + 4 * i);
                const f32x4 y = (t - a1 * mu) * rstd + a0;
#pragma unroll
                for (int c = 0; c < 4; ++c) { const unsigned u = __float_as_uint(y[c]); const unsigned mono = (u & 0x80000000u) ? ~u : (u | 0x80000000u);
                    v[4 * i + c] = (mono & 0xFFFFFF80u) | (unsigned)(127 - (qd * 32 + 4 * i + c)); } }
            unsigned A[16], B[16];
#pragma unroll
            for (int i = 0; i < 16; ++i) { A[i] = v[i]; B[i] = v[16 + i]; }
            sort16_desc(A); sort16_desc(B);
#pragma unroll
            for (int i = 0; i < 16; ++i) A[i] = A[i] > B[15 - i] ? A[i] : B[15 - i];
            merge16_desc(A);
#pragma unroll
            for (int i = 0; i < 16; ++i) B[i] = (unsigned)__builtin_amdgcn_update_dpp(0, (int)A[15 - i], 0xB1, 0xF, 0xF, true);
#pragma unroll
            for (int i = 0; i < 16; ++i) A[i] = A[i] > B[i] ? A[i] : B[i];
            merge16_desc(A);
#pragma unroll
            for (int i = 0; i < 16; ++i) B[i] = (unsigned)__builtin_amdgcn_update_dpp(0, (int)A[15 - i], 0x4E, 0xF, 0xF, true);
#pragma unroll
            for (int i = 0; i < 16; ++i) A[i] = A[i] > B[i] ? A[i] : B[i];
            merge16_desc(A);
            const int g = lane >> 2;
            const unsigned w0 = qd == 0 ? A[0] : qd == 1 ? A[4] : qd == 2 ? A[8] : A[12], w1 = qd == 0 ? A[1] : qd == 1 ? A[5] : qd == 2 ? A[9] : A[13];
            const unsigned w2 = qd == 0 ? A[2] : qd == 1 ? A[6] : qd == 2 ? A[10] : A[14], w3 = qd == 0 ? A[3] : qd == 1 ? A[7] : qd == 2 ? A[11] : A[15];
            *(LAS v4u*)(K1 + g * 16 + 4 * qd) = (v4u){w0, w1, w2, w3};
        }
        LDS_WAIT();
        {
            const int hh = lane >> 3, sub = lane & 7;
            float sa[7]; int ea[7]; unsigned ka[7];
#pragma unroll
            for (int a = 0; a < 7; ++a) { const int ci_ = (ciw >> (4 * a)) & 15, cj_ = (cjw >> (4 * a)) & 15; const bool ok = (sub + 8 * a) < 50;
                const unsigned k0 = K1[(2 * hh) * 16 + ci_], k1 = K1[(2 * hh + 1) * 16 + cj_];
                const float s = key_val(k0) + key_val(k1);
                sa[a] = s; ea[a] = (127 - (int)(k0 & 127u)) * 128 + (127 - (int)(k1 & 127u));
                const unsigned u = __float_as_uint(s); const unsigned mono = (u & 0x80000000u) ? ~u : (u | 0x80000000u);
                ka[a] = ok ? ((mono & 0xFFFFFFC0u) | (unsigned)(63 - (sub + 8 * a))) : 0u;
                K2[hh * 64 + sub + 8 * a] = ka[a]; }
            if (sub == 0) K2[hh * 64 + 56] = 0u;
            LDS_WAIT();
            int rk[7];
#pragma unroll
            for (int a = 0; a < 7; ++a) rk[a] = 0;
#pragma unroll
            for (int q = 0; q < 14; ++q) { const v4u kb = *(const LAS v4u*)(K2 + hh * 64 + 4 * q);
#pragma unroll
                for (int a = 0; a < 7; ++a) rk[a] += (kb.x > ka[a] ? 1 : 0) + (kb.y > ka[a] ? 1 : 0) + (kb.z > ka[a] ? 1 : 0) + (kb.w > ka[a] ? 1 : 0); }
            const float smax = key_val(K1[(2 * hh) * 16]) + key_val(K1[(2 * hh + 1) * 16]);
            float ex[7]; float part = 0.f;
#pragma unroll
            for (int a = 0; a < 7; ++a) { const bool sel = ka[a] != 0u && rk[a] < 16; ex[a] = sel ? __expf(sa[a] - smax) : 0.f; part += ex[a]; }
            part += __builtin_bit_cast(float, __builtin_amdgcn_update_dpp(0, __builtin_bit_cast(int, part), 0xB1, 0xF, 0xF, true));
            part += __builtin_bit_cast(float, __builtin_amdgcn_update_dpp(0, __builtin_bit_cast(int, part), 0x4E, 0xF, 0xF, true));
            part += __builtin_bit_cast(float, __builtin_amdgcn_update_dpp(0, __builtin_bit_cast(int, part), 0x141, 0xF, 0xF, true));
            const float inv = 1.f / part;
#pragma unroll
            for (int a = 0; a < 7; ++a) if (ka[a] != 0u && rk[a] < 16) { Ei[hh * 16 + rk[a]] = ea[a]; Eg[hh * 16 + rk[a]] = ex[a] * inv; }
        }
        LDS_WAIT();
        }
        v32f x;
        {
            float xl[32];
#pragma unroll
            for (int q = 0; q < 4; ++q) {
                const int e0 = lane * 32 + q * 8;
                const v4u w = rw_[q];
                const f32x4 g0 = *(const LAS f32x4*)(PAR + e0), g1 = *(const LAS f32x4*)(PAR + e0 + 4), b0 = *(const LAS f32x4*)(PAR + 2048 + e0), b1 = *(const LAS f32x4*)(PAR + 2048 + e0 + 4);
                xl[8 * q + 0] = (bflo(w.x) - mu) * rstd * g0.x + b0.x; xl[8 * q + 1] = (bfhi(w.x) - mu) * rstd * g0.y + b0.y;
                xl[8 * q + 2] = (bflo(w.y) - mu) * rstd * g0.z + b0.z; xl[8 * q + 3] = (bfhi(w.y) - mu) * rstd * g0.w + b0.w;
                xl[8 * q + 4] = (bflo(w.z) - mu) * rstd * g1.x + b1.x; xl[8 * q + 5] = (bfhi(w.z) - mu) * rstd * g1.y + b1.y;
                xl[8 * q + 6] = (bflo(w.w) - mu) * rstd * g1.z + b1.z; xl[8 * q + 7] = (bfhi(w.w) - mu) * rstd * g1.w + b1.w;
            }
#pragma unroll
            for (int i = 0; i < 32; ++i) x[MK_FP6_ORDER ? ((i & 15) * 2 + (i >> 4)) : i] = xl[i];
        }
        {
            auto loadu = [&](v6u (&w)[4], int e0) {
#pragma unroll
                for (int k = 0; k < 4; ++k) { const int id = __builtin_amdgcn_readfirstlane(Ei[e0 + k]) & 16383; const unsigned char* up = U6 + (size_t)id * ROW6;
                    const v4u a = *(const v4u*)(up + lane * 16); const v2u b = *(const v2u*)(up + 1024 + lane * 8); w[k] = (v6u){a.x, a.y, a.z, a.w, b.x, b.y}; }
            };
            auto compu = [&](const v6u (&w)[4], int e0) {
                float s[4];
#pragma unroll
                for (int k = 0; k < 4; ++k) { const v32f y = __builtin_amdgcn_cvt_scalef32_pk32_f32_fp6(w[k], 1.0f); f32x2 a = (f32x2){0.f, 0.f};
#pragma unroll
                    for (int i = 0; i < 16; ++i) a += (f32x2){y[2 * i], y[2 * i + 1]} * (f32x2){x[2 * i], x[2 * i + 1]};
                    s[k] = a.x + a.y; }
                float u1;
                { const auto r02 = __builtin_amdgcn_permlane32_swap(__float_as_uint(s[0]), __float_as_uint(s[2]), false, false);
                  const auto r13 = __builtin_amdgcn_permlane32_swap(__float_as_uint(s[1]), __float_as_uint(s[3]), false, false);
                  const float a02 = __uint_as_float(r02[0]) + __uint_as_float(r02[1]), a13 = __uint_as_float(r13[0]) + __uint_as_float(r13[1]);
                  const auto rr = __builtin_amdgcn_permlane16_swap(__float_as_uint(a02), __float_as_uint(a13), false, false);
                  u1 = row16_sum(__uint_as_float(rr[0]) + __uint_as_float(rr[1])); }
                if ((lane & 15) == 0) { const int k = lane >> 4; Eg[e0 + k] = Eg[e0 + k] * gelu_exact(u1 * (1.f / U_SCALE)) * (1.f / V_SCALE); }
            };
            v6u wa[4], wb[4], wc[4];
            loadu(wa, 0); loadu(wb, 4);
#pragma unroll 1
            for (int e0 = 0; e0 < 120; e0 += 12) {
                loadu(wc, e0 + 8);
                compu(wa, e0);
                loadu(wa, e0 + 12);
                compu(wb, e0 + 4);
                loadu(wb, e0 + 16);
                compu(wc, e0 + 8);
            }
            compu(wa, 120); compu(wb, 124);
        }
        LDS_WAIT();
        v32f o;
#pragma unroll
        for (int i = 0; i < 32; ++i) o[i] = 0.f;
        {
            auto loadv = [&](v6u (&w)[4], int e0) {
#pragma unroll
                for (int k = 0; k < 4; ++k) { const int id = __builtin_amdgcn_readfirstlane(Ei[e0 + k]) & 16383; const unsigned char* vp = V6 + (size_t)id * ROW6;
                    const v4u a = *(const v4u*)(vp + lane * 16); const v2u b = *(const v2u*)(vp + 1024 + lane * 8); w[k] = (v6u){a.x, a.y, a.z, a.w, b.x, b.y}; }
            };
            auto compv = [&](const v6u (&w)[4], int e0) {
#pragma unroll
                for (int k = 0; k < 4; ++k) { const float wt = Eg[e0 + k]; const v32f y = __builtin_amdgcn_cvt_scalef32_pk32_f32_fp6(w[k], 1.0f); o += y * wt; }
            };
            v6u wa[4], wb[4], wc[4];
            loadv(wa, 0); loadv(wb, 4);
#pragma unroll 1
            for (int e0 = 0; e0 < 120; e0 += 12) {
                loadv(wc, e0 + 8);
                compv(wa, e0);
                loadv(wa, e0 + 12);
                compv(wb, e0 + 4);
                loadv(wb, e0 + 16);
                compv(wc, e0 + 8);
            }
            compv(wa, 120); compv(wb, 124);
        }
        float s1 = 0.f;
#pragma unroll
        for (int i = 0; i < 32; ++i) { o[i] = x[i] * ALPHA + o[i]; s1 += o[i]; }
        const float mean = wave_sum(s1) * (1.f / D); float s2 = 0.f;
#pragma unroll
        for (int i = 0; i < 32; ++i) { o[i] = o[i] - mean; s2 += o[i] * o[i]; }
        const float rstd2 = 1.f / sqrtf(wave_sum(s2) * (1.f / D) + LN_EPS);
#pragma unroll
        for (int q = 0; q < 8; ++q) {
            const int e0 = lane * 32 + q * 4;
            const f32x4 g = *(const LAS f32x4*)(PAR + 4096 + e0), bb = *(const LAS f32x4*)(PAR + 6144 + e0);
            float oo[4];
#pragma unroll
            for (int c = 0; c < 4; ++c) { const int i = q * 4 + c; oo[c] = o[MK_FP6_ORDER ? ((i & 15) * 2 + (i >> 4)) : i]; }
            f32x4 y; y.x = oo[0] * rstd2 * g.x + bb.x; y.y = oo[1] * rstd2 * g.y + bb.y; y.z = oo[2] * rstd2 * g.z + bb.z; y.w = oo[3] * rstd2 * g.w + bb.w;
            *(f32x4*)(p.out + (size_t)r * D + e0) = y;
        }
    }
}

__device__ __forceinline__ void phase_gemm_in(const Params& p, LAS unsigned char* lds) {
    pg8::Gemm g{(const bf16*)(p.ws + WS_H0F8), (const bf16*)(p.ws + WS_BT_IN8), MP, NINP, D / 2};
    pg8::StaticOrder S; S.init(MP, NINP, gridDim.x, blockIdx.x, MK_WGM_IN);
    pg8::EpiInProj E{p.ws, (unsigned char*)p.out};
    pg8::gemm_phase<pg8::EpiInProj, pg8::StaticOrder, true, true, true>(lds, g, S, E);
}
__device__ __forceinline__ void phase_gemm_g2a(const Params& p, LAS unsigned char* lds) {
    pg8::Gemm g{(const bf16*)(p.ws + WS_YA8), (const bf16*)(p.ws + WS_BT_PA), MX, D, D / 2};
    pg8::StaticOrder S; S.init(MX, D, gridDim.x, blockIdx.x, MK_WGM_SQ);
    pg8::EpiGate<false> E{(const bf16*)(MK_DBG == 16 ? p.ws + WS_H0 : MK_DBG == 14 ? p.ws + 489 * MiB : (unsigned char*)p.out + OUT_SGA), nullptr, (bf16*)(p.ws + WS_TMP)};
    pg8::gemm_phase<pg8::EpiGate<false>, pg8::StaticOrder, MK_ALIGN, MK_SP2, true>(lds, g, S, E);
}
__device__ __forceinline__ void phase_gemm_g2b(const Params& p, LAS unsigned char* lds) {
    pg8::Gemm g{(const bf16*)(p.ws + WS_YB), (const bf16*)(p.ws + WS_BT_PB), MX, D, D / 2};
    pg8::StaticOrder S; S.init(MX, D, gridDim.x, blockIdx.x, MK_WGM_SQ);
    pg8::EpiGate<true> E{(const bf16*)((unsigned char*)p.out + OUT_SGB), (const bf16*)(p.ws + WS_TMP), (bf16*)(p.ws + WS_MERGED)};
    pg8::gemm_phase<pg8::EpiGate<true>, pg8::StaticOrder, MK_ALIGN, MK_SP2, true>(lds, g, S, E);
}
__device__ __forceinline__ void phase_gemm_g3(const Params& p, LAS unsigned char* lds) {
    pg8::Gemm g{(const bf16*)(p.ws + WS_MERGED), (const bf16*)(p.ws + WS_BT_WO), MX, D, D / 2};
    pg8::StaticOrder S; S.init(MX, D, gridDim.x, blockIdx.x, MK_WGM_SQ);
    pg8::EpiResid E{(const bf16*)(p.ws + WS_H0), (bf16*)(p.ws + WS_R)};
    pg8::gemm_phase<pg8::EpiResid, pg8::StaticOrder, MK_ALIGN, MK_SP2, true>(lds, g, S, E);
}
__device__ __forceinline__ void phase_gemm_pq(const Params& p, LAS unsigned char* lds) {
    pg8::Gemm g{(const bf16*)(p.ws + WS_R), (const bf16*)(p.ws + WS_BT_F), MX, D, D};
    pg8::StaticOrder S; S.init(MX, D, gridDim.x, blockIdx.x, MK_WGM_SQ);
    pg8::EpiScores E{p.out};
    pg8::gemm_phase<pg8::EpiScores, pg8::StaticOrder, MK_ALIGN, MK_SP2>(lds, g, S, E);
}


namespace ml {
typedef short s16x4 __attribute__((ext_vector_type(4)));
typedef short bf16x8 __attribute__((ext_vector_type(8)));
typedef float f32x16 __attribute__((ext_vector_type(16)));
using mk::v4u; using mk::f32x4; using mk::bf16; using mk::Params;
constexpr int QROW = 272, KROW = 320, VROW = 576, PROW = 144, HROW = 528;
constexpr int L_QS = 0, L_QS2 = L_QS + 64 * QROW, L_KS = L_QS2 + 64 * QROW, L_VS = L_KS + 64 * KROW, L_PS = L_VS + 64 * VROW, L_HS = L_PS + 64 * PROW;
constexpr int L_VEC = L_HS + 64 * HROW;
constexpr int VECSET = 6 * 256;
constexpr int L_NS = L_VEC + 2 * VECSET;
constexpr int L_DEN = L_NS + 1024;
constexpr int L_TAB = L_DEN + 256;
constexpr int L_END = L_TAB + 1088;
static_assert(L_END <= mk::LDS_BYTES, "mLSTM LDS map");
constexpr size_t STATE_F = 32768 + 128;
constexpr size_t WS_STATE = mk::WS_BT_IN;
constexpr size_t WS_DT = mk::WS_BT_IN + 16 * 16 * STATE_F * 4;
static_assert(WS_DT + 1024 <= mk::WS_CB, "state region");

__device__ __forceinline__ int crow(int reg, int h) { return (reg & 3) + 8 * (reg >> 2) + 4 * h; }
__device__ __forceinline__ float scan_add(float v, int lane) {
#pragma unroll
    for (int o = 1; o < 64; o <<= 1) { const float t = __shfl_up(v, o); if (lane >= o) v += t; }
    return v;
}
__device__ __forceinline__ float scan_max(float v, int lane) {
#pragma unroll
    for (int o = 1; o < 64; o <<= 1) { const float t = __shfl_up(v, o); if (lane >= o) v = fmaxf(v, t); }
    return v;
}
__device__ __forceinline__ float wave_max(float v) {
#pragma unroll
    for (int o = 1; o < 64; o <<= 1) v = fmaxf(v, __shfl_xor(v, o));
    return v;
}
__device__ __forceinline__ void gate_load(const Params& p, int b, int hd, int ci, int lane, float& ip, float& fp) {
    const float* GIF = (const float*)(p.ws + mk::WS_GIF);
    const int row = (ci == 0) ? mk::MX + (lane & 15) : b * mk::SEQ + (ci - 1) * 64 + lane;
    ip = GIF[(size_t)row * 16 + hd]; fp = GIF[(size_t)row * 16 + 8 + hd];
}
__device__ __forceinline__ void gate_math(const Params& p, int hd, int ci, int lane, float ip, float fp, float& li, float& lf) {
    const bool pad = (ci == 0) && lane >= 16;
    ip += p.b_if[hd]; fp += p.b_if[8 + hd];
    li = pad ? -1e30f : ip;
    lf = pad ? 0.f : (fminf(fp, 0.f) - log1pf(__expf(-fabsf(fp))));
}
__device__ __forceinline__ bf16x8 tr_frag(LAS unsigned char* tile, int rowstride, int k0, int n0, int lane) {
    const int h = lane >> 5, blk = (lane >> 4) & 1, q = (lane & 15) >> 2, pp = lane & 3;
    LAS unsigned char* a = tile + (k0 + 8 * h + q) * rowstride + 2 * (n0 + 16 * blk + 4 * pp);
    const s16x4 lo = __builtin_amdgcn_ds_read_tr16_b64_v4i16((LAS s16x4*)a);
    const s16x4 hi = __builtin_amdgcn_ds_read_tr16_b64_v4i16((LAS s16x4*)(a + 4 * rowstride));
    return __builtin_shufflevector(lo, hi, 0, 1, 2, 3, 4, 5, 6, 7);
}
#define ML_MFMA32(a, b, c) __builtin_amdgcn_mfma_f32_32x32x16_bf16((a), (b), (c), 0, 0, 0)
#define ML_MFMA16(a, b, c) __builtin_amdgcn_mfma_f32_16x16x32_bf16((a), (b), (c), 0, 0, 0)

template <bool FULL>
__device__ __forceinline__ void mlstm_pass(const Params& p, LAS unsigned char* lds) {
    const int tid = pg8::ftid(), lane = tid & 63, w = __builtin_amdgcn_readfirstlane(tid >> 6);
    const int r = lane & 31, h5 = lane >> 5;
    const bf16* Qg = (const bf16*)(p.ws + mk::WS_Q); const bf16* Kg = (const bf16*)(p.ws + mk::WS_K); bf16* Vg = (bf16*)(p.ws + mk::WS_V);
    const bf16* SOg = (const bf16*)(p.ws + mk::WS_SIGO);
    float* STATE = (float*)(p.ws + WS_STATE); float* MU = (float*)(p.ws + WS_DT); float* BLS = MU + 256; const float* MSTART = MU + 512;
    LAS float* DEN = (LAS float*)(lds + L_DEN);
    int kc = 0;
    const int cgt = blockIdx.x * 512 + tid, cNT = gridDim.x * 512;
    for (int item = blockIdx.x; item < 256; item += gridDim.x) {
        const int bh = item >> 4, j = item & 15, b = bh >> 3, hd = bh & 7;
        const int nchunks = (j == 0) ? 9 : 8, ci0 = (j == 0) ? 0 : 8 * j + 1;
        float m_prev = FULL ? MSTART[bh * 16 + j] : -INFINITY;
        float blsum = 0.f;
        f32x16 Cacc[4];
        if (FULL && j > 0) {
            const float* src = STATE + ((size_t)bh * 16 + (j - 1)) * STATE_F;
#pragma unroll
            for (int i = 0; i < 4; ++i)
#pragma unroll
                for (int g = 0; g < 16; ++g) Cacc[i][g] = src[((w * 4 + i) * 16 + g) * 64 + lane];
            if (tid < 128) ((LAS float*)(lds + L_NS))[tid] = src[32768 + tid];
        } else {
#pragma unroll
            for (int i = 0; i < 4; ++i)
#pragma unroll
                for (int g = 0; g < 16; ++g) Cacc[i][g] = 0.f;
            if (tid < 128) ((LAS float*)(lds + L_NS))[tid] = 0.f;
        }
        v4u pq[2], pk[2], pv[4];
        auto issue_loads = [&](int ci, int tl) {
            const bool meta = (ci == 0);
            const bf16* kb = meta ? Kg + (size_t)16 * 8192 * 128 + (size_t)hd * 16 * 128 : Kg + ((size_t)bh * 8192 + (ci - 1) * 64) * 128;
            const bf16* vb = meta ? Vg + (size_t)16 * 8192 * 256 + (size_t)hd * 16 * 256 : Vg + ((size_t)bh * 8192 + (ci - 1) * 64) * 256;
            const bf16* qb = Qg + ((size_t)bh * 8192 + (meta ? 0 : (ci - 1) * 64)) * 128;
#pragma unroll
            for (int u = 0; u < 2; ++u) { const int id = tl + 512 * u, rr = id >> 4;
                const bool ok = !meta || rr < 16;
                pk[u] = ok ? *(const v4u*)(kb + (size_t)id * 8) : (v4u){0u, 0u, 0u, 0u};
                if (FULL) pq[u] = !meta ? *(const v4u*)(qb + (size_t)id * 8) : (v4u){0u, 0u, 0u, 0u}; }
#pragma unroll
            for (int u = 0; u < 4; ++u) { const int id = tl + 512 * u, rr = id >> 5;
                const bool ok = !meta || rr < 16;
                pv[u] = ok ? *(const v4u*)(vb + (size_t)id * 8) : (v4u){0u, 0u, 0u, 0u}; }
        };
        { int tl = tid; asm volatile("" : "+v"(tl)); issue_loads(ci0, tl); }
        float gip = 0.f, gfp = 0.f; if (w == 7) gate_load(p, b, hd, ci0, lane, gip, gfp);
        auto make_vec = [&](int kk) {
            const int cix = ci0 + kk;
            LAS float* VS_ = (LAS float*)(lds + L_VEC + (kk & 1) * VECSET);
            float li, lf; gate_math(p, hd, cix, lane, gip, gfp, li, lf);
            if (kk + 1 < nchunks) gate_load(p, b, hd, cix + 1, lane, gip, gfp);
            const float bb = scan_add(lf, lane); const float g = li - bb; const float G = fmaxf(m_prev, scan_max(g, lane));
            const float Gend = __shfl(G, 63), bl = __shfl(bb, 63);
            VS_[lane] = g; VS_[64 + lane] = G; VS_[128 + lane] = __expf(m_prev - G); VS_[192 + lane] = __expf(g - Gend); VS_[256 + lane] = __expf(-(bb + G));
            const float decay = __expf(m_prev - Gend);
            if (lane == 0) VS_[320] = decay;
            blsum += bl; m_prev = bl + Gend;
        };
        if (w == 7) make_vec(0);
#pragma unroll 1
        for (int k = 0; k < nchunks; ++k) {
            const int ci = ci0 + k; const bool meta = (ci == 0); const bool outp = FULL && !meta;
            int tl = tid; asm volatile("" : "+v"(tl));
            const int row0 = meta ? mk::MX : b * mk::SEQ + (ci - 1) * 64;
            LAS float* VEC = (LAS float*)(lds + L_VEC + (k & 1) * VECSET);
            LAS float* NScur = (LAS float*)(lds + L_NS + (k & 1) * 512); LAS float* NSnxt = (LAS float*)(lds + L_NS + ((k + 1) & 1) * 512);
#pragma unroll
            for (int u = 0; u < 2; ++u) { const int id = tid + 512 * u, rr = id >> 4, cp = id & 15;
                *(LAS v4u*)(lds + L_KS + rr * KROW + 16 * cp) = pk[u];
                if (FULL) *(LAS v4u*)(lds + L_QS + rr * QROW + 16 * cp) = pq[u]; }
#pragma unroll
            for (int u = 0; u < 4; ++u) { const int id = tid + 512 * u, rr = id >> 5, cp = id & 31; *(LAS v4u*)(lds + L_VS + rr * VROW + 16 * cp) = pv[u]; }
            __syncthreads();
            if (!FULL && k + 1 < nchunks) issue_loads(ci + 1, tl);
            v4u czm2 = {0u, 0u, 0u, 0u}, czm1 = {0u, 0u, 0u, 0u}, cz[4], ccb[4]; int cs = -1;
            if (!FULL) { const int s_ = tl - tid + cgt + cNT * kc; if (k < 8 && s_ < mk::CONV_SLICES) { cs = s_; mk::conv_issue(p, cs, czm2, czm1, cz, ccb); ++kc; } }
            if (outp) {
#pragma unroll
                for (int u = 0; u < 2; ++u) { const int id = tid + 512 * u, rr = id >> 4, cp = id & 15; const float s = VEC[128 + rr]; const v4u q = pq[u];
                    v4u o; o.x = mk::pk2(mk::bflo(q.x) * s, mk::bfhi(q.x) * s); o.y = mk::pk2(mk::bflo(q.y) * s, mk::bfhi(q.y) * s); o.z = mk::pk2(mk::bflo(q.z) * s, mk::bfhi(q.z) * s); o.w = mk::pk2(mk::bflo(q.w) * s, mk::bfhi(q.w) * s);
                    *(LAS v4u*)(lds + L_QS2 + rr * QROW + 16 * cp) = o; }
            }
            if (outp) {
                const int ti = w >> 1, fr = lane & 15, fq = lane >> 4;
#pragma unroll
                for (int tt = 0; tt < 2; ++tt) { const int tj = 2 * (w & 1) + tt;
                    f32x4 sacc = (f32x4){0.f, 0.f, 0.f, 0.f};
                    if (tj <= ti) {
#pragma unroll
                        for (int kk = 0; kk < 4; ++kk) {
                            const bf16x8 a = *(const LAS bf16x8*)(lds + L_QS + (16 * ti + fr) * QROW + 2 * (32 * kk + 8 * fq));
                            const bf16x8 bb = *(const LAS bf16x8*)(lds + L_KS + (16 * tj + fr) * KROW + 2 * (32 * kk + 8 * fq));
                            sacc = ML_MFMA16(a, bb, sacc);
                        }
                    }
                    const int s = 16 * tj + fr; const float gs = VEC[s];
#pragma unroll
                    for (int i = 0; i < 4; ++i) { const int t = 16 * ti + 4 * fq + i; const float Gt = VEC[64 + t];
                        const float wgt = (s <= t) ? __expf(gs - Gt) : 0.f; const float pv_ = sacc[i] * wgt;
                        *(LAS unsigned short*)(lds + L_PS + t * PROW + 2 * s) = (unsigned short)(mk::pk2(pv_, 0.f) & 0xffffu); }
                }
            }
            __syncthreads();
            if (w == 7 && k + 1 < nchunks) make_vec(k + 1);
            v4u po[4];
            if (outp) {
#pragma unroll
                for (int u = 0; u < 4; ++u) po[u] = *(const v4u*)(SOg + ((size_t)bh * 8192 + (ci - 1) * 64 + (tl >> 3)) * 256 + 32 * (tl & 7) + 8 * u);
            }
            bf16x8 vf[4];
#pragma unroll
            for (int ks = 0; ks < 4; ++ks) vf[ks] = tr_frag(lds + L_VS, VROW, 16 * ks, 32 * w, lane);
            f32x16 Hacc[2];
            if (outp) {
#pragma unroll
                for (int ti = 0; ti < 2; ++ti) {
#pragma unroll
                    for (int g = 0; g < 16; ++g) Hacc[ti][g] = 0.f;
#pragma unroll
                    for (int ks = 0; ks < 4; ++ks) { const bf16x8 a = *(const LAS bf16x8*)(lds + L_PS + (32 * ti + r) * PROW + 2 * (16 * ks + 8 * h5)); Hacc[ti] = ML_MFMA32(a, vf[ks], Hacc[ti]); }
                    asm volatile("" ::: "memory");
                }
#pragma unroll
                for (int i = 0; i < 4; ++i)
#pragma unroll
                    for (int s = 0; s < 2; ++s) {
                        v4u cb; cb.x = mk::pk2(Cacc[i][8 * s], Cacc[i][8 * s + 1]); cb.y = mk::pk2(Cacc[i][8 * s + 2], Cacc[i][8 * s + 3]); cb.z = mk::pk2(Cacc[i][8 * s + 4], Cacc[i][8 * s + 5]); cb.w = mk::pk2(Cacc[i][8 * s + 6], Cacc[i][8 * s + 7]);
                        const bf16x8 bfrag = __builtin_bit_cast(bf16x8, cb);
#pragma unroll
                        for (int ti = 0; ti < 2; ++ti) {
                            const LAS unsigned char* qa = lds + L_QS2 + (32 * ti + r) * QROW + 2 * (32 * i + 16 * s + 4 * h5);
                            const s16x4 lo = *(const LAS s16x4*)qa, hi = *(const LAS s16x4*)(qa + 16);
                            Hacc[ti] = ML_MFMA32(__builtin_shufflevector(lo, hi, 0, 1, 2, 3, 4, 5, 6, 7), bfrag, Hacc[ti]);
                        }
                        asm volatile("" ::: "memory");
                    }
                { const int t = tid >> 3, part = tid & 7;
                  const v4u pr = *(const LAS v4u*)(lds + L_PS + t * PROW + 16 * part);
                  float d = ((mk::bflo(pr.x) + mk::bfhi(pr.x)) + (mk::bflo(pr.y) + mk::bfhi(pr.y))) + ((mk::bflo(pr.z) + mk::bfhi(pr.z)) + (mk::bflo(pr.w) + mk::bfhi(pr.w)));
#pragma unroll
                  for (int u = 0; u < 2; ++u) { const v4u qv = *(const LAS v4u*)(lds + L_QS2 + t * QROW + 32 * part + 16 * u); const LAS float* nn = NScur + 16 * part + 8 * u;
                      d += mk::bflo(qv.x) * nn[0] + mk::bfhi(qv.x) * nn[1] + mk::bflo(qv.y) * nn[2] + mk::bfhi(qv.y) * nn[3] + mk::bflo(qv.z) * nn[4] + mk::bfhi(qv.z) * nn[5] + mk::bflo(qv.w) * nn[6] + mk::bfhi(qv.w) * nn[7]; }
                  d = mk::oct_sum(d);
                  if (part == 0) DEN[t] = d; }
            }
            if (outp) {
#pragma unroll
                for (int ti = 0; ti < 2; ++ti)
#pragma unroll
                    for (int g = 0; g < 16; ++g) *(LAS unsigned short*)(lds + L_HS + (32 * ti + crow(g, h5)) * HROW + 2 * (32 * w + r)) = (unsigned short)(mk::pk2(Hacc[ti][g], 0.f) & 0xffffu);
            }
            if (FULL && k + 1 < nchunks) issue_loads(ci + 1, tl);
            {
                const float decay = VEC[320];
#pragma unroll
                for (int ks = 0; ks < 4; ++ks) { const f32x4 w0 = *(const LAS f32x4*)(VEC + 192 + 16 * ks + 8 * h5), w1 = *(const LAS f32x4*)(VEC + 192 + 16 * ks + 8 * h5 + 4);
                    const v4u x = __builtin_bit_cast(v4u, vf[ks]); v4u o;
                    o.x = mk::pk2(mk::bflo(x.x) * w0.x, mk::bfhi(x.x) * w0.y); o.y = mk::pk2(mk::bflo(x.y) * w0.z, mk::bfhi(x.y) * w0.w);
                    o.z = mk::pk2(mk::bflo(x.z) * w1.x, mk::bfhi(x.z) * w1.y); o.w = mk::pk2(mk::bflo(x.w) * w1.z, mk::bfhi(x.w) * w1.w);
                    vf[ks] = __builtin_bit_cast(bf16x8, o); }
#pragma unroll
                for (int i = 0; i < 4; ++i) {
#pragma unroll
                    for (int g = 0; g < 16; ++g) Cacc[i][g] *= decay;
#pragma unroll
                    for (int ks = 0; ks < 4; ++ks) { const bf16x8 a = tr_frag(lds + L_KS, KROW, 16 * ks, 32 * i, lane); Cacc[i] = ML_MFMA32(a, vf[ks], Cacc[i]); }
                    asm volatile("" ::: "memory");
                }
                if (tid < 128) { float a = decay * NScur[tid];
#pragma unroll 8
                    for (int s = 0; s < 64; ++s) a += VEC[192 + s] * mk::bf2f(*(const LAS unsigned short*)(lds + L_KS + s * KROW + 2 * tid));
                    NSnxt[tid] = a; }
            }
            if (!FULL) { if (cs >= 0) mk::conv_finish(p, cs, czm2, czm1, cz, ccb); }
            __syncthreads();
            if (outp) {
                const int t = tl >> 3, part = tl & 7;
                v4u hv[4]; float ss = 0.f;
#pragma unroll
                for (int u = 0; u < 4; ++u) { hv[u] = *(const LAS v4u*)(lds + L_HS + t * HROW + 2 * (32 * part + 8 * u));
                    const float a0 = mk::bflo(hv[u].x), a1 = mk::bfhi(hv[u].x), a2 = mk::bflo(hv[u].y), a3 = mk::bfhi(hv[u].y), a4 = mk::bflo(hv[u].z), a5 = mk::bfhi(hv[u].z), a6 = mk::bflo(hv[u].w), a7 = mk::bfhi(hv[u].w);
                    ss += ((a0 * a0 + a1 * a1) + (a2 * a2 + a3 * a3)) + ((a4 * a4 + a5 * a5) + (a6 * a6 + a7 * a7)); }
                ss = mk::oct_sum(ss);
                const float inv = 1.f / fmaxf(fabsf(DEN[t]), VEC[256 + t]);
                const float sc = inv / sqrtf(inv * inv * ss * (1.f / 256.f) + mk::LN_EPS);
                const float* nw = p.mh_w + hd * 256 + 32 * part; asm volatile("" : "+v"(nw));
                unsigned char* dst = p.ws + mk::WS_YB + (size_t)(row0 + t) * 2048 + hd * 256 + 32 * part;
                unsigned o8[8];
#pragma unroll
                for (int u = 0; u < 4; ++u) { const f32x4 n0 = *(const f32x4*)(nw + 8 * u), n1 = *(const f32x4*)(nw + 8 * u + 4); const v4u so = po[u], hh = hv[u];
                    o8[2 * u] = mk::pk4_fp8(mk::bflo(so.x) * n0.x * sc * mk::bflo(hh.x), mk::bfhi(so.x) * n0.y * sc * mk::bfhi(hh.x), mk::bflo(so.y) * n0.z * sc * mk::bflo(hh.y), mk::bfhi(so.y) * n0.w * sc * mk::bfhi(hh.y));
                    o8[2 * u + 1] = mk::pk4_fp8(mk::bflo(so.z) * n1.x * sc * mk::bflo(hh.z), mk::bfhi(so.z) * n1.y * sc * mk::bfhi(hh.z), mk::bflo(so.w) * n1.z * sc * mk::bflo(hh.w), mk::bfhi(so.w) * n1.w * sc * mk::bfhi(hh.w)); }
                *(v4u*)dst = (v4u){o8[0], o8[1], o8[2], o8[3]}; *(v4u*)(dst + 16) = (v4u){o8[4], o8[5], o8[6], o8[7]};
            }
        }
        if (!FULL) {
            float* dst = STATE + ((size_t)bh * 16 + j) * STATE_F;
#pragma unroll
            for (int i = 0; i < 4; ++i)
#pragma unroll
                for (int g = 0; g < 16; ++g) dst[((w * 4 + i) * 16 + g) * 64 + lane] = Cacc[i][g];
            if (tid < 128) dst[32768 + tid] = ((LAS float*)(lds + L_NS + (nchunks & 1) * 512))[tid];
            if (tid == 448) { MU[bh * 16 + j] = m_prev; BLS[bh * 16 + j] = blsum; }
        }
        __syncthreads();
    }
    if (!FULL) {
#pragma unroll 1
        for (;; ++kc) { const long long s_ = (long long)cgt + (long long)cNT * kc; if (s_ >= mk::CONV_SLICES) break;
            v4u czm2, czm1, cz[4], ccb[4]; mk::conv_issue(p, (int)s_, czm2, czm1, cz, ccb); mk::conv_finish(p, (int)s_, czm2, czm1, cz, ccb); }
    }
}
__device__ __forceinline__ void mlstm_combine(const Params& p) {
    float* STATE = (float*)(p.ws + WS_STATE); const float* MU = (const float*)(p.ws + WS_DT); const float* BLS = MU + 256; float* MSTART = (float*)(p.ws + WS_DT) + 512;
    const size_t total = 16 * STATE_F;
    for (size_t e = (size_t)blockIdx.x * 512 + pg8::ftid(); e < total; e += (size_t)gridDim.x * 512) {
        const int bh = (int)(e / STATE_F); const size_t el = e % STATE_F; float c = 0.f, mm = 0.f;
        if (el == 0) MSTART[bh * 16] = 0.f;
        for (int j = 0; j < 15; ++j) {
            const float mu = MU[bh * 16 + j], bls = BLS[bh * 16 + j];
            const float mn = bls + fmaxf(mm, mu - bls);
            const float dj = __expf(mm + bls - mn), sa = __expf(mu - mn);
            float* s = STATE + ((size_t)bh * 16 + j) * STATE_F + el; c = dj * c + sa * (*s); *s = c; mm = mn;
            if (el == 0) MSTART[bh * 16 + j + 1] = mn;
        }
    }
}
}
typedef GAS unsigned gu32;
#define XB_TMO      128
#define XB_XCNT(j)  (256  + 64 * (j))
#define XB_XSUB(j)  (1280 + 64 * (j))
#define XB_XGEN(j)  (2304 + 64 * (j))
#define XB_TOP      3328
#define XB_TOPGEN   3392
#define XCD_BAR_WORDS 3456
#define XB_SPIN_CAP (1u << 18)

__device__ __forceinline__ unsigned xb_ld(unsigned* p)              { return __hip_atomic_load(p, __ATOMIC_RELAXED, __HIP_MEMORY_SCOPE_AGENT); }
__device__ __forceinline__ unsigned xb_add(unsigned* p, unsigned v) { return __hip_atomic_fetch_add(p, v, __ATOMIC_RELAXED, __HIP_MEMORY_SCOPE_AGENT); }
__device__ __forceinline__ unsigned xb_xcc_id() { return (unsigned)__builtin_amdgcn_s_getreg((3 << 11) | 20) & 0xFu; }
#define XB_SPIN(cond, bar) do { unsigned _sp = 0; while (cond) { __builtin_amdgcn_s_sleep(1); \
    if ((++_sp & 255u) == 0u) { if (xb_ld(&(bar)[XB_TMO])) break; if (_sp > XB_SPIN_CAP) { atomicAdd(&(bar)[XB_TMO], 1u); break; } } } } while (0)

struct XcdBarrier {
    unsigned* bar; unsigned x;
    volatile LAS unsigned* st;
};

__device__ __forceinline__ XcdBarrier xcd_barrier_post(unsigned* bar, volatile LAS unsigned* st) {
    XcdBarrier b; b.bar = bar; b.x = xb_xcc_id(); b.st = st;
    if (threadIdx.x == 0) (void)xb_add(&bar[XB_XCNT(b.x)], 1u);
    return b;
}
__device__ __forceinline__ void xcd_barrier_complete(unsigned* bar, unsigned x, unsigned& nloc, unsigned& nx) {
    const unsigned G = gridDim.x * gridDim.y * gridDim.z;
    unsigned sum, cnt, mine, sp = 0u;
    for (;;) {
        sum = 0u; cnt = 0u; mine = 0u;
#pragma unroll 1
        for (unsigned j = 0; j < 16; ++j) { const unsigned c = xb_ld(&bar[XB_XCNT(j)]); sum += c; cnt += (c > 0u) ? 1u : 0u; mine = (j == x) ? c : mine; }
        if (sum == G) break;
        __builtin_amdgcn_s_sleep(1);
        if ((++sp & 255u) == 0u) { if (xb_ld(&bar[XB_TMO])) break; if (sp > XB_SPIN_CAP) { atomicAdd(&bar[XB_TMO], 1u); break; } }
    }
    nloc = mine > 0u ? mine : 1u; nx = cnt > 0u ? cnt : 1u;
}

__device__ __forceinline__ void xcd_barrier(const XcdBarrier& b) {
    asm volatile("s_waitcnt vmcnt(0)" ::: "memory");
    __syncthreads();
    if (threadIdx.x == 0) {
        unsigned* bar = b.bar;
        __builtin_amdgcn_s_waitcnt(0);
        unsigned nloc = b.st[0], nx = b.st[1];
        if (nloc == 0u) { xcd_barrier_complete(bar, b.x, nloc, nx); b.st[0] = nloc; b.st[1] = nx; }
        const unsigned old = xb_add(&bar[XB_XSUB(b.x)], 1u);
        const unsigned gen = old / nloc;
        if (old + 1u == (gen + 1u) * nloc) {
            __builtin_amdgcn_fence(__ATOMIC_RELEASE, "agent");
            asm volatile("s_waitcnt vmcnt(0)" ::: "memory");
            const unsigned og = xb_add(&bar[XB_TOP], 1u);
            const unsigned tg = og / nx;
            if (og + 1u == (tg + 1u) * nx) xb_add(&bar[XB_TOPGEN], 1u);
            else XB_SPIN(xb_ld(&bar[XB_TOPGEN]) == tg, bar);
            __builtin_amdgcn_fence(__ATOMIC_ACQUIRE, "agent");
            xb_add(&bar[XB_XGEN(b.x)], 1u);
            asm volatile("s_waitcnt vmcnt(0)" ::: "memory");
        } else {
            XB_SPIN(xb_ld(&bar[XB_XGEN(b.x)]) == gen, bar);
            __builtin_amdgcn_fence(__ATOMIC_ACQUIRE, "agent");
            asm volatile("s_waitcnt vmcnt(0)" ::: "memory");
        }
    }
    __syncthreads();
}

constexpr int CW_BAR = 4096;
constexpr int LDS_BARST = LDS_BYTES - 64;
static_assert((CW_BAR + XCD_BAR_WORDS) * 4 <= 65536, "barrier words inside the memset region");
__global__ void __launch_bounds__(512, 2) k_fused(Params p) {
    extern __shared__ __attribute__((aligned(16))) unsigned char lds_raw[]; LAS unsigned char* lds = (LAS unsigned char*)lds_raw;
    if (pg8::ftid() < 16) ((LAS unsigned*)(lds + LDS_BARST))[pg8::ftid()] = 0u;
    __syncthreads();
    (void)xcd_barrier_post((unsigned*)(p.ws + WS_CTL) + CW_BAR, (volatile LAS unsigned*)(lds + LDS_BARST));
#define GRID_SYNC() do { XcdBarrier b_; b_.bar = (unsigned*)(p.ws + WS_CTL) + CW_BAR; b_.x = xb_xcc_id(); b_.st = (volatile LAS unsigned*)(lds + LDS_BARST); xcd_barrier(b_); } while (0)
#define MK_REP(bit) for (int rep_ = 0; rep_ < (((MK_PROBE) >> (bit)) & 1) + 1; ++rep_)
    MK_REP(0) { phase0(p, lds); GRID_SYNC(); }
    MK_REP(1) { phase_gemm_in(p, lds); GRID_SYNC(); }
    MK_REP(2) { ml::mlstm_pass<false>(p, lds); } phase_c1c0(p); GRID_SYNC();
    ml::mlstm_combine(p); GRID_SYNC();
    MK_REP(8) { ml::mlstm_pass<true>(p, lds); } GRID_SYNC();
    MK_REP(3) { phase_uvconv(p); }
    MK_REP(4) { phase_gemm_g2a(p, lds); phase_gemm_g2b(p, lds); } GRID_SYNC();
    MK_REP(5) { phase_gemm_g3(p, lds); GRID_SYNC(); }
    MK_REP(6) { phase_gemm_pq(p, lds); GRID_SYNC(); }
    if ((MK_PROBE >> 7) & 1) { for (int i = 0; i < 8; ++i) GRID_SYNC(); }
    phase_peer(p, lds);
}
}

extern "C" void kernel_launch(void* const* d_in, const int* in_sizes, int n_in, void* d_out, int out_size, void* d_ws, size_t ws_size, hipStream_t stream) {
    using namespace mk;
    static int grid = 0;
    if (grid == 0) {
        if (n_in != 19 || ws_size < WS_END || out_size != MX * D) { fprintf(stderr, "kernel_launch: unexpected shapes (n_in %d, ws %zu, out %d)\n", n_in, ws_size, out_size); grid = -1; return; }
        if (hipFuncSetAttribute((const void*)k_fused, hipFuncAttributeMaxDynamicSharedMemorySize, LDS_BYTES) != hipSuccess) { fprintf(stderr, "kernel_launch: hipFuncSetAttribute failed\n"); grid = -1; return; }
        int dev = 0, cus = 0, per_cu = 0; (void)hipGetDevice(&dev); (void)hipDeviceGetAttribute(&cus, hipDeviceAttributeMultiprocessorCount, dev);
        if (hipOccupancyMaxActiveBlocksPerMultiprocessor(&per_cu, (const void*)k_fused, 512, LDS_BYTES) != hipSuccess || per_cu < 1) { fprintf(stderr, "kernel_launch: occupancy query says %d blocks per CU\n", per_cu); grid = -1; return; }
        grid = cus;
    }
    if (grid < 0) return;
    Params p{};
    const float** pf = (const float**)&p;
    for (int i = 0; i < 19; ++i) pf[i] = (const float*)d_in[i];
    p.out = (float*)d_out; p.ws = (unsigned char*)d_ws;
    if (hipMemsetAsync((char*)d_ws + WS_CTL, 0, 65536, stream) != hipSuccess) { fprintf(stderr, "kernel_launch: hipMemsetAsync of the barrier words failed\n"); return; }
    hipLaunchKernelGGL(k_fused, dim3(grid), dim3(512), LDS_BYTES, stream, p);
}
```

```cpp
#include <hip/hip_runtime.h>
#include <hip/hip_cooperative_groups.h>
#include <cstdio>
#include <cstdint>
namespace pg8 {
__device__ __forceinline__ int ftid() { int t = threadIdx.x; asm volatile("" : "+v"(t)); return t; }
#define PG8_LAS __attribute__((address_space(3)))
typedef unsigned short bf16_t;
typedef short bf16x8 __attribute__((ext_vector_type(8)));
typedef float f32x4 __attribute__((ext_vector_type(4)));
typedef unsigned u32x4 __attribute__((ext_vector_type(4)));
constexpr int BM = 256, BK = 64, HALF = 128, HTB = HALF * BK * 2  , STAGE_BYTES = 8 * HTB, NXCD = 8, WGM = 8;

__host__ __device__ __forceinline__ int lds_byte(int r, int c) { const int st = (r >> 4) * 2 + (c >> 5), rr = r & 15, cc = c & 31, ob = rr * 64 + cc * 2; return st * 1024 + (ob ^ (((ob >> 9) & 1) << 5)); }
__host__ __device__ __forceinline__ void stage_rc(int b, int& R, int& C) { const int st = b / 1024, sb = b % 1024, swz = sb ^ (((sb >> 9) & 1) << 5); R = (st >> 1) * 16 + swz / 64; C = (st & 1) * 32 + (swz % 64) / 2; }
__host__ __device__ __forceinline__ int perm32(int rho) { const int n = rho >> 4, i = rho & 15; return 8 * (i >> 2) + 4 * n + (i & 3); }

struct Unit { int pm, pn; };
struct Gemm { const bf16_t* A; const bf16_t* Bt; int M, N, K; };

struct StaticOrder {
    int nM, nN, nwg, G, c, wgm;
    __host__ __device__ void init(int M, int N, int G_, int c_, int wgm_ = WGM) { nM = M / BM; nN = N / BM; nwg = nM * nN; G = G_; c = c_; wgm = wgm_; }
    __host__ __device__ bool next(int i, Unit& u) const {
        const long L = (long)i * G + c; if (L >= nwg) return false;
        int wgid = (int)L; { const int q = nwg / NXCD, r = nwg % NXCD, xcd = wgid % NXCD, off = wgid / NXCD; wgid = (xcd < r ? xcd * (q + 1) : r * (q + 1) + (xcd - r) * q) + off; }
        const int nig = wgm * nN, gid = wgid / nig, fm = gid * wgm, gsz = (nM - fm) < wgm ? (nM - fm) : wgm;
        u.pm = fm + ((wgid % nig) % gsz); u.pn = (wgid % nig) / gsz;
        if (colmap) { const int s = u.pn; u.pn = s < 4 ? 24 + s : s < 29 ? 36 + s : s < 41 ? s - 1 : s - 41; }
        return true;
    }
    int colmap = 0;
    __device__ __forceinline__ void a_ready(const Unit&) const {}
    __device__ __forceinline__ void done(const Unit&) const {}
};

typedef __bf16 bf16x2_t __attribute__((ext_vector_type(2)));
__device__ __forceinline__ unsigned cvt_pk_bf16(float lo, float hi) { bf16x2_t v; v[0] = (__bf16)lo; v[1] = (__bf16)hi; return __builtin_bit_cast(unsigned, v); }
typedef float f32x2 __attribute__((ext_vector_type(2)));
__device__ __forceinline__ f32x2 gelu_pk(f32x2 v) {
    const f32x2 av = __builtin_elementwise_abs(v), d = av * 0.2316418882f + 1.0f;
    f32x2 t; t.x = __builtin_amdgcn_rcpf(d.x); t.y = __builtin_amdgcn_rcpf(d.y);
    f32x2 q = t * 0.5307027145f + (-0.7265760135f); q = q * t + 0.7107068705f; q = q * t + (-0.142248368f); q = q * t + 0.127414796f; q = q * t;
    const f32x2 s = (v * v) * (-0.72134752044f);
    f32x2 e; e.x = __builtin_amdgcn_exp2f(s.x); e.y = __builtin_amdgcn_exp2f(s.y);
    const f32x2 m = v * (q * e), r = v - m;
    f32x2 o; o.x = v.x < 0.f ? m.x : r.x; o.y = v.y < 0.f ? m.y : r.y; return o;
}

template <int ACT  > struct EpiBf16 {
    static constexpr bool PERM = true, AFTER_DRAIN = false; static_assert(ACT == 0 || ACT == 1, "EpiBf16: ACT is 0 (none) or 1 (gelu_pk)");
    bf16_t* O; int ldc; const float* bias; int split_cols; size_t split_stride; float scale0;
    __device__ __forceinline__ void operator()(const f32x4 (&acc)[2][2][4][2], const Unit& u, int wr, int wc, int fr, int fq) const {
        const int row0 = u.pm * BM + wr * 64 + fr; int colt = u.pn * BM; bf16_t* base = O;
        float sc = 1.f; if (split_cols) { const int t = colt / split_cols; base += (size_t)t * split_stride; colt -= t * split_cols; if (t == 0) sc = scale0; }
        const int col0 = colt + wc * 32 + 8 * fq, bcol0 = u.pn * BM + wc * 32 + 8 * fq;
        f32x4 bv[2][2];
#pragma unroll
        for (int bj = 0; bj < 2; ++bj)
#pragma unroll
            for (int n = 0; n < 2; ++n) bv[bj][n] = bias ? *(const f32x4*)(bias + bcol0 + bj * HALF + 4 * n) : (f32x4){0.f, 0.f, 0.f, 0.f};
#pragma unroll
        for (int ai = 0; ai < 2; ++ai)
#pragma unroll
            for (int m = 0; m < 4; ++m) { bf16_t* rowp = base + (size_t)(row0 + ai * HALF + m * 16) * ldc + col0;
#pragma unroll
                for (int bj = 0; bj < 2; ++bj) { f32x4 v0 = acc[ai][bj][m][0] + bv[bj][0], v1 = acc[ai][bj][m][1] + bv[bj][1];
                    if (ACT == 1) { f32x2 a = gelu_pk((f32x2){v0[0], v0[1]}), b = gelu_pk((f32x2){v0[2], v0[3]}), c = gelu_pk((f32x2){v1[0], v1[1]}), d = gelu_pk((f32x2){v1[2], v1[3]});
                        v0 = (f32x4){a.x, a.y, b.x, b.y}; v1 = (f32x4){c.x, c.y, d.x, d.y}; }
                    v0 = v0 * sc; v1 = v1 * sc; u32x4 w; w.x = cvt_pk_bf16(v0[0], v0[1]); w.y = cvt_pk_bf16(v0[2], v0[3]); w.z = cvt_pk_bf16(v1[0], v1[1]); w.w = cvt_pk_bf16(v1[2], v1[3]);
                    *(u32x4*)(rowp + bj * HALF) = w; } }
    }
};
typedef int i32x4 __attribute__((ext_vector_type(4)));
__device__ __forceinline__ const char* sgpr_ptr(const char* p) { const unsigned long long u = (unsigned long long)p; const unsigned lo = __builtin_amdgcn_readfirstlane((unsigned)u), hi = __builtin_amdgcn_readfirstlane((unsigned)(u >> 32)); return (const char*)(((unsigned long long)hi << 32) | lo); }
typedef int i32x8 __attribute__((ext_vector_type(8)));
template <bool FP8> __device__ __forceinline__ f32x4 mma_step(const i32x8& b, const i32x8& a, f32x4 c) {
    if constexpr (FP8) {
        return __builtin_amdgcn_mfma_scale_f32_16x16x128_f8f6f4(b, a, c, 0, 0, 0, 0x79797979, 0, 0x7f7f7f7f);
    } else {
        const bf16x8 b0 = __builtin_bit_cast(bf16x8, (i32x4)__builtin_shufflevector(b, b, 0, 1, 2, 3)), b1 = __builtin_bit_cast(bf16x8, (i32x4)__builtin_shufflevector(b, b, 4, 5, 6, 7));
        const bf16x8 a0 = __builtin_bit_cast(bf16x8, (i32x4)__builtin_shufflevector(a, a, 0, 1, 2, 3)), a1 = __builtin_bit_cast(bf16x8, (i32x4)__builtin_shufflevector(a, a, 4, 5, 6, 7));
        c = __builtin_amdgcn_mfma_f32_16x16x32_bf16(b0, a0, c, 0, 0, 0);
        return __builtin_amdgcn_mfma_f32_16x16x32_bf16(b1, a1, c, 0, 0, 0);
    }
}
template <class E, class = void> struct epi_dual { static constexpr bool v = false; };
template <class E> struct epi_dual<E, decltype((void)E::DUAL)> { static constexpr bool v = E::DUAL; };
template <class Epi, class Sched, bool ALIGN_EPI = false, bool SP2 = false, bool FP8 = false>
__device__ __forceinline__ void gemm_phase(PG8_LAS unsigned char* lds, const Gemm g, const Sched& S, const Epi& E) {
    const int tid = ftid(), wid = __builtin_amdgcn_readfirstlane(tid >> 6), lane = tid & 63, wr = wid >> 2, wc = wid & 3, fr = lane & 15, fq = lane >> 4;
    constexpr bool DUAL = epi_dual<Epi>::v;
    const int K = g.K, nth = K / BK;
    size_t jA = 0, jB = 0; if constexpr (DUAL) { jA = Epi::jA; jB = Epi::jB; }
    unsigned voffA, voffB;
    { int R, C; stage_rc(tid * 16, R, C); const int Rb = Epi::PERM ? ((R & ~31) + perm32(R & 31)) : R; voffA = (unsigned)(R * K + C) * 2u; voffB = (unsigned)(Rb * K + C) * 2u; }
    const size_t pstep = (size_t)64 * K * 2;
    const size_t kstep = (size_t)(BK * 2);
    const size_t hstep = (size_t)HALF * K * 2;
    const size_t tstep = 2 * hstep;
    const unsigned ldsw = (unsigned)wid * 1024u;
    const int aoff = lds_byte(wr * 64 + fr, fq * 8), boff = lds_byte(wc * 32 + fr, fq * 8);
#define PG8_SA(b, h) (((b) * 2 + (h)) * HTB)
#define PG8_SB(b, h) ((4 + (b) * 2 + (h)) * HTB)
#define PG8_STAGE(bufoff, gbase, voff) do { _Pragma("unroll") for (int _i = 0; _i < 2; ++_i) { const char* gb_ = sgpr_ptr((const char*)(gbase) + _i * pstep); unsigned vo_ = (voff); asm volatile("" : "+v"(vo_)); \
        __builtin_amdgcn_global_load_lds((const unsigned*)(gb_ + vo_), (PG8_LAS unsigned*)(lds + (bufoff) + ldsw + _i * 8192), 16, 0, 0); } } while (0)
#define PG8_LDA(dst, b, h) do { _Pragma("unroll") for (int m = 0; m < 4; ++m) { const i32x4 lo_ = *(const PG8_LAS i32x4*)(lds + PG8_SA(b, h) + aoff + m * 2048), hi_ = *(const PG8_LAS i32x4*)(lds + PG8_SA(b, h) + aoff + m * 2048 + 1024); dst[m] = __builtin_shufflevector(lo_, hi_, 0, 1, 2, 3, 4, 5, 6, 7); } } while (0)
#define PG8_LDB(dst, b, h) do { _Pragma("unroll") for (int n = 0; n < 2; ++n) { const i32x4 lo_ = *(const PG8_LAS i32x4*)(lds + PG8_SB(b, h) + boff + n * 2048), hi_ = *(const PG8_LAS i32x4*)(lds + PG8_SB(b, h) + boff + n * 2048 + 1024); dst[n] = __builtin_shufflevector(lo_, hi_, 0, 1, 2, 3, 4, 5, 6, 7); } } while (0)
#define PG8_MMA(ai, bj, At, Bt) do { __builtin_amdgcn_s_setprio(1); _Pragma("unroll") for (int m = 0; m < 4; ++m) _Pragma("unroll") for (int n = 0; n < 2; ++n) \
        acc[ai][bj][m][n] = mma_step<FP8>(Bt[n], At[m], acc[ai][bj][m][n]); __builtin_amdgcn_s_setprio(0); } while (0)
#define PG8_WAIT_V(n) asm volatile("s_waitcnt vmcnt(" #n ")" ::: "memory")
#define PG8_WAIT_L(n) asm volatile("s_waitcnt lgkmcnt(" #n ")" ::: "memory")
#define PG8_BAR __builtin_amdgcn_s_barrier()
#define PG8_SCHED __builtin_amdgcn_sched_barrier(0)
    Unit cur, nxt; int ui = 0;
    if (!S.next(0, cur)) return;
    f32x4 acc[2][2][4][2];
#pragma unroll
    for (int a = 0; a < 2; ++a)
#pragma unroll
        for (int b = 0; b < 2; ++b)
#pragma unroll
            for (int m = 0; m < 4; ++m)
#pragma unroll
                for (int n = 0; n < 2; ++n) acc[a][b][m][n] = (f32x4){0.f, 0.f, 0.f, 0.f};
    i32x8 At[4], B0[2], B1[2];
    const char* cA = (const char*)g.A + (size_t)cur.pm * tstep; const char* cB = (const char*)g.Bt + (size_t)cur.pn * tstep;
    S.a_ready(cur);
    if constexpr (SP2) {
        PG8_STAGE(PG8_SB(0, 0), cB, voffB); PG8_STAGE(PG8_SB(0, 1), cB + hstep, voffB); PG8_STAGE(PG8_SA(0, 0), cA, voffA); PG8_STAGE(PG8_SA(0, 1), cA + hstep, voffA);
        if (wr == 1) PG8_BAR;
        PG8_WAIT_V(2); PG8_BAR;
        PG8_STAGE(PG8_SB(1, 0), cB + kstep, voffB); PG8_STAGE(PG8_SA(1, 0), cA + kstep, voffA); PG8_STAGE(PG8_SB(1, 1), cB + hstep + kstep, voffB);
        PG8_WAIT_V(6); PG8_BAR;
    } else {
        PG8_STAGE(PG8_SB(0, 0), cB, voffB); PG8_STAGE(PG8_SA(0, 0), cA, voffA); PG8_STAGE(PG8_SB(0, 1), cB + hstep, voffB); PG8_STAGE(PG8_SA(0, 1), cA + hstep, voffA);
        if (wr == 1) PG8_BAR;
        PG8_WAIT_V(4); PG8_BAR;
        PG8_STAGE(PG8_SB(1, 0), cB + kstep, voffB); PG8_STAGE(PG8_SA(1, 0), cA + kstep, voffA); PG8_STAGE(PG8_SB(1, 1), cB + hstep + kstep, voffB);
        PG8_WAIT_V(6); PG8_BAR;
    }
    for (;;) {
        const bool has_next = S.next(ui + 1, nxt);
        const char* nA = has_next ? (const char*)g.A + (size_t)nxt.pm * tstep : cA; const char* nB = has_next ? (const char*)g.Bt + (size_t)nxt.pn * tstep : cB;
        const char* hA = cA; const char* hB = cB;
#pragma unroll 1
        for (int h = 0; h < (DUAL ? 2 : 1); ++h) {
        const bool lasth = !DUAL || h == 1;
        const char* xA = lasth ? nA : cA + jA; const char* xB = lasth ? nB : cB + jB;
        for (int t = 0; t < nth; t += 2) {
            const bool last = (t == nth - 2);
            const char* a1 = hA + (size_t)(t + 1) * kstep;
            const char* a2 = last ? xA : hA + (size_t)(t + 2) * kstep; const char* b2 = last ? xB : hB + (size_t)(t + 2) * kstep;
            const char* a3 = a2 + kstep; const char* b3 = b2 + kstep;
            if (last && lasth && has_next) S.a_ready(nxt);
            if constexpr (SP2) {
            PG8_LDB(B0, 0, 0); PG8_LDB(B1, 0, 1); PG8_SCHED; PG8_LDA(At, 0, 0); PG8_STAGE(PG8_SA(1, 1), a1 + hstep, voffA);
            PG8_WAIT_V(8); PG8_WAIT_L(0); PG8_BAR; PG8_MMA(0, 0, At, B0); PG8_MMA(0, 1, At, B1); PG8_BAR; PG8_SCHED;
            PG8_LDA(At, 0, 1); PG8_STAGE(PG8_SB(0, 0), b2, voffB); PG8_STAGE(PG8_SB(0, 1), b2 + hstep, voffB); PG8_STAGE(PG8_SA(0, 0), a2, voffA);
            PG8_WAIT_V(8); PG8_WAIT_L(0); PG8_BAR; PG8_MMA(1, 0, At, B0); PG8_MMA(1, 1, At, B1); PG8_BAR; PG8_SCHED;
            PG8_LDB(B0, 1, 0); PG8_LDB(B1, 1, 1); PG8_SCHED; PG8_LDA(At, 1, 0); PG8_STAGE(PG8_SA(0, 1), a2 + hstep, voffA);
            PG8_WAIT_V(8); PG8_WAIT_L(0); PG8_BAR; PG8_MMA(0, 0, At, B0); PG8_MMA(0, 1, At, B1); PG8_BAR; PG8_SCHED;
            PG8_LDA(At, 1, 1); PG8_STAGE(PG8_SB(1, 0), b3, voffB); PG8_STAGE(PG8_SB(1, 1), b3 + hstep, voffB); PG8_STAGE(PG8_SA(1, 0), a3, voffA);
            PG8_WAIT_V(8); PG8_WAIT_L(0); PG8_BAR; PG8_MMA(1, 0, At, B0); PG8_MMA(1, 1, At, B1); PG8_BAR; PG8_SCHED;
            } else {
            PG8_LDB(B0, 0, 0); PG8_SCHED; PG8_LDA(At, 0, 0); PG8_STAGE(PG8_SA(1, 1), a1 + hstep, voffA);
            PG8_WAIT_L(8); PG8_BAR; PG8_WAIT_L(0); PG8_MMA(0, 0, At, B0); PG8_BAR; PG8_SCHED;
            PG8_LDB(B1, 0, 1); PG8_STAGE(PG8_SB(0, 0), b2, voffB);
            PG8_BAR; PG8_WAIT_L(0); PG8_MMA(0, 1, At, B1); PG8_BAR;
            PG8_LDA(At, 0, 1); PG8_STAGE(PG8_SA(0, 0), a2, voffA);
            PG8_BAR; PG8_WAIT_L(0); PG8_MMA(1, 0, At, B0); PG8_BAR; PG8_SCHED;
            PG8_STAGE(PG8_SB(0, 1), b2 + hstep, voffB);
            PG8_WAIT_V(6); PG8_BAR; PG8_MMA(1, 1, At, B1); PG8_BAR;
            PG8_LDB(B0, 1, 0); PG8_SCHED; PG8_LDA(At, 1, 0); PG8_STAGE(PG8_SA(0, 1), a2 + hstep, voffA);
            PG8_WAIT_L(8); PG8_BAR; PG8_WAIT_L(0); PG8_MMA(0, 0, At, B0); PG8_BAR; PG8_SCHED;
            PG8_LDB(B1, 1, 1); PG8_STAGE(PG8_SB(1, 0), b3, voffB);
            PG8_BAR; PG8_WAIT_L(0); PG8_MMA(0, 1, At, B1); PG8_BAR;
            PG8_LDA(At, 1, 1); PG8_STAGE(PG8_SA(1, 0), a3, voffA);
            PG8_BAR; PG8_WAIT_L(0); PG8_MMA(1, 0, At, B0); PG8_BAR; PG8_SCHED;
            PG8_STAGE(PG8_SB(1, 1), b3 + hstep, voffB);
            PG8_WAIT_V(6); PG8_BAR; PG8_MMA(1, 1, At, B1); PG8_BAR;
            }
        }
        if constexpr (DUAL) { if (h == 0) { E.mid(acc, cur, wr, wc, fr, fq); hA = cA + jA; hB = cB + jB; } }
        }
        if constexpr (ALIGN_EPI) { if (wr == 0) PG8_BAR; }
        if constexpr (!Epi::AFTER_DRAIN) { E(acc, cur, wr, wc, fr, fq); S.done(cur); }
#ifdef MK_PROBE
#if (MK_PROBE >> 9) & 1
        if constexpr (!Epi::AFTER_DRAIN) { asm volatile("" ::: "memory"); E(acc, cur, wr, wc, fr, fq); }
#endif
#if (MK_PROBE >> 10) & 1
        if constexpr (!Epi::AFTER_DRAIN) { if (g.N > 4096) { asm volatile("" ::: "memory"); E(acc, cur, wr, wc, fr, fq); } }
#endif
#endif
        if (!has_next) break;
#pragma unroll
        for (int a = 0; a < 2; ++a)
#pragma unroll
            for (int b = 0; b < 2; ++b)
#pragma unroll
                for (int m = 0; m < 4; ++m)
#pragma unroll
                    for (int n = 0; n < 2; ++n) acc[a][b][m][n] = (f32x4){0.f, 0.f, 0.f, 0.f};
        cur = nxt; cA = nA; cB = nB; ++ui;
        if constexpr (ALIGN_EPI) { if (wr == 1) PG8_BAR; }
    }
    PG8_WAIT_V(0);
    if constexpr (!ALIGN_EPI) { if (wr == 0) PG8_BAR; }
    PG8_BAR;
    if constexpr (Epi::AFTER_DRAIN) { E.fused(acc, cur, wr, wc, fr, fq, lds, wid, lane); S.done(cur); }
#undef PG8_SA
#undef PG8_SB
#undef PG8_STAGE
#undef PG8_LDA
#undef PG8_LDB
#undef PG8_MMA
#undef PG8_WAIT_V
#undef PG8_WAIT_L
#undef PG8_BAR
#undef PG8_SCHED
}
}

#ifndef MK_DBG
#define MK_DBG 0
#endif
#ifndef MK_PEER_SPLIT
#define MK_PEER_SPLIT 1
#endif
#ifndef MK_COLMAP
#define MK_COLMAP 0
#endif
#ifndef MK_STAG
#define MK_STAG 0
#endif
#ifndef MK_PROBE
#define MK_PROBE 0
#endif
#ifndef MK_WGM_IN
#define MK_WGM_IN 7
#endif
#ifndef MK_WGM_SQ
#define MK_WGM_SQ 2
#endif
#ifndef MK_ALIGN
#define MK_ALIGN true
#endif
#ifndef MK_SP2
#define MK_SP2 true
#endif
namespace mk {
#define GAS __attribute__((address_space(1)))
#define LAS __attribute__((address_space(3)))
typedef unsigned short bf16;
typedef unsigned v4u __attribute__((ext_vector_type(4)));
typedef unsigned v2u __attribute__((ext_vector_type(2)));
typedef float f32x4 __attribute__((ext_vector_type(4)));
typedef float f32x2 __attribute__((ext_vector_type(2)));

constexpr int D = 2048, MX = 16384, MP = 16640, SEQ = 8192, NMETA = 16;
constexpr int NIN = 16400, NINP = 16640;
constexpr int NH = 8, DQK = 128, DV = 256;
constexpr int LSEQ = SEQ + NMETA;
constexpr float LN_EPS = 1e-5f;
constexpr float ALPHA = 1.189207115002721f;
constexpr float QSCALE = 0.08838834764831845f;

constexpr size_t MiB = 1u << 20;
constexpr size_t WS_CTL = 0, CTL_ZERO_BYTES = 512 * 1024;
constexpr size_t CTL_C1 = 256 * 1024;
constexpr size_t CTL_C0 = 264 * 1024;
constexpr size_t CTL_C1P = 512 * 1024, CTL_C0P = 1024 * 1024;
constexpr size_t WS_GIF = 2 * MiB;
constexpr size_t WS_BT_PA = 4 * MiB, WS_BT_PB = 12 * MiB, WS_BT_WO = 20 * MiB, WS_BT_F = 28 * MiB;
constexpr size_t WS_H0 = 36 * MiB;
constexpr size_t WS_BT_IN = 101 * MiB;
constexpr size_t WS_H0F8 = 101 * MiB;
constexpr size_t WS_BT_IN8 = 133 * MiB + 512 * 1024;
static_assert(WS_H0F8 + (size_t)16640 * 2048 <= WS_BT_IN8 && WS_BT_IN8 + (size_t)16640 * 2048 <= 166 * MiB, "fp8 operand copies");
constexpr size_t WS_UBF = 489 * MiB;
constexpr size_t WS_CB = 166 * MiB;
constexpr size_t WS_R = WS_CB;
constexpr size_t WS_Z = 230 * MiB;
constexpr size_t WS_VBF = 521 * MiB;
constexpr size_t WS_YA8 = WS_BT_IN8;
constexpr size_t WS_YB = WS_Z;
constexpr size_t WS_Q = 295 * MiB;
constexpr size_t WS_K = 327 * MiB;
constexpr size_t WS_TMP = WS_Q;
constexpr size_t WS_V = 360 * MiB;
constexpr size_t WS_SIGO = 425 * MiB;
constexpr size_t WS_MERGED = WS_SIGO;
constexpr size_t WS_END = 553 * MiB;
constexpr size_t OUT_SGA = 0, OUT_SGB = 64 * MiB;

constexpr int LDS_BYTES = 147456;

struct Params {
    const float *x, *meta, *ln0_g, *ln0_b, *w_in, *b_if, *conv_w, *mh_w, *p_a, *p_b, *w_o, *ln1_g, *ln1_b, *peer_wq, *peer_keys, *peer_u, *peer_v, *ln2_g, *ln2_b;
    float* out; unsigned char* ws;
};

__device__ __forceinline__ float bf2f(unsigned u) { return __uint_as_float(u << 16); }
__device__ __forceinline__ float bflo(unsigned w) { return __uint_as_float(w << 16); }
__device__ __forceinline__ float bfhi(unsigned w) { return __uint_as_float(w & 0xffff0000u); }
__device__ __forceinline__ unsigned pk2(float lo, float hi) { return pg8::cvt_pk_bf16(lo, hi); }
template <int CTRL> __device__ __forceinline__ float dpp_f(float v) { return __builtin_bit_cast(float, __builtin_amdgcn_update_dpp(0, __builtin_bit_cast(int, v), CTRL, 0xF, 0xF, true)); }
__device__ __forceinline__ float quad_sum(float v) { v += dpp_f<0xB1>(v); v += dpp_f<0x4E>(v); return v; }
__device__ __forceinline__ float oct_sum(float v) { v = quad_sum(v); v += dpp_f<0x141>(v); return v; }
__device__ __forceinline__ float row16_sum(float v) { v = oct_sum(v); v += dpp_f<0x140>(v); return v; }
__device__ __forceinline__ float wave_sum(float v) {
    v = row16_sum(v);
    const float a = __builtin_bit_cast(float, __builtin_amdgcn_readlane(__builtin_bit_cast(int, v), 0)), b = __builtin_bit_cast(float, __builtin_amdgcn_readlane(__builtin_bit_cast(int, v), 16));
    const float c = __builtin_bit_cast(float, __builtin_amdgcn_readlane(__builtin_bit_cast(int, v), 32)), d = __builtin_bit_cast(float, __builtin_amdgcn_readlane(__builtin_bit_cast(int, v), 48));
    return (a + b) + (c + d);
}
__device__ __forceinline__ float sigmoidf_(float x) { return __builtin_amdgcn_rcpf(1.0f + __expf(-x)); }
#define LDS_WAIT() asm volatile("s_waitcnt lgkmcnt(0)" ::: "memory")

__device__ __forceinline__ int in_dest_row(int n) {
    if (n < 2048) return n;
    if (n < 4096) { const int c = n - 2048; return (8 + (c >> 7)) * 256 + (c & 127); }
    if (n < 6144) { const int c = n - 4096; return (8 + (c >> 7)) * 256 + 128 + (c & 127); }
    if (n < 7168) return 24 * 256 + (n - 6144);
    if (n < 8192) return 28 * 256 + (n - 7168);
    if (n < 10240) return 32 * 256 + (n - 8192);
    if (n < 12288) return 40 * 256 + (n - 10240);
    if (n < 12304) return 64 * 256 + (n - 12288);
    if (n < 14352) return 48 * 256 + (n - 12304);
    return 56 * 256 + (n - 14352);
}
template <bool INMAP>
__device__ __forceinline__ void transpose_item(const float* W, int K, int N, bf16* WT, LAS float* scr, int item, int lane) {
    const int nblk = (N + 31) / 32, kb = item / nblk, nb = item % nblk, k0 = 64 * kb, n0 = 32 * nb;
    const int rr = lane >> 3, c4 = (lane & 7) * 4; const bool ok = (n0 + c4) < N;
    f32x4 v[8];
#pragma unroll
    for (int i = 0; i < 8; ++i) v[i] = ok ? *(const f32x4*)(W + (size_t)(k0 + 8 * i + rr) * N + n0 + c4) : (f32x4){0.f, 0.f, 0.f, 0.f};
#pragma unroll
    for (int i = 0; i < 8; ++i) { LAS float* d = scr + (8 * i + rr) * 33 + c4; d[0] = v[i].x; d[1] = v[i].y; d[2] = v[i].z; d[3] = v[i].w; }
    LDS_WAIT();
    const int c = lane & 7;
#pragma unroll
    for (int j = 0; j < 4; ++j) { const int nl = (lane >> 3) + 8 * j; const int n = n0 + nl; const LAS float* s = scr + (8 * c) * 33 + nl;
        v4u o; o.x = pk2(s[0 * 33], s[1 * 33]); o.y = pk2(s[2 * 33], s[3 * 33]); o.z = pk2(s[4 * 33], s[5 * 33]); o.w = pk2(s[6 * 33], s[7 * 33]);
        if (n < N) { const int dr = INMAP ? in_dest_row(n) : n; *(v4u*)(WT + (size_t)dr * K + k0 + 8 * c) = o; } }
    LDS_WAIT();
}
__device__ __forceinline__ unsigned pk4_fp8(float a, float b, float c, float d) { int w = 0; w = __builtin_amdgcn_cvt_pk_fp8_f32(a, b, w, false); w = __builtin_amdgcn_cvt_pk_fp8_f32(c, d, w, true); return (unsigned)w; }
template <bool INMAP>
__device__ __forceinline__ void transpose_item_fp8(const float* W, int K, int N, unsigned char* WT, LAS float* scr, int item, int lane) {
    const int nblk = (N + 31) / 32, kb = item / nblk, nb = item % nblk, k0 = 128 * kb, n0 = 32 * nb;
    const int rr = lane >> 3, c4 = (lane & 7) * 4; const bool ok = (n0 + c4) < N;
    f32x4 v[16];
#pragma unroll
    for (int i = 0; i < 16; ++i) v[i] = ok ? *(const f32x4*)(W + (size_t)(k0 + 8 * i + rr) * N + n0 + c4) : (f32x4){0.f, 0.f, 0.f, 0.f};
#pragma unroll
    for (int i = 0; i < 16; ++i) { LAS float* d = scr + (8 * i + rr) * 33 + c4; d[0] = v[i].x * 64.f; d[1] = v[i].y * 64.f; d[2] = v[i].z * 64.f; d[3] = v[i].w * 64.f; }
    LDS_WAIT();
    const int c = lane & 7;
#pragma unroll
    for (int j = 0; j < 4; ++j) { const int nl = (lane >> 3) + 8 * j; const int n = n0 + nl; const LAS float* s = scr + (16 * c) * 33 + nl;
        v4u o; o.x = pk4_fp8(s[0 * 33], s[1 * 33], s[2 * 33], s[3 * 33]); o.y = pk4_fp8(s[4 * 33], s[5 * 33], s[6 * 33], s[7 * 33]);
        o.z = pk4_fp8(s[8 * 33], s[9 * 33], s[10 * 33], s[11 * 33]); o.w = pk4_fp8(s[12 * 33], s[13 * 33], s[14 * 33], s[15 * 33]);
        if (n < N) *(v4u*)(WT + (size_t)(INMAP ? in_dest_row(n) : n) * K + k0 + 16 * c) = o; }
    LDS_WAIT();
}
__device__ __forceinline__ void ln0_load(const Params& p, int r, int lane, f32x4 (&v)[8]) {
    if (r >= MX + NMETA) {
#pragma unroll
        for (int j = 0; j < 8; ++j) v[j] = (f32x4){0.f, 0.f, 0.f, 0.f};
        return; }
    const float* src = (r < MX) ? p.x + (size_t)r * D : p.meta + (size_t)(r - MX) * D;
    const f32x4* xr = (const f32x4*)src + lane;
#pragma unroll
    for (int j = 0; j < 8; ++j) v[j] = xr[64 * j];
}
__device__ __forceinline__ void ln0_finish(const Params& p, int r, int lane, f32x4 (&v)[8]) {
    bf16* orow = (bf16*)(p.ws + WS_H0) + (size_t)r * D;
    unsigned long long* o8 = (unsigned long long*)orow + lane;
    unsigned* o4 = (unsigned*)(p.ws + WS_H0F8 + (size_t)r * D) + lane;
    if (r >= MX + NMETA) {
#pragma unroll
        for (int j = 0; j < 8; ++j) { o8[64 * j] = 0ull; o4[64 * j] = 0u; }
        return;
    }
    float s = 0.f;
#pragma unroll
    for (int j = 0; j < 8; ++j) s += (v[j].x + v[j].y) + (v[j].z + v[j].w);
    const float mean = wave_sum(s) * (1.f / D); float s2 = 0.f;
#pragma unroll
    for (int j = 0; j < 8; ++j) { v[j] = v[j] - mean; s2 += (v[j].x * v[j].x + v[j].y * v[j].y) + (v[j].z * v[j].z + v[j].w * v[j].w); }
    const float rstd = 1.f / sqrtf(wave_sum(s2) * (1.f / D) + LN_EPS);
#pragma unroll
    for (int j = 0; j < 8; ++j) {
        const f32x4 g = *((const f32x4*)p.ln0_g + lane + 64 * j), b = *((const f32x4*)p.ln0_b + lane + 64 * j);
        const f32x4 y = v[j] * rstd * g + b;
        o8[64 * j] = (unsigned long long)pk2(y.x, y.y) | ((unsigned long long)pk2(y.z, y.w) << 32);
        o4[64 * j] = pk4_fp8(y.x, y.y, y.z, y.w);
    }
}
typedef float f32x16_ __attribute__((ext_vector_type(16)));
__device__ __forceinline__ void wf_item(const Params& p, int item, int lane) {
    const int hp = item >> 8, dt = (item >> 2) & 63, nt = item & 3, d0 = 32 * dt, n0 = 32 * nt;
    const int i = lane & 31, kk = lane >> 5;
    const f32x4* arow = (const f32x4*)(p.peer_wq + (size_t)(d0 + i) * D + hp * 128);
    const f32x4* brow = (const f32x4*)(p.peer_keys + (size_t)hp * 16384 + (size_t)(n0 + i) * 128);
    f32x16_ acc;
#pragma unroll
    for (int g = 0; g < 16; ++g) acc[g] = 0.f;
#pragma unroll 8
    for (int q = 0; q < 32; ++q) {
        const f32x4 a = arow[q], bb = brow[q];
        acc = __builtin_amdgcn_mfma_f32_32x32x2f32(kk ? a.y : a.x, kk ? bb.y : bb.x, acc, 0, 0, 0);
        acc = __builtin_amdgcn_mfma_f32_32x32x2f32(kk ? a.w : a.z, kk ? bb.w : bb.z, acc, 0, 0, 0);
    }
    const int col = hp * 128 + n0 + i;
    bf16* dst = (bf16*)(p.ws + WS_BT_F) + (size_t)col * D + d0;
    float c1p = 0.f, c0p = 0.f;
#pragma unroll
    for (int gg = 0; gg < 4; ++gg) {
        const int dd = d0 + 8 * gg + 4 * kk;
        const f32x4 g1 = *(const f32x4*)(p.ln1_g + dd), b1 = *(const f32x4*)(p.ln1_b + dd);
        const unsigned lo = pk2(g1.x * acc[4 * gg], g1.y * acc[4 * gg + 1]), hi = pk2(g1.z * acc[4 * gg + 2], g1.w * acc[4 * gg + 3]);
        *(v2u*)(dst + 8 * gg + 4 * kk) = (v2u){lo, hi};
        c1p += (bflo(lo) + bfhi(lo)) + (bflo(hi) + bfhi(hi));
        c0p += (b1.x * acc[4 * gg] + b1.y * acc[4 * gg + 1]) + (b1.z * acc[4 * gg + 2] + b1.w * acc[4 * gg + 3]);
    }
    { const auto r1 = __builtin_amdgcn_permlane32_swap(__float_as_uint(c1p), __float_as_uint(c1p), false, false); c1p = __uint_as_float(r1[0]) + __uint_as_float(r1[1]);
      const auto r0 = __builtin_amdgcn_permlane32_swap(__float_as_uint(c0p), __float_as_uint(c0p), false, false); c0p = __uint_as_float(r0[0]) + __uint_as_float(r0[1]); }
    if (kk == 0) { ((float*)(p.ws + CTL_C1P))[dt * 2048 + col] = c1p; ((float*)(p.ws + CTL_C0P))[dt * 2048 + col] = c0p; }
}
__device__ __forceinline__ void phase0(const Params& p, LAS unsigned char* lds) {
    const int tid = pg8::ftid(), lane = tid & 63, wave = tid >> 6;
    const int gw = blockIdx.x * 8 + wave, NGW = gridDim.x * 8;
    LAS float* scr = (LAS float*)(lds + wave * 16896);
    if (!(wave & 1)) for (int it = gw; it < 4096; it += NGW) wf_item(p, it, lane);
    constexpr int I_IN = 16 * 513, I_SQ8 = 16 * 64;
    for (int rep12_ = 0; rep12_ < (((MK_PROBE) >> 12) & 1) + 1; ++rep12_)
    for (int it = gw; it < I_IN + 3 * I_SQ8; it += NGW) {
        int r = it;
        if (r < I_IN) { transpose_item_fp8<true>(p.w_in, D, NIN, p.ws + WS_BT_IN8, scr, r, lane); continue; } r -= I_IN;
        if (r < I_SQ8) { transpose_item_fp8<false>(p.p_a, D, D, p.ws + WS_BT_PA, scr, r, lane); continue; } r -= I_SQ8;
        if (r < I_SQ8) { transpose_item_fp8<false>(p.p_b, D, D, p.ws + WS_BT_PB, scr, r, lane); continue; } r -= I_SQ8;
        transpose_item_fp8<false>(p.w_o, D, D, p.ws + WS_BT_WO, scr, r, lane);
    }
    for (int r = gw; r < 240; r += NGW) { unsigned long long* o8 = (unsigned long long*)(p.ws + WS_BT_IN8 + (size_t)(64 * 256 + 16 + r) * D) + lane;
#pragma unroll
        for (int j = 0; j < 4; ++j) o8[64 * j] = 0ull; }
    for (int rep13_ = 0; rep13_ < (((MK_PROBE) >> 13) & 1) + 1; ++rep13_) {
        f32x4 va[8], vb[8], vc[8], vd[8];
        int r = gw;
        if (r < MP) ln0_load(p, r, lane, va);
        if (r + NGW < MP) ln0_load(p, r + NGW, lane, vb);
        if (r + 2 * NGW < MP) ln0_load(p, r + 2 * NGW, lane, vc);
        if (r + 3 * NGW < MP) ln0_load(p, r + 3 * NGW, lane, vd);
#pragma unroll 1
        for (; r < MP; r += 4 * NGW) {
            ln0_finish(p, r, lane, va); if (r + 4 * NGW < MP) ln0_load(p, r + 4 * NGW, lane, va);
            if (r + NGW < MP) { ln0_finish(p, r + NGW, lane, vb); if (r + 5 * NGW < MP) ln0_load(p, r + 5 * NGW, lane, vb); }
            if (r + 2 * NGW < MP) { ln0_finish(p, r + 2 * NGW, lane, vc); if (r + 6 * NGW < MP) ln0_load(p, r + 6 * NGW, lane, vc); }
            if (r + 3 * NGW < MP) { ln0_finish(p, r + 3 * NGW, lane, vd); if (r + 7 * NGW < MP) ln0_load(p, r + 7 * NGW, lane, vd); }
        }
    }
    for (int rep14_ = 0; rep14_ < (((MK_PROBE) >> 14) & 1) + 1; ++rep14_)
    if (wave & 1) for (int it = gw; it < 4096; it += NGW) wf_item(p, it, lane);
    (void)tid;
}
typedef float v32f __attribute__((ext_vector_type(32)));
typedef float v16f __attribute__((ext_vector_type(16)));
typedef unsigned v6u __attribute__((ext_vector_type(6)));
constexpr int ROW6 = 1536;
__device__ __forceinline__ void uvconv_range(const Params& p, size_t u0, size_t u1, int wk, int nwk) {
    const size_t units = (size_t)16384 * 64;
    const size_t NT = (size_t)nwk * 512;
#pragma unroll 1
    for (size_t i = u0 + (size_t)wk * 512 + pg8::ftid(); i < u1; i += NT) {
        const int t = i >= units; const size_t j = t ? i - units : i;
        const float* src = t ? p.peer_v : p.peer_u; unsigned char* dst = p.ws + (t ? WS_VBF : WS_UBF); const float sc = t ? 2.f : 64.f;
        const size_t row = j >> 6; const int l = (int)(j & 63);
        const f32x4* s4 = (const f32x4*)(src + row * 2048 + l * 32);
        v16f x0, x1;
#pragma unroll
        for (int q = 0; q < 4; ++q) { const f32x4 a = s4[q] * sc, b = s4[4 + q] * sc; x0[4 * q] = a.x; x0[4 * q + 1] = a.y; x0[4 * q + 2] = a.z; x0[4 * q + 3] = a.w; x1[4 * q] = b.x; x1[4 * q + 1] = b.y; x1[4 * q + 2] = b.z; x1[4 * q + 3] = b.w; }
        const v6u w = __builtin_amdgcn_cvt_scalef32_2xpk16_fp6_f32(x0, x1, 1.0f);
        *(v4u*)(dst + row * ROW6 + l * 16) = (v4u){w[0], w[1], w[2], w[3]};
        *(v2u*)(dst + row * ROW6 + 1024 + l * 8) = (v2u){w[4], w[5]};
    }
}
#ifndef MK_UV_EARLY
#define MK_UV_EARLY 786432
#endif
__device__ __forceinline__ size_t uv_early_units() { const int extra = ((MP / 256) * (NINP / 256)) % (int)gridDim.x; return extra ? (size_t)MK_UV_EARLY : (size_t)0; }
__device__ __forceinline__ void phase_uvconv_early(const Params& p) {
    const int extra = ((MP / 256) * (NINP / 256)) % (int)gridDim.x;
    if (extra == 0 || (int)blockIdx.x < extra) return;
    uvconv_range(p, 0, uv_early_units(), (int)blockIdx.x - extra, (int)gridDim.x - extra);
}
__device__ __forceinline__ void phase_uvconv(const Params& p) { uvconv_range(p, uv_early_units(), (size_t)2 * 16384 * 64, (int)blockIdx.x, (int)gridDim.x); }
}

namespace pg8 {
struct EpiInProj {
    static constexpr bool PERM = true, AFTER_DRAIN = false;
    unsigned char* ws; unsigned char* outb;
    __device__ __forceinline__ void operator()(const f32x4 (&acc)[2][2][4][2], const Unit& u, int wr, int wc, int fr, int fq) const {
        bf16_t* const CB = (bf16_t*)(ws + mk::WS_CB); bf16_t* const Z = (bf16_t*)(ws + mk::WS_Z); bf16_t* const Q = (bf16_t*)(ws + mk::WS_Q); bf16_t* const K = (bf16_t*)(ws + mk::WS_K); bf16_t* const V = (bf16_t*)(ws + mk::WS_V);
        bf16_t* const SIGO = (bf16_t*)(ws + mk::WS_SIGO); bf16_t* const SGA = (bf16_t*)(outb + mk::OUT_SGA); bf16_t* const SGB = (bf16_t*)(outb + mk::OUT_SGB); float* const GIF = (float*)(ws + mk::WS_GIF);
        const int pn = u.pn, pm = u.pm; const bool meta = (pm >= 64);
        int row0 = pm * BM + wr * 64 + fr, cl = wc * 32 + 8 * fq;
        asm volatile("" : "+v"(row0), "+v"(cl));
        if (pn >= 8 && pn < 24) {
            typedef unsigned u32x2_ __attribute__((ext_vector_type(2)));
            unsigned char* base = (unsigned char*)Z + (size_t)(pn - 8) * 128 + cl;
#pragma unroll
            for (int ai = 0; ai < 2; ++ai)
#pragma unroll
                for (int m = 0; m < 4; ++m) { const f32x4 z0 = acc[ai][0][m][0] * acc[ai][1][m][0], z1 = acc[ai][0][m][1] * acc[ai][1][m][1];
                    *(u32x2_*)(base + (size_t)(row0 + ai * HALF + m * 16) * 2048) = (u32x2_){mk::pk4_fp8(z0[0], z0[1], z0[2], z0[3]), mk::pk4_fp8(z1[0], z1[1], z1[2], z1[3])}; }
            return;
        }
        if (pn >= 64) {
            if (wc == 0 && fq < 2) {
#pragma unroll
                for (int ai = 0; ai < 2; ++ai)
#pragma unroll
                    for (int m = 0; m < 4; ++m) { float* g = GIF + (size_t)((row0 + ai * HALF + m * 16) * 16 + (cl & 31));     *(f32x4*)g = acc[ai][0][m][0]; *(f32x4*)(g + 4) = acc[ai][0][m][1]; }
            }
            return;
        }
        if (pn < 8) { if (!meta) store_fp8(acc, (unsigned char*)CB, pn, row0, cl); }
        else if (pn < 28) { if (!meta) store_heads<2, 128>(acc, Q, nullptr, pn - 24, pm, row0, cl); }
        else if (pn < 32) store_heads<0, 128>(acc, K, K + (size_t)16 * 8192 * 128, pn - 28, pm, row0, cl);
        else if (pn < 40) store_heads<0, 256>(acc, V, V + (size_t)16 * 8192 * 256, pn - 32, pm, row0, cl);
        else if (meta) return;
        else if (pn < 48) store_heads<1, 256>(acc, SIGO, nullptr, pn - 40, pm, row0, cl);
        else if (pn < 56) store_gate(acc, (unsigned char*)SGA, pn - 48, row0, cl);
        else store_gate(acc, (unsigned char*)SGB, pn - 56, row0, cl);
    }
    __device__ __forceinline__ void store_fp8(const f32x4 (&acc)[2][2][4][2], unsigned char* base, int colt, int row0, int cl) const {
        typedef unsigned u32x2_ __attribute__((ext_vector_type(2)));
        base += (size_t)colt * 256 + cl;
#pragma unroll
        for (int ai = 0; ai < 2; ++ai)
#pragma unroll
            for (int m = 0; m < 4; ++m) { unsigned char* rowp = base + (size_t)(row0 + ai * HALF + m * 16) * 2048;
#pragma unroll
                for (int bj = 0; bj < 2; ++bj) { const f32x4 v0 = acc[ai][bj][m][0], v1 = acc[ai][bj][m][1];
                    *(u32x2_*)(rowp + bj * HALF) = (u32x2_){mk::pk4_fp8(v0[0], v0[1], v0[2], v0[3]), mk::pk4_fp8(v1[0], v1[1], v1[2], v1[3])}; } }
    }
    __device__ __forceinline__ void store_gate(const f32x4 (&acc)[2][2][4][2], unsigned char* base, int colt, int row0, int cl) const {
        typedef unsigned u32x2_ __attribute__((ext_vector_type(2)));
        base += (size_t)colt * 256 + cl;
#pragma unroll
        for (int ai = 0; ai < 2; ++ai)
#pragma unroll
            for (int m = 0; m < 4; ++m) { unsigned char* rowp = base + (size_t)(row0 + ai * HALF + m * 16) * 2048;
#pragma unroll
                for (int bj = 0; bj < 2; ++bj) { f32x4 v0 = acc[ai][bj][m][0], v1 = acc[ai][bj][m][1];
                    asm volatile("" : "+v"(v0), "+v"(v1));
                    unsigned w0 = 0u, w1 = 0u;
#pragma unroll
                    for (int e = 0; e < 4; ++e) { w0 = __builtin_amdgcn_cvt_pk_u8_f32(__builtin_rintf(255.f * mk::sigmoidf_(v0[e])), e, w0); w1 = __builtin_amdgcn_cvt_pk_u8_f32(__builtin_rintf(255.f * mk::sigmoidf_(v1[e])), e, w1); }
                    *(u32x2_*)(rowp + bj * HALF) = (u32x2_){w0, w1};
                    asm volatile("" ::: "memory"); }
                asm volatile("" ::: "memory"); }
    }
    template <int ACT, int HW> __device__ __forceinline__ void store_heads(const f32x4 (&acc)[2][2][4][2], bf16_t* X, bf16_t* MT, int colt, int pm, int row0, int cl) const {
        const bool meta = pm >= 64; const int b = pm >> 5;
#pragma unroll
        for (int ai = 0; ai < 2; ++ai)
#pragma unroll
            for (int m = 0; m < 4; ++m) { const int row = row0 + ai * HALF + m * 16; const int s = row & 8191, j = row - 16384;
                if (meta && j >= 16) continue;
#pragma unroll
                for (int bj = 0; bj < 2; ++bj) { f32x4 v0 = acc[ai][bj][m][0], v1 = acc[ai][bj][m][1];
                    const int h = (HW == 128) ? 2 * colt + bj : colt, c = (HW == 128) ? cl : bj * HALF + cl;
                    bf16_t* dst = meta ? MT + (size_t)(h * 16 + j) * HW + c : X + ((size_t)(b * 8 + h) * 8192 + s) * HW + c;
                    if (ACT == 1) { asm volatile("" : "+v"(v0), "+v"(v1));
#pragma unroll
                        for (int e = 0; e < 4; ++e) { v0[e] = mk::sigmoidf_(v0[e]); v1[e] = mk::sigmoidf_(v1[e]); } }
                    else if (ACT == 2) { v0 = v0 * mk::QSCALE; v1 = v1 * mk::QSCALE; }
                    u32x4 w; w.x = cvt_pk_bf16(v0[0], v0[1]); w.y = cvt_pk_bf16(v0[2], v0[3]); w.z = cvt_pk_bf16(v1[0], v1[1]); w.w = cvt_pk_bf16(v1[2], v1[3]);
                    *(u32x4*)dst = w;
                    if (ACT == 1) asm volatile("" ::: "memory"); }
                asm volatile("" ::: "memory"); }
    }
    template <int ACT> __device__ __forceinline__ void store(const f32x4 (&acc)[2][2][4][2], bf16_t* base, int ld, int colt, int row0, int cl) const {
        base += (size_t)colt * 256 + cl;
#pragma unroll
        for (int ai = 0; ai < 2; ++ai)
#pragma unroll
            for (int m = 0; m < 4; ++m) { bf16_t* rowp = base + (size_t)(row0 + ai * HALF + m * 16) * ld;
#pragma unroll
                for (int bj = 0; bj < 2; ++bj) { f32x4 v0 = acc[ai][bj][m][0], v1 = acc[ai][bj][m][1];
                    if (ACT == 1) { asm volatile("" : "+v"(v0), "+v"(v1));
#pragma unroll
                        for (int e = 0; e < 4; ++e) { v0[e] = mk::sigmoidf_(v0[e]); v1[e] = mk::sigmoidf_(v1[e]); } }
                    else if (ACT == 2) { v0 = v0 * mk::QSCALE; v1 = v1 * mk::QSCALE; }
                    u32x4 w; w.x = cvt_pk_bf16(v0[0], v0[1]); w.y = cvt_pk_bf16(v0[2], v0[3]); w.z = cvt_pk_bf16(v1[0], v1[1]); w.w = cvt_pk_bf16(v1[2], v1[3]);
                    *(u32x4*)(rowp + bj * HALF) = w;
                    if (ACT == 1) asm volatile("" ::: "memory"); }
                asm volatile("" ::: "memory"); }
    }
};
template <bool SECOND> struct EpiGate {
    static constexpr bool PERM = true, AFTER_DRAIN = false;
    const bf16_t* G; const bf16_t* T; bf16_t* O;
    __device__ __forceinline__ void operator()(const f32x4 (&acc)[2][2][4][2], const Unit& u, int wr, int wc, int fr, int fq) const {
        const int row0 = u.pm * BM + wr * 64 + fr, col0 = u.pn * BM + wc * 32 + 8 * fq;
        constexpr int NB = SECOND ? 1 : 2;
#pragma unroll
        for (int a0 = 0; a0 < 2; a0 += NB) {
            u32x4 gv[NB][4][2], tv[NB][4][2];
#pragma unroll
            for (int aa = 0; aa < NB; ++aa)
#pragma unroll
                for (int m = 0; m < 4; ++m)
#pragma unroll
                    for (int bj = 0; bj < 2; ++bj) { const size_t off = (size_t)(row0 + (a0 + aa) * HALF + m * 16) * 2048 + col0 + bj * HALF;
                        gv[aa][m][bj] = *(const u32x4*)(G + off); if (SECOND) tv[aa][m][bj] = *(const u32x4*)(T + off); else tv[aa][m][bj] = (u32x4){0u, 0u, 0u, 0u}; }
            asm volatile("" ::: "memory");
#pragma unroll
            for (int aa = 0; aa < NB; ++aa)
#pragma unroll
                for (int m = 0; m < 4; ++m)
#pragma unroll
                    for (int bj = 0; bj < 2; ++bj) { const int ai = a0 + aa; const size_t off = (size_t)(row0 + ai * HALF + m * 16) * 2048 + col0 + bj * HALF;
                        const u32x4 g = gv[aa][m][bj], t = tv[aa][m][bj];
                        const f32x4 v0 = acc[ai][bj][m][0], v1 = acc[ai][bj][m][1]; float o[8];
                        o[0] = mk::bflo(g.x) * v0[0] + mk::bflo(t.x); o[1] = mk::bfhi(g.x) * v0[1] + mk::bfhi(t.x);
                        o[2] = mk::bflo(g.y) * v0[2] + mk::bflo(t.y); o[3] = mk::bfhi(g.y) * v0[3] + mk::bfhi(t.y);
                        o[4] = mk::bflo(g.z) * v1[0] + mk::bflo(t.z); o[5] = mk::bfhi(g.z) * v1[1] + mk::bfhi(t.z);
                        o[6] = mk::bflo(g.w) * v1[2] + mk::bflo(t.w); o[7] = mk::bfhi(g.w) * v1[3] + mk::bfhi(t.w);
                        if (SECOND) {
                            typedef unsigned u32x2_ __attribute__((ext_vector_type(2)));
                            *(u32x2_*)((unsigned char*)O + off) = (u32x2_){mk::pk4_fp8(o[0], o[1], o[2], o[3]), mk::pk4_fp8(o[4], o[5], o[6], o[7])};
                        } else {
                            u32x4 w; w.x = cvt_pk_bf16(o[0], o[1]); w.y = cvt_pk_bf16(o[2], o[3]); w.z = cvt_pk_bf16(o[4], o[5]); w.w = cvt_pk_bf16(o[6], o[7]);
                            *(u32x4*)(O + off) = w; } }
            asm volatile("" ::: "memory");
        }
    }
};
struct EpiGate2 {
    static constexpr bool PERM = true, AFTER_DRAIN = false, DUAL = true;
    const unsigned char* GA; const unsigned char* GB; unsigned char* O;
    static constexpr size_t jA = (size_t)(mk::WS_YB - mk::WS_YA8), jB = (size_t)(mk::WS_BT_PB - mk::WS_BT_PA);
    typedef unsigned u32x2_ __attribute__((ext_vector_type(2)));
    static __device__ __forceinline__ float ub(unsigned w, int i) { return (float)((w >> (8 * i)) & 0xffu); }
    __device__ __forceinline__ void mid(f32x4 (&acc)[2][2][4][2], const Unit& u, int wr, int wc, int fr, int fq) const {
        unsigned off0 = (unsigned)((u.pm * BM + wr * 64 + fr) * 2048 + u.pn * BM + wc * 32 + 8 * fq);
        asm volatile("" : "+v"(off0));
        const unsigned char* ga = (const unsigned char*)sgpr_ptr((const char*)GA); const unsigned char* gb = (const unsigned char*)sgpr_ptr((const char*)GB);
        u32x2_ av[2][4][2], bv[2][4][2];
#pragma unroll
        for (int ai = 0; ai < 2; ++ai)
#pragma unroll
            for (int m = 0; m < 4; ++m)
#pragma unroll
                for (int bj = 0; bj < 2; ++bj) { const unsigned off = off0 + (unsigned)((ai * HALF + m * 16) * 2048 + bj * HALF); av[ai][m][bj] = *(const u32x2_*)(ga + off); bv[ai][m][bj] = *(const u32x2_*)(gb + off); }
        asm volatile("" ::: "memory");
#pragma unroll
        for (int ai = 0; ai < 2; ++ai)
#pragma unroll
            for (int m = 0; m < 4; ++m)
#pragma unroll
                for (int bj = 0; bj < 2; ++bj) { const u32x2_ a = av[ai][m][bj], b = bv[ai][m][bj];
                    f32x4 r0, r1;
#pragma unroll
                    for (int e = 0; e < 4; ++e) { r0[e] = ub(a.x, e) * __builtin_amdgcn_rcpf(fmaxf(ub(b.x, e), GMIN)); r1[e] = ub(a.y, e) * __builtin_amdgcn_rcpf(fmaxf(ub(b.y, e), GMIN)); }
                    acc[ai][bj][m][0] = acc[ai][bj][m][0] * r0; acc[ai][bj][m][1] = acc[ai][bj][m][1] * r1; }
        asm volatile("" ::: "memory");
    }
    static constexpr float GMIN = 1.f / 1024.f;
    __device__ __forceinline__ void operator()(const f32x4 (&acc)[2][2][4][2], const Unit& u, int wr, int wc, int fr, int fq) const {
        unsigned off0 = (unsigned)((u.pm * BM + wr * 64 + fr) * 2048 + u.pn * BM + wc * 32 + 8 * fq);
        asm volatile("" : "+v"(off0));
        const unsigned char* gb = (const unsigned char*)sgpr_ptr((const char*)GB); unsigned char* o_ = (unsigned char*)sgpr_ptr((const char*)O);
        u32x2_ bv[2][4][2];
#pragma unroll
        for (int ai = 0; ai < 2; ++ai)
#pragma unroll
            for (int m = 0; m < 4; ++m)
#pragma unroll
                for (int bj = 0; bj < 2; ++bj) bv[ai][m][bj] = *(const u32x2_*)(gb + (off0 + (unsigned)((ai * HALF + m * 16) * 2048 + bj * HALF)));
        asm volatile("" ::: "memory");
#pragma unroll
        for (int ai = 0; ai < 2; ++ai)
#pragma unroll
            for (int m = 0; m < 4; ++m)
#pragma unroll
                for (int bj = 0; bj < 2; ++bj) { const unsigned off = off0 + (unsigned)((ai * HALF + m * 16) * 2048 + bj * HALF);
                    const u32x2_ b = bv[ai][m][bj]; const f32x4 v0 = acc[ai][bj][m][0], v1 = acc[ai][bj][m][1]; float o[8];
#pragma unroll
                    for (int e = 0; e < 4; ++e) { o[e] = fmaxf(ub(b.x, e), GMIN) * (1.f / 255.f) * v0[e]; o[4 + e] = fmaxf(ub(b.y, e), GMIN) * (1.f / 255.f) * v1[e]; }
                    *(u32x2_*)(o_ + off) = (u32x2_){mk::pk4_fp8(o[0], o[1], o[2], o[3]), mk::pk4_fp8(o[4], o[5], o[6], o[7])}; }
    }
};
struct EpiResid {
    static constexpr bool PERM = true, AFTER_DRAIN = false;
    const bf16_t* H0; bf16_t* R;
    __device__ __forceinline__ void operator()(const f32x4 (&acc)[2][2][4][2], const Unit& u, int wr, int wc, int fr, int fq) const {
        const int row0 = u.pm * BM + wr * 64 + fr, col0 = u.pn * BM + wc * 32 + 8 * fq;
        u32x4 hv[2][4][2];
#pragma unroll
        for (int ai = 0; ai < 2; ++ai)
#pragma unroll
            for (int m = 0; m < 4; ++m)
#pragma unroll
                for (int bj = 0; bj < 2; ++bj) hv[ai][m][bj] = *(const u32x4*)(H0 + (size_t)(row0 + ai * HALF + m * 16) * 2048 + col0 + bj * HALF);
        asm volatile("" ::: "memory");
#pragma unroll
        for (int ai = 0; ai < 2; ++ai)
#pragma unroll
            for (int m = 0; m < 4; ++m)
#pragma unroll
                for (int bj = 0; bj < 2; ++bj) { const size_t off = (size_t)(row0 + ai * HALF + m * 16) * 2048 + col0 + bj * HALF;
                    const u32x4 h = hv[ai][m][bj];
                    const f32x4 v0 = acc[ai][bj][m][0], v1 = acc[ai][bj][m][1]; float o[8];
                    o[0] = mk::ALPHA * mk::bflo(h.x) + v0[0]; o[1] = mk::ALPHA * mk::bfhi(h.x) + v0[1];
                    o[2] = mk::ALPHA * mk::bflo(h.y) + v0[2]; o[3] = mk::ALPHA * mk::bfhi(h.y) + v0[3];
                    o[4] = mk::ALPHA * mk::bflo(h.z) + v1[0]; o[5] = mk::ALPHA * mk::bfhi(h.z) + v1[1];
                    o[6] = mk::ALPHA * mk::bflo(h.w) + v1[2]; o[7] = mk::ALPHA * mk::bfhi(h.w) + v1[3];
                    u32x4 w; w.x = cvt_pk_bf16(o[0], o[1]); w.y = cvt_pk_bf16(o[2], o[3]); w.z = cvt_pk_bf16(o[4], o[5]); w.w = cvt_pk_bf16(o[6], o[7]);
                    *(u32x4*)(R + off) = w; }
    }
};
struct EpiScores {
    static constexpr bool PERM = true, AFTER_DRAIN = false;
    _Float16* S;
    __device__ __forceinline__ void operator()(const f32x4 (&acc)[2][2][4][2], const Unit& u, int wr, int wc, int fr, int fq) const {
        typedef _Float16 h8_t __attribute__((ext_vector_type(8)));
        const int row0 = u.pm * BM + wr * 64 + fr, col0 = u.pn * BM + wc * 32 + 8 * fq;
#pragma unroll
        for (int ai = 0; ai < 2; ++ai)
#pragma unroll
            for (int m = 0; m < 4; ++m) { _Float16* rowp = S + (size_t)(row0 + ai * HALF + m * 16) * 2048 + col0;
#pragma unroll
                for (int bj = 0; bj < 2; ++bj) { const f32x4 v0 = acc[ai][bj][m][0], v1 = acc[ai][bj][m][1]; h8_t w;
                    w[0] = (_Float16)v0[0]; w[1] = (_Float16)v0[1]; w[2] = (_Float16)v0[2]; w[3] = (_Float16)v0[3]; w[4] = (_Float16)v1[0]; w[5] = (_Float16)v1[1]; w[6] = (_Float16)v1[2]; w[7] = (_Float16)v1[3];
                    *(h8_t*)(rowp + bj * HALF) = w; } }
    }
};
}

namespace mk {
__device__ __forceinline__ void phase_c1c0(const Params& p) {
    const int gt = blockIdx.x * 512 + pg8::ftid();
    if (gt < 4096) { const int col = gt & 2047; const float* src = (const float*)(p.ws + (gt < 2048 ? CTL_C1P : CTL_C0P)); float a = 0.f;
        for (int i = 0; i < 64; ++i) a += src[i * 2048 + col];
        ((float*)(p.ws + (gt < 2048 ? CTL_C1 : CTL_C0)))[col] = a; }
}
constexpr int CONV_SLICES = 1024 * 256 * 4;
__device__ __forceinline__ void conv_issue(const Params& p, int s, v2u& zm2, v2u& zm1, v2u (&z)[4], v2u (&cb)[4]) {
    const unsigned char* CB = p.ws + WS_CB; const unsigned char* Z = p.ws + WS_Z;
    const int it = s & 262143, qq = s >> 18, c0 = (it & 255) * 8, r0 = (it >> 8) * 16 + 4 * qq;
    const bool first = (r0 & (SEQ - 1)) == 0;
    zm2 = *(const v2u*)(Z + (size_t)(first ? MX + 14 : r0 - 2) * D + c0);
    zm1 = *(const v2u*)(Z + (size_t)(first ? MX + 15 : r0 - 1) * D + c0);
#pragma unroll
    for (int i = 0; i < 4; ++i) { const size_t off = (size_t)(r0 + i) * D + c0; z[i] = *(const v2u*)(Z + off); cb[i] = *(const v2u*)(CB + off); }
}
__device__ __forceinline__ void fp8x8_f32(v2u w, float (&o)[8]) {
    typedef float f2_t __attribute__((ext_vector_type(2)));
    const f2_t a = __builtin_amdgcn_cvt_pk_f32_fp8((int)w.x, false), b = __builtin_amdgcn_cvt_pk_f32_fp8((int)w.x, true), c = __builtin_amdgcn_cvt_pk_f32_fp8((int)w.y, false), d = __builtin_amdgcn_cvt_pk_f32_fp8((int)w.y, true);
    o[0] = a[0]; o[1] = a[1]; o[2] = b[0]; o[3] = b[1]; o[4] = c[0]; o[5] = c[1]; o[6] = d[0]; o[7] = d[1];
}
__device__ __forceinline__ void conv_finish(const Params& p, int s, v2u zm2_, v2u zm1_, const v2u (&zz)[4], const v2u (&cbb)[4]) {
    const int it = s & 262143, qq = s >> 18, c0 = (it & 255) * 8, r0 = (it >> 8) * 16 + 4 * qq;
    const float* cw = p.conv_w + c0; asm volatile("" : "+v"(cw));
    float w0[8], w1[8], w2[8];
    { const f32x4 a0 = *(const f32x4*)cw, a1 = *(const f32x4*)(cw + 4), b0 = *(const f32x4*)(cw + 2048), b1 = *(const f32x4*)(cw + 2052), d0 = *(const f32x4*)(cw + 4096), d1 = *(const f32x4*)(cw + 4100);
#pragma unroll
      for (int e = 0; e < 4; ++e) { w0[e] = a0[e]; w0[4 + e] = a1[e]; w1[e] = b0[e]; w1[4 + e] = b1[e]; w2[e] = d0[e]; w2[4 + e] = d1[e]; } }
    float zm2[8], zm1[8]; fp8x8_f32(zm2_, zm2); fp8x8_f32(zm1_, zm1);
#pragma unroll
    for (int i = 0; i < 4; ++i) {
        const size_t off = (size_t)(r0 + i) * D + c0;
        float z[8], cb[8], y[8]; fp8x8_f32(zz[i], z); fp8x8_f32(cbb[i], cb);
#pragma unroll
        for (int e = 0; e < 8; ++e) { y[e] = cb[e] * (w0[e] * zm2[e] + w1[e] * zm1[e] + w2[e] * z[e]); zm2[e] = zm1[e]; zm1[e] = z[e]; }
        *(v2u*)(p.ws + WS_YA8 + off) = (v2u){pk4_fp8(y[0], y[1], y[2], y[3]), pk4_fp8(y[4], y[5], y[6], y[7])};
    }
}

constexpr float U_SCALE = 64.f, V_SCALE = 2.f;
#ifndef MK_FP6_ORDER
#define MK_FP6_ORDER 1
#endif
__device__ __forceinline__ float gelu_exact(float a) { return 0.5f * a * (1.f + erff(a * 0.70710678118654752f)); }
__device__ __forceinline__ void ce_desc(unsigned& a, unsigned& b) { const unsigned hi = a > b ? a : b, lo = a > b ? b : a; a = hi; b = lo; }
__device__ __forceinline__ void merge16_desc(unsigned (&v)[16]) {
#pragma unroll
    for (int j = 8; j > 0; j >>= 1)
#pragma unroll
        for (int i = 0; i < 16; ++i) { const int l = i ^ j; if (l > i) ce_desc(v[i], v[l]); }
}
__device__ __forceinline__ void sort16_desc(unsigned (&v)[16]) {
#pragma unroll
    for (int k = 2; k <= 16; k <<= 1)
#pragma unroll
        for (int j = k >> 1; j > 0; j >>= 1)
#pragma unroll
            for (int i = 0; i < 16; ++i) { const int l = i ^ j; if (l > i) { if ((i & k) == 0) ce_desc(v[i], v[l]); else ce_desc(v[l], v[i]); } }
}
__device__ __forceinline__ float key_val(unsigned k) { const unsigned m = k & 0xFFFFFF80u; return __uint_as_float((m & 0x80000000u) ? (m & 0x7FFFFFFFu) : ~m); }
template <int PART>
__device__ __forceinline__ void phase_peer(const Params& p, LAS unsigned char* lds) {
    int* const EIx = (int*)(p.ws + WS_V); float* const EGx = (float*)(p.ws + WS_V + 8 * MiB); float* const STx = (float*)(p.ws + WS_V + 16 * MiB);
    const int tid = pg8::ftid(), lane0 = tid & 63, wave = tid >> 6;
    LAS unsigned* K1 = (LAS unsigned*)(lds + wave * 4096);
    LAS unsigned* K2 = (LAS unsigned*)(lds + wave * 4096 + 1024);
    LAS int* Ei = (LAS int*)(lds + wave * 4096 + 3072);
    LAS float* Eg = (LAS float*)(lds + wave * 4096 + 3584);
    LAS float* PAR = (LAS float*)(lds + 32768);
    {
        const float* C1g = (const float*)(p.ws + CTL_C1); const float* C0g = (const float*)(p.ws + CTL_C0);
        for (int i = tid; i < 2048; i += 512) { PAR[i] = p.ln1_g[i]; PAR[2048 + i] = p.ln1_b[i]; PAR[4096 + i] = p.ln2_g[i]; PAR[6144 + i] = p.ln2_b[i]; PAR[8192 + i] = C1g[i]; PAR[10240 + i] = C0g[i]; }
    }
    __syncthreads();
    unsigned ciw = 0u, cjw = 0u;
    { const int sub0 = lane0 & 7; int c = 0; for (int i = 0; i < 16; ++i) { const int nj = 16 / (i + 1); for (int j = 0; j < nj; ++j) { if ((c & 7) == sub0) { ciw |= (unsigned)i << (4 * (c >> 3)); cjw |= (unsigned)j << (4 * (c >> 3)); } ++c; } } }
    const bf16* R = (const bf16*)(p.ws + WS_R);
    const unsigned char* U6 = p.ws + WS_UBF; const unsigned char* V6 = p.ws + WS_VBF;
    const _Float16* SC = (const _Float16*)(p.ws + WS_TMP);
    const int gw = blockIdx.x * 8 + wave, NGW = gridDim.x * 8;
#pragma unroll 1
    for (int r = gw; r < MX; r += NGW) {
        int lane = lane0; asm volatile("" : "+v"(lane));
        const int qd = lane & 3, qbase = lane & ~3;
        float mu, rstd;
        v4u rw_[4];
        {
            v4u (&w)[4] = rw_; float s1 = 0.f;
#pragma unroll
            for (int q = 0; q < 4; ++q) { w[q] = *(const v4u*)(R + (size_t)r * D + lane * 32 + q * 8);
                s1 += ((bflo(w[q].x) + bfhi(w[q].x)) + (bflo(w[q].y) + bfhi(w[q].y))) + ((bflo(w[q].z) + bfhi(w[q].z)) + (bflo(w[q].w) + bfhi(w[q].w))); }
            if constexpr (PART == 1) { mu = STx[2 * r]; rstd = STx[2 * r + 1]; }
            else {
            mu = wave_sum(s1) * (1.f / D); float s2 = 0.f;
#pragma unroll
            for (int q = 0; q < 4; ++q) { const float d0 = bflo(w[q].x) - mu, d1 = bfhi(w[q].x) - mu, d2 = bflo(w[q].y) - mu, d3 = bfhi(w[q].y) - mu, d4 = bflo(w[q].z) - mu, d5 = bfhi(w[q].z) - mu, d6 = bflo(w[q].w) - mu, d7 = bfhi(w[q].w) - mu;
                s2 += ((d0 * d0 + d1 * d1) + (d2 * d2 + d3 * d3)) + ((d4 * d4 + d5 * d5) + (d6 * d6 + d7 * d7)); }
            rstd = 1.f / sqrtf(wave_sum(s2) * (1.f / D) + LN_EPS);
            }
        }
        if constexpr (PART == 1) {
            Ei[lane] = EIx[(size_t)r * 128 + lane]; Ei[lane + 64] = EIx[(size_t)r * 128 + 64 + lane];
            Eg[lane] = EGx[(size_t)r * 128 + lane]; Eg[lane + 64] = EGx[(size_t)r * 128 + 64 + lane];
        }
        if constexpr (PART != 1)
        for (int rep11_ = 0; rep11_ < (((MK_PROBE) >> 11) & 1) + 1; ++rep11_) {
        {
            unsigned v[32];
#pragma unroll
            for (int i = 0; i < 8; ++i) { typedef _Float16 h4_t __attribute__((ext_vector_type(4))); const h4_t th = *(const h4_t*)(SC + (size_t)r * D + lane * 32 + 4 * i);
                const f32x4 t = {(float)th[0], (float)th[1], (float)th[2], (float)th[3]};
                const f32x4 a1 = *(const LAS f32x4*)(PAR + 8192 + lane * 32 + 4 * i), a0 = *(const LAS f32x4*)(PAR + 10240 + lane * 32 + 4 * i);
                const f32x4 y = (t - a1 * mu) * rstd + a0;
#pragma unroll
                for (int c = 0; c < 4; ++c) { const unsigned u = __float_as_uint(y[c]); const unsigned mono = (u & 0x80000000u) ? ~u : (u | 0x80000000u);
                    v[4 * i + c] = (mono & 0xFFFFFF80u) | (unsigned)(127 - (qd * 32 + 4 * i + c)); } }
            unsigned A[16], B[16];
#pragma unroll
            for (int i = 0; i < 16; ++i) { A[i] = v[i]; B[i] = v[16 + i]; }
            sort16_desc(A); sort16_desc(B);
#pragma unroll
            for (int i = 0; i < 16; ++i) A[i] = A[i] > B[15 - i] ? A[i] : B[15 - i];
            merge16_desc(A);
#pragma unroll
            for (int i = 0; i < 16; ++i) B[i] = (unsigned)__builtin_amdgcn_update_dpp(0, (int)A[15 - i], 0xB1, 0xF, 0xF, true);
#pragma unroll
            for (int i = 0; i < 16; ++i) A[i] = A[i] > B[i] ? A[i] : B[i];
            merge16_desc(A);
#pragma unroll
            for (int i = 0; i < 16; ++i) B[i] = (unsigned)__builtin_amdgcn_update_dpp(0, (int)A[15 - i], 0x4E, 0xF, 0xF, true);
#pragma unroll
            for (int i = 0; i < 16; ++i) A[i] = A[i] > B[i] ? A[i] : B[i];
            merge16_desc(A);
            const int g = lane >> 2;
            const unsigned w0 = qd == 0 ? A[0] : qd == 1 ? A[4] : qd == 2 ? A[8] : A[12], w1 = qd == 0 ? A[1] : qd == 1 ? A[5] : qd == 2 ? A[9] : A[13];
            const unsigned w2 = qd == 0 ? A[2] : qd == 1 ? A[6] : qd == 2 ? A[10] : A[14], w3 = qd == 0 ? A[3] : qd == 1 ? A[7] : qd == 2 ? A[11] : A[15];
            *(LAS v4u*)(K1 + g * 16 + 4 * qd) = (v4u){w0, w1, w2, w3};
        }
        LDS_WAIT();
        {
            const int hh = lane >> 3, sub = lane & 7;
            float sa[7]; int ea[7]; unsigned ka[7];
#pragma unroll
            for (int a = 0; a < 7; ++a) { const int ci_ = (ciw >> (4 * a)) & 15, cj_ = (cjw >> (4 * a)) & 15; const bool ok = (sub + 8 * a) < 50;
                const unsigned k0 = K1[(2 * hh) * 16 + ci_], k1 = K1[(2 * hh + 1) * 16 + cj_];
                const float s = key_val(k0) + key_val(k1);
                sa[a] = s; ea[a] = (127 - (int)(k0 & 127u)) * 128 + (127 - (int)(k1 & 127u));
                const unsigned u = __float_as_uint(s); const unsigned mono = (u & 0x80000000u) ? ~u : (u | 0x80000000u);
                ka[a] = ok ? ((mono & 0xFFFFFFC0u) | (unsigned)(63 - (sub + 8 * a))) : 0u;
                K2[hh * 64 + sub + 8 * a] = ka[a]; }
            if (sub == 0) K2[hh * 64 + 56] = 0u;
            LDS_WAIT();
            int rk[7];
#pragma unroll
            for (int a = 0; a < 7; ++a) rk[a] = 0;
#pragma unroll
            for (int q = 0; q < 14; ++q) { const v4u kb = *(const LAS v4u*)(K2 + hh * 64 + 4 * q);
#pragma unroll
                for (int a = 0; a < 7; ++a) rk[a] += (kb.x > ka[a] ? 1 : 0) + (kb.y > ka[a] ? 1 : 0) + (kb.z > ka[a] ? 1 : 0) + (kb.w > ka[a] ? 1 : 0); }
            const float smax = key_val(K1[(2 * hh) * 16]) + key_val(K1[(2 * hh + 1) * 16]);
            float ex[7]; float part = 0.f;
#pragma unroll
            for (int a = 0; a < 7; ++a) { const bool sel = ka[a] != 0u && rk[a] < 16; ex[a] = sel ? __expf(sa[a] - smax) : 0.f; part += ex[a]; }
            part += __builtin_bit_cast(float, __builtin_amdgcn_update_dpp(0, __builtin_bit_cast(int, part), 0xB1, 0xF, 0xF, true));
            part += __builtin_bit_cast(float, __builtin_amdgcn_update_dpp(0, __builtin_bit_cast(int, part), 0x4E, 0xF, 0xF, true));
            part += __builtin_bit_cast(float, __builtin_amdgcn_update_dpp(0, __builtin_bit_cast(int, part), 0x141, 0xF, 0xF, true));
            const float inv = 1.f / part;
#pragma unroll
            for (int a = 0; a < 7; ++a) if (ka[a] != 0u && rk[a] < 16) { Ei[hh * 16 + rk[a]] = ea[a]; Eg[hh * 16 + rk[a]] = ex[a] * inv; }
        }
        LDS_WAIT();
        }
        v32f x;
        {
            float xl[32];
#pragma unroll
            for (int q = 0; q < 4; ++q) {
                const int e0 = lane * 32 + q * 8;
                const v4u w = rw_[q];
                const f32x4 g0 = *(const LAS f32x4*)(PAR + e0), g1 = *(const LAS f32x4*)(PAR + e0 + 4), b0 = *(const LAS f32x4*)(PAR + 2048 + e0), b1 = *(const LAS f32x4*)(PAR + 2048 + e0 + 4);
                xl[8 * q + 0] = (bflo(w.x) - mu) * rstd * g0.x + b0.x; xl[8 * q + 1] = (bfhi(w.x) - mu) * rstd * g0.y + b0.y;
                xl[8 * q + 2] = (bflo(w.y) - mu) * rstd * g0.z + b0.z; xl[8 * q + 3] = (bfhi(w.y) - mu) * rstd * g0.w + b0.w;
                xl[8 * q + 4] = (bflo(w.z) - mu) * rstd * g1.x + b1.x; xl[8 * q + 5] = (bfhi(w.z) - mu) * rstd * g1.y + b1.y;
                xl[8 * q + 6] = (bflo(w.w) - mu) * rstd * g1.z + b1.z; xl[8 * q + 7] = (bfhi(w.w) - mu) * rstd * g1.w + b1.w;
            }
#pragma unroll
            for (int i = 0; i < 32; ++i) x[MK_FP6_ORDER ? ((i & 15) * 2 + (i >> 4)) : i] = xl[i];
        }
        if constexpr (PART != 1) {
            auto loadu = [&](v6u (&w)[4], int e0) {
#pragma unroll
                for (int k = 0; k < 4; ++k) { const int id = __builtin_amdgcn_readfirstlane(Ei[e0 + k]) & 16383; const unsigned char* up = U6 + (size_t)id * ROW6;
                    const v4u a = *(const v4u*)(up + lane * 16); const v2u b = *(const v2u*)(up + 1024 + lane * 8); w[k] = (v6u){a.x, a.y, a.z, a.w, b.x, b.y}; }
            };
            auto compu = [&](const v6u (&w)[4], int e0) {
                float s[4];
#pragma unroll
                for (int k = 0; k < 4; ++k) { const v32f y = __builtin_amdgcn_cvt_scalef32_pk32_f32_fp6(w[k], 1.0f); f32x2 a = (f32x2){0.f, 0.f};
#pragma unroll
                    for (int i = 0; i < 16; ++i) a += (f32x2){y[2 * i], y[2 * i + 1]} * (f32x2){x[2 * i], x[2 * i + 1]};
                    s[k] = a.x + a.y; }
                float u1;
                { const auto r02 = __builtin_amdgcn_permlane32_swap(__float_as_uint(s[0]), __float_as_uint(s[2]), false, false);
                  const auto r13 = __builtin_amdgcn_permlane32_swap(__float_as_uint(s[1]), __float_as_uint(s[3]), false, false);
                  const float a02 = __uint_as_float(r02[0]) + __uint_as_float(r02[1]), a13 = __uint_as_float(r13[0]) + __uint_as_float(r13[1]);
                  const auto rr = __builtin_amdgcn_permlane16_swap(__float_as_uint(a02), __float_as_uint(a13), false, false);
                  u1 = row16_sum(__uint_as_float(rr[0]) + __uint_as_float(rr[1])); }
                if ((lane & 15) == 0) { const int k = lane >> 4; Eg[e0 + k] = Eg[e0 + k] * gelu_exact(u1 * (1.f / U_SCALE)) * (1.f / V_SCALE); }
            };
            v6u wa[4], wb[4], wc[4];
            loadu(wa, 0); loadu(wb, 4);
#pragma unroll 1
            for (int e0 = 0; e0 < 120; e0 += 12) {
                loadu(wc, e0 + 8);
                compu(wa, e0);
                loadu(wa, e0 + 12);
                compu(wb, e0 + 4);
                loadu(wb, e0 + 16);
                compu(wc, e0 + 8);
            }
            compu(wa, 120); compu(wb, 124);
        }
        LDS_WAIT();
        if constexpr (PART == 0) {
            EIx[(size_t)r * 128 + lane] = Ei[lane]; EIx[(size_t)r * 128 + 64 + lane] = Ei[lane + 64];
            EGx[(size_t)r * 128 + lane] = Eg[lane]; EGx[(size_t)r * 128 + 64 + lane] = Eg[lane + 64];
            if (lane == 0) { STx[2 * r] = mu; STx[2 * r + 1] = rstd; }
            (void)x;
        } else {
        v32f o;
#pragma unroll
        for (int i = 0; i < 32; ++i) o[i] = 0.f;
        {
            auto loadv = [&](v6u (&w)[4], int e0) {
#pragma unroll
                for (int k = 0; k < 4; ++k) { const int id = __builtin_amdgcn_readfirstlane(Ei[e0 + k]) & 16383; const unsigned char* vp = V6 + (size_t)id * ROW6;
                    const v4u a = *(const v4u*)(vp + lane * 16); const v2u b = *(const v2u*)(vp + 1024 + lane * 8); w[k] = (v6u){a.x, a.y, a.z, a.w, b.x, b.y}; }
            };
            auto compv = [&](const v6u (&w)[4], int e0) {
#pragma unroll
                for (int k = 0; k < 4; ++k) { const float wt = Eg[e0 + k]; const v32f y = __builtin_amdgcn_cvt_scalef32_pk32_f32_fp6(w[k], 1.0f); o += y * wt; }
            };
            v6u wa[4], wb[4], wc[4];
            loadv(wa, 0); loadv(wb, 4);
#pragma unroll 1
            for (int e0 = 0; e0 < 120; e0 += 12) {
                loadv(wc, e0 + 8);
                compv(wa, e0);
                loadv(wa, e0 + 12);
                compv(wb, e0 + 4);
                loadv(wb, e0 + 16);
                compv(wc, e0 + 8);
            }
            compv(wa, 120); compv(wb, 124);
        }
        float s1 = 0.f;
#pragma unroll
        for (int i = 0; i < 32; ++i) { o[i] = x[i] * ALPHA + o[i]; s1 += o[i]; }
        const float mean = wave_sum(s1) * (1.f / D); float s2 = 0.f;
#pragma unroll
        for (int i = 0; i < 32; ++i) { o[i] = o[i] - mean; s2 += o[i] * o[i]; }
        const float rstd2 = 1.f / sqrtf(wave_sum(s2) * (1.f / D) + LN_EPS);
#pragma unroll
        for (int q = 0; q < 8; ++q) {
            const int e0 = lane * 32 + q * 4;
            const f32x4 g = *(const LAS f32x4*)(PAR + 4096 + e0), bb = *(const LAS f32x4*)(PAR + 6144 + e0);
            float oo[4];
#pragma unroll
            for (int c = 0; c < 4; ++c) { const int i = q * 4 + c; oo[c] = o[MK_FP6_ORDER ? ((i & 15) * 2 + (i >> 4)) : i]; }
            f32x4 y; y.x = oo[0] * rstd2 * g.x + bb.x; y.y = oo[1] * rstd2 * g.y + bb.y; y.z = oo[2] * rstd2 * g.z + bb.z; y.w = oo[3] * rstd2 * g.w + bb.w;
            *(f32x4*)(p.out + (size_t)r * D + e0) = y;
        }
        }
    }
}

__device__ __forceinline__ void phase_gemm_in(const Params& p, LAS unsigned char* lds) {
    pg8::Gemm g{(const bf16*)(p.ws + WS_H0F8), (const bf16*)(p.ws + WS_BT_IN8), MP, NINP, D / 2};
    pg8::StaticOrder S; S.init(MP, NINP, gridDim.x, blockIdx.x, MK_WGM_IN); S.colmap = MK_COLMAP;
    pg8::EpiInProj E{p.ws, (unsigned char*)p.out};
#if MK_STAG
    { const unsigned long long t0 = wall_clock64(); const unsigned long long d = (unsigned long long)(blockIdx.x & 3) * MK_STAG; while (wall_clock64() - t0 < d) __builtin_amdgcn_s_sleep(8); }
#endif
    pg8::gemm_phase<pg8::EpiInProj, pg8::StaticOrder, true, true, true>(lds, g, S, E);
}
__device__ __forceinline__ void phase_gemm_g2a(const Params& p, LAS unsigned char* lds) {
    pg8::Gemm g{(const bf16*)(p.ws + WS_YA8), (const bf16*)(p.ws + WS_BT_PA), MX, D, D / 2};
    pg8::StaticOrder S; S.init(MX, D, gridDim.x, blockIdx.x, MK_WGM_SQ);
    pg8::EpiGate<false> E{(const bf16*)(MK_DBG == 16 ? p.ws + WS_H0 : MK_DBG == 14 ? p.ws + 489 * MiB : (unsigned char*)p.out + OUT_SGA), nullptr, (bf16*)(p.ws + WS_TMP)};
    pg8::gemm_phase<pg8::EpiGate<false>, pg8::StaticOrder, MK_ALIGN, MK_SP2, true>(lds, g, S, E);
}
__device__ __forceinline__ void phase_gemm_g2b(const Params& p, LAS unsigned char* lds) {
    pg8::Gemm g{(const bf16*)(p.ws + WS_YB), (const bf16*)(p.ws + WS_BT_PB), MX, D, D / 2};
    pg8::StaticOrder S; S.init(MX, D, gridDim.x, blockIdx.x, MK_WGM_SQ);
    pg8::EpiGate<true> E{(const bf16*)((unsigned char*)p.out + OUT_SGB), (const bf16*)(p.ws + WS_TMP), (bf16*)(p.ws + WS_MERGED)};
    pg8::gemm_phase<pg8::EpiGate<true>, pg8::StaticOrder, MK_ALIGN, MK_SP2, true>(lds, g, S, E);
}
__device__ __forceinline__ void phase_gemm_g2(const Params& p, LAS unsigned char* lds) {
    static_assert(WS_YB > WS_YA8 && WS_BT_PB > WS_BT_PA, "the second product's operands sit behind the first's");
    pg8::Gemm g{(const bf16*)(p.ws + WS_YA8), (const bf16*)(p.ws + WS_BT_PA), MX, D, D / 2};
    pg8::StaticOrder S; S.init(MX, D, gridDim.x, blockIdx.x, MK_WGM_SQ);
    pg8::EpiGate2 E{(const unsigned char*)p.out + OUT_SGA, (const unsigned char*)p.out + OUT_SGB, p.ws + WS_MERGED};
    pg8::gemm_phase<pg8::EpiGate2, pg8::StaticOrder, MK_ALIGN, MK_SP2, true>(lds, g, S, E);
}
__device__ __forceinline__ void phase_gemm_g3(const Params& p, LAS unsigned char* lds) {
    pg8::Gemm g{(const bf16*)(p.ws + WS_MERGED), (const bf16*)(p.ws + WS_BT_WO), MX, D, D / 2};
    pg8::StaticOrder S; S.init(MX, D, gridDim.x, blockIdx.x, MK_WGM_SQ);
    pg8::EpiResid E{(const bf16*)(p.ws + WS_H0), (bf16*)(p.ws + WS_R)};
    pg8::gemm_phase<pg8::EpiResid, pg8::StaticOrder, MK_ALIGN, MK_SP2, true>(lds, g, S, E);
}
__device__ __forceinline__ void phase_gemm_pq(const Params& p, LAS unsigned char* lds) {
    pg8::Gemm g{(const bf16*)(p.ws + WS_R), (const bf16*)(p.ws + WS_BT_F), MX, D, D};
    pg8::StaticOrder S; S.init(MX, D, gridDim.x, blockIdx.x, MK_WGM_SQ);
    pg8::EpiScores E{(_Float16*)(p.ws + WS_TMP)};
    pg8::gemm_phase<pg8::EpiScores, pg8::StaticOrder, MK_ALIGN, MK_SP2>(lds, g, S, E);
}


namespace ml {
typedef short s16x4 __attribute__((ext_vector_type(4)));
typedef short bf16x8 __attribute__((ext_vector_type(8)));
typedef float f32x16 __attribute__((ext_vector_type(16)));
using mk::v4u; using mk::f32x4; using mk::bf16; using mk::Params;
constexpr int QROW = 272, KROW = 320, VROW = 576, PROW = 144, HROW = 528;
constexpr int L_QS = 0, L_QS2 = L_QS + 64 * QROW, L_KS = L_QS2 + 64 * QROW, L_VS = L_KS + 64 * KROW, L_PS = L_VS + 64 * VROW, L_HS = L_PS + 64 * PROW;
constexpr int L_VEC = L_HS + 64 * HROW;
constexpr int VECSET = 6 * 256;
constexpr int L_NS = L_VEC + 2 * VECSET;
constexpr int L_DEN = L_NS + 1024;
constexpr int L_TAB = L_DEN + 256;
constexpr int L_END = L_TAB + 1088;
static_assert(L_END <= mk::LDS_BYTES, "mLSTM LDS map");
constexpr size_t STATE_F = 32768 + 128;
constexpr size_t WS_STATE = mk::WS_BT_IN;
constexpr size_t WS_DT = mk::WS_BT_IN + 16 * 16 * STATE_F * 4;
static_assert(WS_DT + 1024 <= mk::WS_CB, "state region");

__device__ __forceinline__ int crow(int reg, int h) { return (reg & 3) + 8 * (reg >> 2) + 4 * h; }
__device__ __forceinline__ float scan_add(float v, int lane) {
#pragma unroll
    for (int o = 1; o < 64; o <<= 1) { const float t = __shfl_up(v, o); if (lane >= o) v += t; }
    return v;
}
__device__ __forceinline__ float scan_max(float v, int lane) {
#pragma unroll
    for (int o = 1; o < 64; o <<= 1) { const float t = __shfl_up(v, o); if (lane >= o) v = fmaxf(v, t); }
    return v;
}
__device__ __forceinline__ float wave_max(float v) {
#pragma unroll
    for (int o = 1; o < 64; o <<= 1) v = fmaxf(v, __shfl_xor(v, o));
    return v;
}
__device__ __forceinline__ void gate_load(const Params& p, int b, int hd, int ci, int lane, float& ip, float& fp) {
    const float* GIF = (const float*)(p.ws + mk::WS_GIF);
    const int row = (ci == 0) ? mk::MX + (lane & 15) : b * mk::SEQ + (ci - 1) * 64 + lane;
    ip = GIF[(size_t)row * 16 + hd]; fp = GIF[(size_t)row * 16 + 8 + hd];
}
__device__ __forceinline__ void gate_math(const Params& p, int hd, int ci, int lane, float ip, float fp, float& li, float& lf) {
    const bool pad = (ci == 0) && lane >= 16;
    ip += p.b_if[hd]; fp += p.b_if[8 + hd];
    li = pad ? -1e30f : ip;
    lf = pad ? 0.f : (fminf(fp, 0.f) - log1pf(__expf(-fabsf(fp))));
}
__device__ __forceinline__ bf16x8 tr_frag(LAS unsigned char* tile, int rowstride, int k0, int n0, int lane) {
    const int h = lane >> 5, blk = (lane >> 4) & 1, q = (lane & 15) >> 2, pp = lane & 3;
    LAS unsigned char* a = tile + (k0 + 8 * h + q) * rowstride + 2 * (n0 + 16 * blk + 4 * pp);
    const s16x4 lo = __builtin_amdgcn_ds_read_tr16_b64_v4i16((LAS s16x4*)a);
    const s16x4 hi = __builtin_amdgcn_ds_read_tr16_b64_v4i16((LAS s16x4*)(a + 4 * rowstride));
    return __builtin_shufflevector(lo, hi, 0, 1, 2, 3, 4, 5, 6, 7);
}
#define ML_MFMA32(a, b, c) __builtin_amdgcn_mfma_f32_32x32x16_bf16((a), (b), (c), 0, 0, 0)
#define ML_MFMA16(a, b, c) __builtin_amdgcn_mfma_f32_16x16x32_bf16((a), (b), (c), 0, 0, 0)

template <bool FULL>
__device__ __forceinline__ void mlstm_pass(const Params& p, LAS unsigned char* lds) {
    const int tid = pg8::ftid(), lane = tid & 63, w = __builtin_amdgcn_readfirstlane(tid >> 6);
    const int r = lane & 31, h5 = lane >> 5;
    const bf16* Qg = (const bf16*)(p.ws + mk::WS_Q); const bf16* Kg = (const bf16*)(p.ws + mk::WS_K); bf16* Vg = (bf16*)(p.ws + mk::WS_V);
    const bf16* SOg = (const bf16*)(p.ws + mk::WS_SIGO);
    float* STATE = (float*)(p.ws + WS_STATE); float* MU = (float*)(p.ws + WS_DT); float* BLS = MU + 256; const float* MSTART = MU + 512;
    LAS float* DEN = (LAS float*)(lds + L_DEN);
    int kc = 0;
    const int cgt = blockIdx.x * 512 + tid, cNT = gridDim.x * 512;
    for (int item = blockIdx.x; item < 256; item += gridDim.x) {
        const int bh = item >> 4, j = item & 15, b = bh >> 3, hd = bh & 7;
        const int nchunks = (j == 0) ? 9 : 8, ci0 = (j == 0) ? 0 : 8 * j + 1;
        float m_prev = FULL ? MSTART[bh * 16 + j] : -INFINITY;
        float blsum = 0.f;
        f32x16 Cacc[4];
        if (FULL && j > 0) {
            const float* src = STATE + ((size_t)bh * 16 + (j - 1)) * STATE_F;
#pragma unroll
            for (int i = 0; i < 4; ++i)
#pragma unroll
                for (int g = 0; g < 16; ++g) Cacc[i][g] = src[((w * 4 + i) * 16 + g) * 64 + lane];
            if (tid < 128) ((LAS float*)(lds + L_NS))[tid] = src[32768 + tid];
        } else {
#pragma unroll
            for (int i = 0; i < 4; ++i)
#pragma unroll
                for (int g = 0; g < 16; ++g) Cacc[i][g] = 0.f;
            if (tid < 128) ((LAS float*)(lds + L_NS))[tid] = 0.f;
        }
        v4u pq[2], pk[2], pv[4];
        auto issue_loads = [&](int ci, int tl) {
            const bool meta = (ci == 0);
            const bf16* kb = meta ? Kg + (size_t)16 * 8192 * 128 + (size_t)hd * 16 * 128 : Kg + ((size_t)bh * 8192 + (ci - 1) * 64) * 128;
            const bf16* vb = meta ? Vg + (size_t)16 * 8192 * 256 + (size_t)hd * 16 * 256 : Vg + ((size_t)bh * 8192 + (ci - 1) * 64) * 256;
            const bf16* qb = Qg + ((size_t)bh * 8192 + (meta ? 0 : (ci - 1) * 64)) * 128;
#pragma unroll
            for (int u = 0; u < 2; ++u) { const int id = tl + 512 * u, rr = id >> 4;
                const bool ok = !meta || rr < 16;
                pk[u] = ok ? *(const v4u*)(kb + (size_t)id * 8) : (v4u){0u, 0u, 0u, 0u};
                if (FULL) pq[u] = !meta ? *(const v4u*)(qb + (size_t)id * 8) : (v4u){0u, 0u, 0u, 0u}; }
#pragma unroll
            for (int u = 0; u < 4; ++u) { const int id = tl + 512 * u, rr = id >> 5;
                const bool ok = !meta || rr < 16;
                pv[u] = ok ? *(const v4u*)(vb + (size_t)id * 8) : (v4u){0u, 0u, 0u, 0u}; }
        };
        { int tl = tid; asm volatile("" : "+v"(tl)); issue_loads(ci0, tl); }
        float gip = 0.f, gfp = 0.f; if (w == 7) gate_load(p, b, hd, ci0, lane, gip, gfp);
        auto make_vec = [&](int kk) {
            const int cix = ci0 + kk;
            LAS float* VS_ = (LAS float*)(lds + L_VEC + (kk & 1) * VECSET);
            float li, lf; gate_math(p, hd, cix, lane, gip, gfp, li, lf);
            if (kk + 1 < nchunks) gate_load(p, b, hd, cix + 1, lane, gip, gfp);
            const float bb = scan_add(lf, lane); const float g = li - bb; const float G = fmaxf(m_prev, scan_max(g, lane));
            const float Gend = __shfl(G, 63), bl = __shfl(bb, 63);
            VS_[lane] = g; VS_[64 + lane] = G; VS_[128 + lane] = __expf(m_prev - G); VS_[192 + lane] = __expf(g - Gend); VS_[256 + lane] = __expf(-(bb + G));
            const float decay = __expf(m_prev - Gend);
            if (lane == 0) VS_[320] = decay;
            blsum += bl; m_prev = bl + Gend;
        };
        if (w == 7) make_vec(0);
#pragma unroll 1
        for (int k = 0; k < nchunks; ++k) {
            const int ci = ci0 + k; const bool meta = (ci == 0); const bool outp = FULL && !meta;
            int tl = tid; asm volatile("" : "+v"(tl));
            const int row0 = meta ? mk::MX : b * mk::SEQ + (ci - 1) * 64;
            LAS float* VEC = (LAS float*)(lds + L_VEC + (k & 1) * VECSET);
            LAS float* NScur = (LAS float*)(lds + L_NS + (k & 1) * 512); LAS float* NSnxt = (LAS float*)(lds + L_NS + ((k + 1) & 1) * 512);
#pragma unroll
            for (int u = 0; u < 2; ++u) { const int id = tid + 512 * u, rr = id >> 4, cp = id & 15;
                *(LAS v4u*)(lds + L_KS + rr * KROW + 16 * cp) = pk[u];
                if (FULL) *(LAS v4u*)(lds + L_QS + rr * QROW + 16 * cp) = pq[u]; }
#pragma unroll
            for (int u = 0; u < 4; ++u) { const int id = tid + 512 * u, rr = id >> 5, cp = id & 31; *(LAS v4u*)(lds + L_VS + rr * VROW + 16 * cp) = pv[u]; }
            __syncthreads();
            if (!FULL && k + 1 < nchunks) issue_loads(ci + 1, tl);
            mk::v2u czm2 = {0u, 0u}, czm1 = {0u, 0u}, cz[4], ccb[4]; int cs = -1;
            if (!FULL) { const int s_ = tl - tid + cgt + cNT * kc; if (k < 8 && s_ < mk::CONV_SLICES) { cs = s_; mk::conv_issue(p, cs, czm2, czm1, cz, ccb); ++kc; } }
            if (outp) {
#pragma unroll
                for (int u = 0; u < 2; ++u) { const int id = tid + 512 * u, rr = id >> 4, cp = id & 15; const float s = VEC[128 + rr]; const v4u q = pq[u];
                    v4u o; o.x = mk::pk2(mk::bflo(q.x) * s, mk::bfhi(q.x) * s); o.y = mk::pk2(mk::bflo(q.y) * s, mk::bfhi(q.y) * s); o.z = mk::pk2(mk::bflo(q.z) * s, mk::bfhi(q.z) * s); o.w = mk::pk2(mk::bflo(q.w) * s, mk::bfhi(q.w) * s);
                    *(LAS v4u*)(lds + L_QS2 + rr * QROW + 16 * cp) = o; }
            }
            if (outp) {
                const int ti = w >> 1, fr = lane & 15, fq = lane >> 4;
#pragma unroll
                for (int tt = 0; tt < 2; ++tt) { const int tj = 2 * (w & 1) + tt;
                    f32x4 sacc = (f32x4){0.f, 0.f, 0.f, 0.f};
                    if (tj <= ti) {
#pragma unroll
                        for (int kk = 0; kk < 4; ++kk) {
                            const bf16x8 a = *(const LAS bf16x8*)(lds + L_QS + (16 * ti + fr) * QROW + 2 * (32 * kk + 8 * fq));
                            const bf16x8 bb = *(const LAS bf16x8*)(lds + L_KS + (16 * tj + fr) * KROW + 2 * (32 * kk + 8 * fq));
                            sacc = ML_MFMA16(a, bb, sacc);
                        }
                    }
                    const int s = 16 * tj + fr; const float gs = VEC[s];
#pragma unroll
                    for (int i = 0; i < 4; ++i) { const int t = 16 * ti + 4 * fq + i; const float Gt = VEC[64 + t];
                        const float wgt = (s <= t) ? __expf(gs - Gt) : 0.f; const float pv_ = sacc[i] * wgt;
                        *(LAS unsigned short*)(lds + L_PS + t * PROW + 2 * s) = (unsigned short)(mk::pk2(pv_, 0.f) & 0xffffu); }
                }
            }
            __syncthreads();
            if (w == 7 && k + 1 < nchunks) make_vec(k + 1);
            v4u po[4];
            if (outp) {
#pragma unroll
                for (int u = 0; u < 4; ++u) po[u] = *(const v4u*)(SOg + ((size_t)bh * 8192 + (ci - 1) * 64 + (tl >> 3)) * 256 + 32 * (tl & 7) + 8 * u);
            }
            bf16x8 vf[4];
#pragma unroll
            for (int ks = 0; ks < 4; ++ks) vf[ks] = tr_frag(lds + L_VS, VROW, 16 * ks, 32 * w, lane);
            f32x16 Hacc[2];
            if (outp) {
#pragma unroll
                for (int ti = 0; ti < 2; ++ti) {
#pragma unroll
                    for (int g = 0; g < 16; ++g) Hacc[ti][g] = 0.f;
#pragma unroll
                    for (int ks = 0; ks < 4; ++ks) { const bf16x8 a = *(const LAS bf16x8*)(lds + L_PS + (32 * ti + r) * PROW + 2 * (16 * ks + 8 * h5)); Hacc[ti] = ML_MFMA32(a, vf[ks], Hacc[ti]); }
                    asm volatile("" ::: "memory");
                }
#pragma unroll
                for (int i = 0; i < 4; ++i)
#pragma unroll
                    for (int s = 0; s < 2; ++s) {
                        v4u cb; cb.x = mk::pk2(Cacc[i][8 * s], Cacc[i][8 * s + 1]); cb.y = mk::pk2(Cacc[i][8 * s + 2], Cacc[i][8 * s + 3]); cb.z = mk::pk2(Cacc[i][8 * s + 4], Cacc[i][8 * s + 5]); cb.w = mk::pk2(Cacc[i][8 * s + 6], Cacc[i][8 * s + 7]);
                        const bf16x8 bfrag = __builtin_bit_cast(bf16x8, cb);
#pragma unroll
                        for (int ti = 0; ti < 2; ++ti) {
                            const LAS unsigned char* qa = lds + L_QS2 + (32 * ti + r) * QROW + 2 * (32 * i + 16 * s + 4 * h5);
                            const s16x4 lo = *(const LAS s16x4*)qa, hi = *(const LAS s16x4*)(qa + 16);
                            Hacc[ti] = ML_MFMA32(__builtin_shufflevector(lo, hi, 0, 1, 2, 3, 4, 5, 6, 7), bfrag, Hacc[ti]);
                        }
                        asm volatile("" ::: "memory");
                    }
                { const int t = tid >> 3, part = tid & 7;
                  const v4u pr = *(const LAS v4u*)(lds + L_PS + t * PROW + 16 * part);
                  float d = ((mk::bflo(pr.x) + mk::bfhi(pr.x)) + (mk::bflo(pr.y) + mk::bfhi(pr.y))) + ((mk::bflo(pr.z) + mk::bfhi(pr.z)) + (mk::bflo(pr.w) + mk::bfhi(pr.w)));
#pragma unroll
                  for (int u = 0; u < 2; ++u) { const v4u qv = *(const LAS v4u*)(lds + L_QS2 + t * QROW + 32 * part + 16 * u); const LAS float* nn = NScur + 16 * part + 8 * u;
                      d += mk::bflo(qv.x) * nn[0] + mk::bfhi(qv.x) * nn[1] + mk::bflo(qv.y) * nn[2] + mk::bfhi(qv.y) * nn[3] + mk::bflo(qv.z) * nn[4] + mk::bfhi(qv.z) * nn[5] + mk::bflo(qv.w) * nn[6] + mk::bfhi(qv.w) * nn[7]; }
                  d = mk::oct_sum(d);
                  if (part == 0) DEN[t] = d; }
            }
            if (outp) {
#pragma unroll
                for (int ti = 0; ti < 2; ++ti)
#pragma unroll
                    for (int g = 0; g < 16; ++g) *(LAS unsigned short*)(lds + L_HS + (32 * ti + crow(g, h5)) * HROW + 2 * (32 * w + r)) = (unsigned short)(mk::pk2(Hacc[ti][g], 0.f) & 0xffffu);
            }
            if (FULL && k + 1 < nchunks) issue_loads(ci + 1, tl);
            {
                const float decay = VEC[320];
#pragma unroll
                for (int ks = 0; ks < 4; ++ks) { const f32x4 w0 = *(const LAS f32x4*)(VEC + 192 + 16 * ks + 8 * h5), w1 = *(const LAS f32x4*)(VEC + 192 + 16 * ks + 8 * h5 + 4);
                    const v4u x = __builtin_bit_cast(v4u, vf[ks]); v4u o;
                    o.x = mk::pk2(mk::bflo(x.x) * w0.x, mk::bfhi(x.x) * w0.y); o.y = mk::pk2(mk::bflo(x.y) * w0.z, mk::bfhi(x.y) * w0.w);
                    o.z = mk::pk2(mk::bflo(x.z) * w1.x, mk::bfhi(x.z) * w1.y); o.w = mk::pk2(mk::bflo(x.w) * w1.z, mk::bfhi(x.w) * w1.w);
                    vf[ks] = __builtin_bit_cast(bf16x8, o); }
#pragma unroll
                for (int i = 0; i < 4; ++i) {
#pragma unroll
                    for (int g = 0; g < 16; ++g) Cacc[i][g] *= decay;
#pragma unroll
                    for (int ks = 0; ks < 4; ++ks) { const bf16x8 a = tr_frag(lds + L_KS, KROW, 16 * ks, 32 * i, lane); Cacc[i] = ML_MFMA32(a, vf[ks], Cacc[i]); }
                    asm volatile("" ::: "memory");
                }
                if (tid < 128) { float a = decay * NScur[tid];
#pragma unroll 8
                    for (int s = 0; s < 64; ++s) a += VEC[192 + s] * mk::bf2f(*(const LAS unsigned short*)(lds + L_KS + s * KROW + 2 * tid));
                    NSnxt[tid] = a; }
            }
            if (!FULL) { if (cs >= 0) mk::conv_finish(p, cs, czm2, czm1, cz, ccb); }
            __syncthreads();
            if (outp) {
                const int t = tl >> 3, part = tl & 7;
                v4u hv[4]; float ss = 0.f;
#pragma unroll
                for (int u = 0; u < 4; ++u) { hv[u] = *(const LAS v4u*)(lds + L_HS + t * HROW + 2 * (32 * part + 8 * u));
                    const float a0 = mk::bflo(hv[u].x), a1 = mk::bfhi(hv[u].x), a2 = mk::bflo(hv[u].y), a3 = mk::bfhi(hv[u].y), a4 = mk::bflo(hv[u].z), a5 = mk::bfhi(hv[u].z), a6 = mk::bflo(hv[u].w), a7 = mk::bfhi(hv[u].w);
                    ss += ((a0 * a0 + a1 * a1) + (a2 * a2 + a3 * a3)) + ((a4 * a4 + a5 * a5) + (a6 * a6 + a7 * a7)); }
                ss = mk::oct_sum(ss);
                const float inv = 1.f / fmaxf(fabsf(DEN[t]), VEC[256 + t]);
                const float sc = inv / sqrtf(inv * inv * ss * (1.f / 256.f) + mk::LN_EPS);
                const float* nw = p.mh_w + hd * 256 + 32 * part; asm volatile("" : "+v"(nw));
                unsigned char* dst = p.ws + mk::WS_YB + (size_t)(row0 + t) * 2048 + hd * 256 + 32 * part;
                unsigned o8[8];
#pragma unroll
                for (int u = 0; u < 4; ++u) { const f32x4 n0 = *(const f32x4*)(nw + 8 * u), n1 = *(const f32x4*)(nw + 8 * u + 4); const v4u so = po[u], hh = hv[u];
                    o8[2 * u] = mk::pk4_fp8(mk::bflo(so.x) * n0.x * sc * mk::bflo(hh.x), mk::bfhi(so.x) * n0.y * sc * mk::bfhi(hh.x), mk::bflo(so.y) * n0.z * sc * mk::bflo(hh.y), mk::bfhi(so.y) * n0.w * sc * mk::bfhi(hh.y));
                    o8[2 * u + 1] = mk::pk4_fp8(mk::bflo(so.z) * n1.x * sc * mk::bflo(hh.z), mk::bfhi(so.z) * n1.y * sc * mk::bfhi(hh.z), mk::bflo(so.w) * n1.z * sc * mk::bflo(hh.w), mk::bfhi(so.w) * n1.w * sc * mk::bfhi(hh.w)); }
                *(v4u*)dst = (v4u){o8[0], o8[1], o8[2], o8[3]}; *(v4u*)(dst + 16) = (v4u){o8[4], o8[5], o8[6], o8[7]};
            }
        }
        if (!FULL) {
            float* dst = STATE + ((size_t)bh * 16 + j) * STATE_F;
#pragma unroll
            for (int i = 0; i < 4; ++i)
#pragma unroll
                for (int g = 0; g < 16; ++g) dst[((w * 4 + i) * 16 + g) * 64 + lane] = Cacc[i][g];
            if (tid < 128) dst[32768 + tid] = ((LAS float*)(lds + L_NS + (nchunks & 1) * 512))[tid];
            if (tid == 448) { MU[bh * 16 + j] = m_prev; BLS[bh * 16 + j] = blsum; }
        }
        __syncthreads();
    }
    if (!FULL) {
#pragma unroll 1
        for (;; ++kc) { const long long s_ = (long long)cgt + (long long)cNT * kc; if (s_ >= mk::CONV_SLICES) break;
            mk::v2u czm2, czm1, cz[4], ccb[4]; mk::conv_issue(p, (int)s_, czm2, czm1, cz, ccb); mk::conv_finish(p, (int)s_, czm2, czm1, cz, ccb); }
    }
}
__device__ __forceinline__ void mlstm_combine(const Params& p) {
    float* STATE = (float*)(p.ws + WS_STATE); const float* MU = (const float*)(p.ws + WS_DT); const float* BLS = MU + 256; float* MSTART = (float*)(p.ws + WS_DT) + 512;
    const int tid = pg8::ftid();
#pragma unroll 1
    for (int w = blockIdx.x; w < 256; w += gridDim.x) {
        const int bh = w >> 4, sub = w & 15;
        float dj[15], sa[15]; float mm = 0.f;
        if (sub == 0 && tid == 0) MSTART[bh * 16] = 0.f;
#pragma unroll
        for (int j = 0; j < 15; ++j) {
            const float mu = MU[bh * 16 + j], bls = BLS[bh * 16 + j];
            const float mn = bls + fmaxf(mm, mu - bls);
            dj[j] = __expf(mm + bls - mn); sa[j] = __expf(mu - mn); mm = mn;
            if (sub == 0 && tid == 0) MSTART[bh * 16 + j + 1] = mn;
        }
        float a[5][15];
#pragma unroll
        for (int k = 0; k < 5; ++k) { const int el = sub * 512 + tid + k * 8192; const bool ok = el < STATE_F;
#pragma unroll
            for (int j = 0; j < 15; ++j) a[k][j] = ok ? STATE[((size_t)bh * 16 + j) * STATE_F + el] : 0.f; }
#pragma unroll
        for (int k = 0; k < 5; ++k) { float c = 0.f;
#pragma unroll
            for (int j = 0; j < 15; ++j) { c = dj[j] * c + sa[j] * a[k][j]; a[k][j] = c; } }
#pragma unroll
        for (int k = 0; k < 5; ++k) { const int el = sub * 512 + tid + k * 8192;
            if (el < STATE_F) {
#pragma unroll
                for (int j = 0; j < 15; ++j) STATE[((size_t)bh * 16 + j) * STATE_F + el] = a[k][j]; } }
    }
}
}
typedef GAS unsigned gu32;
#define XB_TMO      128
#define XB_XCNT(j)  (256  + 64 * (j))
#define XB_XSUB(j)  (1280 + 64 * (j))
#define XB_XGEN(j)  (2304 + 64 * (j))
#define XB_TOP      3328
#define XB_TOPGEN   3392
#define XCD_BAR_WORDS 3456
#define XB_SPIN_CAP (1u << 18)

__device__ __forceinline__ unsigned xb_ld(unsigned* p)              { return __hip_atomic_load(p, __ATOMIC_RELAXED, __HIP_MEMORY_SCOPE_AGENT); }
__device__ __forceinline__ unsigned xb_add(unsigned* p, unsigned v) { return __hip_atomic_fetch_add(p, v, __ATOMIC_RELAXED, __HIP_MEMORY_SCOPE_AGENT); }
__device__ __forceinline__ unsigned xb_xcc_id() { return (unsigned)__builtin_amdgcn_s_getreg((3 << 11) | 20) & 0xFu; }
#define XB_SPIN(cond, bar) do { unsigned _sp = 0; while (cond) { __builtin_amdgcn_s_sleep(1); \
    if ((++_sp & 255u) == 0u) { if (xb_ld(&(bar)[XB_TMO])) break; if (_sp > XB_SPIN_CAP) { atomicAdd(&(bar)[XB_TMO], 1u); break; } } } } while (0)

struct XcdBarrier {
    unsigned* bar; unsigned x;
    volatile LAS unsigned* st;
};

__device__ __forceinline__ XcdBarrier xcd_barrier_post(unsigned* bar, volatile LAS unsigned* st) {
    XcdBarrier b; b.bar = bar; b.x = xb_xcc_id(); b.st = st;
    if (threadIdx.x == 0) (void)xb_add(&bar[XB_XCNT(b.x)], 1u);
    return b;
}
__device__ __forceinline__ void xcd_barrier_complete(unsigned* bar, unsigned x, unsigned& nloc, unsigned& nx) {
    const unsigned G = gridDim.x * gridDim.y * gridDim.z;
    unsigned sum, cnt, mine, sp = 0u;
    for (;;) {
        sum = 0u; cnt = 0u; mine = 0u;
#pragma unroll 1
        for (unsigned j = 0; j < 16; ++j) { const unsigned c = xb_ld(&bar[XB_XCNT(j)]); sum += c; cnt += (c > 0u) ? 1u : 0u; mine = (j == x) ? c : mine; }
        if (sum == G) break;
        __builtin_amdgcn_s_sleep(1);
        if ((++sp & 255u) == 0u) { if (xb_ld(&bar[XB_TMO])) break; if (sp > XB_SPIN_CAP) { atomicAdd(&bar[XB_TMO], 1u); break; } }
    }
    nloc = mine > 0u ? mine : 1u; nx = cnt > 0u ? cnt : 1u;
}

__device__ __forceinline__ void xcd_barrier(const XcdBarrier& b) {
    asm volatile("s_waitcnt vmcnt(0)" ::: "memory");
    __syncthreads();
    if (threadIdx.x == 0) {
        unsigned* bar = b.bar;
        __builtin_amdgcn_s_waitcnt(0);
        unsigned nloc = b.st[0], nx = b.st[1];
        if (nloc == 0u) { xcd_barrier_complete(bar, b.x, nloc, nx); b.st[0] = nloc; b.st[1] = nx; }
        const unsigned old = xb_add(&bar[XB_XSUB(b.x)], 1u);
        const unsigned gen = old / nloc;
        if (old + 1u == (gen + 1u) * nloc) {
            __builtin_amdgcn_fence(__ATOMIC_RELEASE, "agent");
            asm volatile("s_waitcnt vmcnt(0)" ::: "memory");
            const unsigned og = xb_add(&bar[XB_TOP], 1u);
            const unsigned tg = og / nx;
            if (og + 1u == (tg + 1u) * nx) xb_add(&bar[XB_TOPGEN], 1u);
            else XB_SPIN(xb_ld(&bar[XB_TOPGEN]) == tg, bar);
            __builtin_amdgcn_fence(__ATOMIC_ACQUIRE, "agent");
            xb_add(&bar[XB_XGEN(b.x)], 1u);
            asm volatile("s_waitcnt vmcnt(0)" ::: "memory");
        } else {
            XB_SPIN(xb_ld(&bar[XB_XGEN(b.x)]) == gen, bar);
            __builtin_amdgcn_fence(__ATOMIC_ACQUIRE, "agent");
            asm volatile("s_waitcnt vmcnt(0)" ::: "memory");
        }
    }
    __syncthreads();
}

constexpr int CW_BAR = 4096;
constexpr int LDS_BARST = LDS_BYTES - 64;
static_assert((CW_BAR + XCD_BAR_WORDS) * 4 <= 65536, "barrier words inside the memset region");
__global__ void __launch_bounds__(512, 2) k_fused(Params p) {
    extern __shared__ __attribute__((aligned(16))) unsigned char lds_raw[]; LAS unsigned char* lds = (LAS unsigned char*)lds_raw;
    if (pg8::ftid() < 16) ((LAS unsigned*)(lds + LDS_BARST))[pg8::ftid()] = 0u;
    __syncthreads();
    (void)xcd_barrier_post((unsigned*)(p.ws + WS_CTL) + CW_BAR, (volatile LAS unsigned*)(lds + LDS_BARST));
#define GRID_SYNC() do { XcdBarrier b_; b_.bar = (unsigned*)(p.ws + WS_CTL) + CW_BAR; b_.x = xb_xcc_id(); b_.st = (volatile LAS unsigned*)(lds + LDS_BARST); xcd_barrier(b_); } while (0)
#define MK_REP(bit) for (int rep_ = 0; rep_ < (((MK_PROBE) >> (bit)) & 1) + 1; ++rep_)
    MK_REP(0) { phase0(p, lds); GRID_SYNC(); }
    MK_REP(1) { phase_gemm_in(p, lds); phase_uvconv_early(p); GRID_SYNC(); }
    MK_REP(2) { ml::mlstm_pass<false>(p, lds); } phase_c1c0(p); GRID_SYNC();
    ml::mlstm_combine(p); GRID_SYNC();
    MK_REP(8) { ml::mlstm_pass<true>(p, lds); } GRID_SYNC();
    MK_REP(3) { phase_uvconv(p); }
    MK_REP(4) { phase_gemm_g2(p, lds); } GRID_SYNC();
    MK_REP(5) { phase_gemm_g3(p, lds); GRID_SYNC(); }
    MK_REP(6) { phase_gemm_pq(p, lds); GRID_SYNC(); }
    if ((MK_PROBE >> 7) & 1) { for (int i = 0; i < 8; ++i) GRID_SYNC(); }
#if MK_PEER_SPLIT
    phase_peer<0>(p, lds); GRID_SYNC(); phase_peer<1>(p, lds);
#else
    phase_peer<2>(p, lds);
#endif
}
}

extern "C" void kernel_launch(void* const* d_in, const int* in_sizes, int n_in, void* d_out, int out_size, void* d_ws, size_t ws_size, hipStream_t stream) {
    using namespace mk;
    static int grid = 0;
    if (grid == 0) {
        if (n_in != 19 || ws_size < WS_END || out_size != MX * D) { fprintf(stderr, "kernel_launch: unexpected shapes (n_in %d, ws %zu, out %d)\n", n_in, ws_size, out_size); grid = -1; return; }
        if (hipFuncSetAttribute((const void*)k_fused, hipFuncAttributeMaxDynamicSharedMemorySize, LDS_BYTES) != hipSuccess) { fprintf(stderr, "kernel_launch: hipFuncSetAttribute failed\n"); grid = -1; return; }
        int dev = 0, cus = 0, per_cu = 0; (void)hipGetDevice(&dev); (void)hipDeviceGetAttribute(&cus, hipDeviceAttributeMultiprocessorCount, dev);
        if (hipOccupancyMaxActiveBlocksPerMultiprocessor(&per_cu, (const void*)k_fused, 512, LDS_BYTES) != hipSuccess || per_cu < 1) { fprintf(stderr, "kernel_launch: occupancy query says %d blocks per CU\n", per_cu); grid = -1; return; }
        grid = cus;
    }
    if (grid < 0) return;
    Params p{};
    const float** pf = (const float**)&p;
    for (int i = 0; i < 19; ++i) pf[i] = (const float*)d_in[i];
    p.out = (float*)d_out; p.ws = (unsigned char*)d_ws;
    if (hipMemsetAsync((char*)d_ws + WS_CTL, 0, 65536, stream) != hipSuccess) { fprintf(stderr, "kernel_launch: hipMemsetAsync of the barrier words failed\n"); return; }
    hipLaunchKernelGGL(k_fused, dim3(grid), dim3(512), LDS_BYTES, stream, p);
}
```

```cpp
#include <hip/hip_runtime.h>
#include <hip/hip_cooperative_groups.h>
#include <cstdio>
#include <cstdint>
namespace pg8 {
__device__ __forceinline__ int ftid() { int t = threadIdx.x; asm volatile("" : "+v"(t)); return t; }
#define PG8_LAS __attribute__((address_space(3)))
typedef unsigned short bf16_t;
typedef short bf16x8 __attribute__((ext_vector_type(8)));
typedef float f32x4 __attribute__((ext_vector_type(4)));
typedef unsigned u32x4 __attribute__((ext_vector_type(4)));
constexpr int BM = 256, BK = 64, HALF = 128, HTB = HALF * BK * 2  , STAGE_BYTES = 8 * HTB, NXCD = 8, WGM = 8;

__host__ __device__ __forceinline__ int lds_byte(int r, int c) { const int st = (r >> 4) * 2 + (c >> 5), rr = r & 15, cc = c & 31, ob = rr * 64 + cc * 2; return st * 1024 + (ob ^ (((ob >> 9) & 1) << 5)); }
__host__ __device__ __forceinline__ void stage_rc(int b, int& R, int& C) { const int st = b / 1024, sb = b % 1024, swz = sb ^ (((sb >> 9) & 1) << 5); R = (st >> 1) * 16 + swz / 64; C = (st & 1) * 32 + (swz % 64) / 2; }
__host__ __device__ __forceinline__ int perm32(int rho) { const int n = rho >> 4, i = rho & 15; return 8 * (i >> 2) + 4 * n + (i & 3); }

struct Unit { int pm, pn; };
struct Gemm { const bf16_t* A; const bf16_t* Bt; int M, N, K; };

struct StaticOrder {
    int nM, nN, nwg, G, c, wgm;
    __host__ __device__ void init(int M, int N, int G_, int c_, int wgm_ = WGM) { nM = M / BM; nN = N / BM; nwg = nM * nN; G = G_; c = c_; wgm = wgm_; }
    __host__ __device__ bool next(int i, Unit& u) const {
        const long L = (long)i * G + c; if (L >= nwg) return false;
        int wgid = (int)L; { const int q = nwg / NXCD, r = nwg % NXCD, xcd = wgid % NXCD, off = wgid / NXCD; wgid = (xcd < r ? xcd * (q + 1) : r * (q + 1) + (xcd - r) * q) + off; }
        const int nig = wgm * nN, gid = wgid / nig, fm = gid * wgm, gsz = (nM - fm) < wgm ? (nM - fm) : wgm;
        u.pm = fm + ((wgid % nig) % gsz); u.pn = (wgid % nig) / gsz;
        if (colmap) { const int s = u.pn; u.pn = s < 4 ? 24 + s : s < 29 ? 36 + s : s < 41 ? s - 1 : s - 41; }
        return true;
    }
    int colmap = 0;
    __device__ __forceinline__ void a_ready(const Unit&) const {}
    __device__ __forceinline__ void done(const Unit&) const {}
};

typedef __bf16 bf16x2_t __attribute__((ext_vector_type(2)));
__device__ __forceinline__ unsigned cvt_pk_bf16(float lo, float hi) { bf16x2_t v; v[0] = (__bf16)lo; v[1] = (__bf16)hi; return __builtin_bit_cast(unsigned, v); }
typedef float f32x2 __attribute__((ext_vector_type(2)));
__device__ __forceinline__ f32x2 gelu_pk(f32x2 v) {
    const f32x2 av = __builtin_elementwise_abs(v), d = av * 0.2316418882f + 1.0f;
    f32x2 t; t.x = __builtin_amdgcn_rcpf(d.x); t.y = __builtin_amdgcn_rcpf(d.y);
    f32x2 q = t * 0.5307027145f + (-0.7265760135f); q = q * t + 0.7107068705f; q = q * t + (-0.142248368f); q = q * t + 0.127414796f; q = q * t;
    const f32x2 s = (v * v) * (-0.72134752044f);
    f32x2 e; e.x = __builtin_amdgcn_exp2f(s.x); e.y = __builtin_amdgcn_exp2f(s.y);
    const f32x2 m = v * (q * e), r = v - m;
    f32x2 o; o.x = v.x < 0.f ? m.x : r.x; o.y = v.y < 0.f ? m.y : r.y; return o;
}

template <int ACT  > struct EpiBf16 {
    static constexpr bool PERM = true, AFTER_DRAIN = false; static_assert(ACT == 0 || ACT == 1, "EpiBf16: ACT is 0 (none) or 1 (gelu_pk)");
    bf16_t* O; int ldc; const float* bias; int split_cols; size_t split_stride; float scale0;
    __device__ __forceinline__ void operator()(const f32x4 (&acc)[2][2][4][2], const Unit& u, int wr, int wc, int fr, int fq) const {
        const int row0 = u.pm * BM + wr * 64 + fr; int colt = u.pn * BM; bf16_t* base = O;
        float sc = 1.f; if (split_cols) { const int t = colt / split_cols; base += (size_t)t * split_stride; colt -= t * split_cols; if (t == 0) sc = scale0; }
        const int col0 = colt + wc * 32 + 8 * fq, bcol0 = u.pn * BM + wc * 32 + 8 * fq;
        f32x4 bv[2][2];
#pragma unroll
        for (int bj = 0; bj < 2; ++bj)
#pragma unroll
            for (int n = 0; n < 2; ++n) bv[bj][n] = bias ? *(const f32x4*)(bias + bcol0 + bj * HALF + 4 * n) : (f32x4){0.f, 0.f, 0.f, 0.f};
#pragma unroll
        for (int ai = 0; ai < 2; ++ai)
#pragma unroll
            for (int m = 0; m < 4; ++m) { bf16_t* rowp = base + (size_t)(row0 + ai * HALF + m * 16) * ldc + col0;
#pragma unroll
                for (int bj = 0; bj < 2; ++bj) { f32x4 v0 = acc[ai][bj][m][0] + bv[bj][0], v1 = acc[ai][bj][m][1] + bv[bj][1];
                    if (ACT == 1) { f32x2 a = gelu_pk((f32x2){v0[0], v0[1]}), b = gelu_pk((f32x2){v0[2], v0[3]}), c = gelu_pk((f32x2){v1[0], v1[1]}), d = gelu_pk((f32x2){v1[2], v1[3]});
                        v0 = (f32x4){a.x, a.y, b.x, b.y}; v1 = (f32x4){c.x, c.y, d.x, d.y}; }
                    v0 = v0 * sc; v1 = v1 * sc; u32x4 w; w.x = cvt_pk_bf16(v0[0], v0[1]); w.y = cvt_pk_bf16(v0[2], v0[3]); w.z = cvt_pk_bf16(v1[0], v1[1]); w.w = cvt_pk_bf16(v1[2], v1[3]);
                    *(u32x4*)(rowp + bj * HALF) = w; } }
    }
};
typedef int i32x4 __attribute__((ext_vector_type(4)));
__device__ __forceinline__ const char* sgpr_ptr(const char* p) { const unsigned long long u = (unsigned long long)p; const unsigned lo = __builtin_amdgcn_readfirstlane((unsigned)u), hi = __builtin_amdgcn_readfirstlane((unsigned)(u >> 32)); return (const char*)(((unsigned long long)hi << 32) | lo); }
typedef int i32x8 __attribute__((ext_vector_type(8)));
template <bool FP8> __device__ __forceinline__ f32x4 mma_step(const i32x8& b, const i32x8& a, f32x4 c) {
    if constexpr (FP8) {
        return __builtin_amdgcn_mfma_scale_f32_16x16x128_f8f6f4(b, a, c, 0, 0, 0, 0x79797979, 0, 0x7f7f7f7f);
    } else {
        const bf16x8 b0 = __builtin_bit_cast(bf16x8, (i32x4)__builtin_shufflevector(b, b, 0, 1, 2, 3)), b1 = __builtin_bit_cast(bf16x8, (i32x4)__builtin_shufflevector(b, b, 4, 5, 6, 7));
        const bf16x8 a0 = __builtin_bit_cast(bf16x8, (i32x4)__builtin_shufflevector(a, a, 0, 1, 2, 3)), a1 = __builtin_bit_cast(bf16x8, (i32x4)__builtin_shufflevector(a, a, 4, 5, 6, 7));
        c = __builtin_amdgcn_mfma_f32_16x16x32_bf16(b0, a0, c, 0, 0, 0);
        return __builtin_amdgcn_mfma_f32_16x16x32_bf16(b1, a1, c, 0, 0, 0);
    }
}
template <class E, class = void> struct epi_dual { static constexpr bool v = false; };
template <class E> struct epi_dual<E, decltype((void)E::DUAL)> { static constexpr bool v = E::DUAL; };
template <class Epi, class Sched, bool ALIGN_EPI = false, bool SP2 = false, bool FP8 = false>
__device__ __forceinline__ void gemm_phase(PG8_LAS unsigned char* lds, const Gemm g, const Sched& S, const Epi& E) {
    const int tid = ftid(), wid = __builtin_amdgcn_readfirstlane(tid >> 6), lane = tid & 63, wr = wid >> 2, wc = wid & 3, fr = lane & 15, fq = lane >> 4;
    constexpr bool DUAL = epi_dual<Epi>::v;
    const int K = g.K, nth = K / BK;
    size_t jA = 0, jB = 0; if constexpr (DUAL) { jA = Epi::jA; jB = Epi::jB; }
    unsigned voffA, voffB;
    { int R, C; stage_rc(tid * 16, R, C); const int Rb = Epi::PERM ? ((R & ~31) + perm32(R & 31)) : R; voffA = (unsigned)(R * K + C) * 2u; voffB = (unsigned)(Rb * K + C) * 2u; }
    const size_t pstep = (size_t)64 * K * 2;
    const size_t kstep = (size_t)(BK * 2);
    const size_t hstep = (size_t)HALF * K * 2;
    const size_t tstep = 2 * hstep;
    const unsigned ldsw = (unsigned)wid * 1024u;
    const int aoff = lds_byte(wr * 64 + fr, fq * 8), boff = lds_byte(wc * 32 + fr, fq * 8);
#define PG8_SA(b, h) (((b) * 2 + (h)) * HTB)
#define PG8_SB(b, h) ((4 + (b) * 2 + (h)) * HTB)
#define PG8_STAGE(bufoff, gbase, voff) do { _Pragma("unroll") for (int _i = 0; _i < 2; ++_i) { const char* gb_ = sgpr_ptr((const char*)(gbase) + _i * pstep); unsigned vo_ = (voff); asm volatile("" : "+v"(vo_)); \
        __builtin_amdgcn_global_load_lds((const unsigned*)(gb_ + vo_), (PG8_LAS unsigned*)(lds + (bufoff) + ldsw + _i * 8192), 16, 0, 0); } } while (0)
#define PG8_LDA(dst, b, h) do { _Pragma("unroll") for (int m = 0; m < 4; ++m) { const i32x4 lo_ = *(const PG8_LAS i32x4*)(lds + PG8_SA(b, h) + aoff + m * 2048), hi_ = *(const PG8_LAS i32x4*)(lds + PG8_SA(b, h) + aoff + m * 2048 + 1024); dst[m] = __builtin_shufflevector(lo_, hi_, 0, 1, 2, 3, 4, 5, 6, 7); } } while (0)
#define PG8_LDB(dst, b, h) do { _Pragma("unroll") for (int n = 0; n < 2; ++n) { const i32x4 lo_ = *(const PG8_LAS i32x4*)(lds + PG8_SB(b, h) + boff + n * 2048), hi_ = *(const PG8_LAS i32x4*)(lds + PG8_SB(b, h) + boff + n * 2048 + 1024); dst[n] = __builtin_shufflevector(lo_, hi_, 0, 1, 2, 3, 4, 5, 6, 7); } } while (0)
#define PG8_MMA(ai, bj, At, Bt) do { __builtin_amdgcn_s_setprio(1); _Pragma("unroll") for (int m = 0; m < 4; ++m) _Pragma("unroll") for (int n = 0; n < 2; ++n) \
        acc[ai][bj][m][n] = mma_step<FP8>(Bt[n], At[m], acc[ai][bj][m][n]); __builtin_amdgcn_s_setprio(0); } while (0)
#define PG8_WAIT_V(n) asm volatile("s_waitcnt vmcnt(" #n ")" ::: "memory")
#define PG8_WAIT_L(n) asm volatile("s_waitcnt lgkmcnt(" #n ")" ::: "memory")
#define PG8_BAR __builtin_amdgcn_s_barrier()
#define PG8_SCHED __builtin_amdgcn_sched_barrier(0)
    Unit cur, nxt; int ui = 0;
    if (!S.next(0, cur)) return;
    f32x4 acc[2][2][4][2];
#pragma unroll
    for (int a = 0; a < 2; ++a)
#pragma unroll
        for (int b = 0; b < 2; ++b)
#pragma unroll
            for (int m = 0; m < 4; ++m)
#pragma unroll
                for (int n = 0; n < 2; ++n) acc[a][b][m][n] = (f32x4){0.f, 0.f, 0.f, 0.f};
    i32x8 At[4], B0[2], B1[2];
    const char* cA = (const char*)g.A + (size_t)cur.pm * tstep; const char* cB = (const char*)g.Bt + (size_t)cur.pn * tstep;
    S.a_ready(cur);
    if constexpr (SP2) {
        PG8_STAGE(PG8_SB(0, 0), cB, voffB); PG8_STAGE(PG8_SB(0, 1), cB + hstep, voffB); PG8_STAGE(PG8_SA(0, 0), cA, voffA); PG8_STAGE(PG8_SA(0, 1), cA + hstep, voffA);
        if (wr == 1) PG8_BAR;
        PG8_WAIT_V(2); PG8_BAR;
        PG8_STAGE(PG8_SB(1, 0), cB + kstep, voffB); PG8_STAGE(PG8_SA(1, 0), cA + kstep, voffA); PG8_STAGE(PG8_SB(1, 1), cB + hstep + kstep, voffB);
        PG8_WAIT_V(6); PG8_BAR;
    } else {
        PG8_STAGE(PG8_SB(0, 0), cB, voffB); PG8_STAGE(PG8_SA(0, 0), cA, voffA); PG8_STAGE(PG8_SB(0, 1), cB + hstep, voffB); PG8_STAGE(PG8_SA(0, 1), cA + hstep, voffA);
        if (wr == 1) PG8_BAR;
        PG8_WAIT_V(4); PG8_BAR;
        PG8_STAGE(PG8_SB(1, 0), cB + kstep, voffB); PG8_STAGE(PG8_SA(1, 0), cA + kstep, voffA); PG8_STAGE(PG8_SB(1, 1), cB + hstep + kstep, voffB);
        PG8_WAIT_V(6); PG8_BAR;
    }
    for (;;) {
        const bool has_next = S.next(ui + 1, nxt);
        const char* nA = has_next ? (const char*)g.A + (size_t)nxt.pm * tstep : cA; const char* nB = has_next ? (const char*)g.Bt + (size_t)nxt.pn * tstep : cB;
        const char* hA = cA; const char* hB = cB;
#pragma unroll 1
        for (int h = 0; h < (DUAL ? 2 : 1); ++h) {
        const bool lasth = !DUAL || h == 1;
        const char* xA = lasth ? nA : cA + jA; const char* xB = lasth ? nB : cB + jB;
        for (int t = 0; t < nth; t += 2) {
            const bool last = (t == nth - 2);
            const char* a1 = hA + (size_t)(t + 1) * kstep;
            const char* a2 = last ? xA : hA + (size_t)(t + 2) * kstep; const char* b2 = last ? xB : hB + (size_t)(t + 2) * kstep;
            const char* a3 = a2 + kstep; const char* b3 = b2 + kstep;
            if (last && lasth && has_next) S.a_ready(nxt);
            if constexpr (SP2) {
            PG8_LDB(B0, 0, 0); PG8_LDB(B1, 0, 1); PG8_SCHED; PG8_LDA(At, 0, 0); PG8_STAGE(PG8_SA(1, 1), a1 + hstep, voffA);
            PG8_WAIT_V(8); PG8_WAIT_L(0); PG8_BAR; PG8_MMA(0, 0, At, B0); PG8_MMA(0, 1, At, B1); PG8_BAR; PG8_SCHED;
            PG8_LDA(At, 0, 1); PG8_STAGE(PG8_SB(0, 0), b2, voffB); PG8_STAGE(PG8_SB(0, 1), b2 + hstep, voffB); PG8_STAGE(PG8_SA(0, 0), a2, voffA);
            PG8_WAIT_V(8); PG8_WAIT_L(0); PG8_BAR; PG8_MMA(1, 0, At, B0); PG8_MMA(1, 1, At, B1); PG8_BAR; PG8_SCHED;
            PG8_LDB(B0, 1, 0); PG8_LDB(B1, 1, 1); PG8_SCHED; PG8_LDA(At, 1, 0); PG8_STAGE(PG8_SA(0, 1), a2 + hstep, voffA);
            PG8_WAIT_V(8); PG8_WAIT_L(0); PG8_BAR; PG8_MMA(0, 0, At, B0); PG8_MMA(0, 1, At, B1); PG8_BAR; PG8_SCHED;
            PG8_LDA(At, 1, 1); PG8_STAGE(PG8_SB(1, 0), b3, voffB); PG8_STAGE(PG8_SB(1, 1), b3 + hstep, voffB); PG8_STAGE(PG8_SA(1, 0), a3, voffA);
            PG8_WAIT_V(8); PG8_WAIT_L(0); PG8_BAR; PG8_MMA(1, 0, At, B0); PG8_MMA(1, 1, At, B1); PG8_BAR; PG8_SCHED;
            } else {
            PG8_LDB(B0, 0, 0); PG8_SCHED; PG8_LDA(At, 0, 0); PG8_STAGE(PG8_SA(1, 1), a1 + hstep, voffA);
            PG8_WAIT_L(8); PG8_BAR; PG8_WAIT_L(0); PG8_MMA(0, 0, At, B0); PG8_BAR; PG8_SCHED;
            PG8_LDB(B1, 0, 1); PG8_STAGE(PG8_SB(0, 0), b2, voffB);
            PG8_BAR; PG8_WAIT_L(0); PG8_MMA(0, 1, At, B1); PG8_BAR;
            PG8_LDA(At, 0, 1); PG8_STAGE(PG8_SA(0, 0), a2, voffA);
            PG8_BAR; PG8_WAIT_L(0); PG8_MMA(1, 0, At, B0); PG8_BAR; PG8_SCHED;
            PG8_STAGE(PG8_SB(0, 1), b2 + hstep, voffB);
            PG8_WAIT_V(6); PG8_BAR; PG8_MMA(1, 1, At, B1); PG8_BAR;
            PG8_LDB(B0, 1, 0); PG8_SCHED; PG8_LDA(At, 1, 0); PG8_STAGE(PG8_SA(0, 1), a2 + hstep, voffA);
            PG8_WAIT_L(8); PG8_BAR; PG8_WAIT_L(0); PG8_MMA(0, 0, At, B0); PG8_BAR; PG8_SCHED;
            PG8_LDB(B1, 1, 1); PG8_STAGE(PG8_SB(1, 0), b3, voffB);
            PG8_BAR; PG8_WAIT_L(0); PG8_MMA(0, 1, At, B1); PG8_BAR;
            PG8_LDA(At, 1, 1); PG8_STAGE(PG8_SA(1, 0), a3, voffA);
            PG8_BAR; PG8_WAIT_L(0); PG8_MMA(1, 0, At, B0); PG8_BAR; PG8_SCHED;
            PG8_STAGE(PG8_SB(1, 1), b3 + hstep, voffB);
            PG8_WAIT_V(6); PG8_BAR; PG8_MMA(1, 1, At, B1); PG8_BAR;
            }
        }
        if constexpr (DUAL) { if (h == 0) { E.mid(acc, cur, wr, wc, fr, fq); hA = cA + jA; hB = cB + jB; } }
        }
        if constexpr (ALIGN_EPI) { if (wr == 0) PG8_BAR; }
        if constexpr (!Epi::AFTER_DRAIN) { E(acc, cur, wr, wc, fr, fq); S.done(cur); }
#ifdef MK_PROBE
#if (MK_PROBE >> 9) & 1
        if constexpr (!Epi::AFTER_DRAIN) { asm volatile("" ::: "memory"); E(acc, cur, wr, wc, fr, fq); }
#endif
#if (MK_PROBE >> 10) & 1
        if constexpr (!Epi::AFTER_DRAIN) { if (g.N > 4096) { asm volatile("" ::: "memory"); E(acc, cur, wr, wc, fr, fq); } }
#endif
#endif
        if (!has_next) break;
#pragma unroll
        for (int a = 0; a < 2; ++a)
#pragma unroll
            for (int b = 0; b < 2; ++b)
#pragma unroll
                for (int m = 0; m < 4; ++m)
#pragma unroll
                    for (int n = 0; n < 2; ++n) acc[a][b][m][n] = (f32x4){0.f, 0.f, 0.f, 0.f};
        cur = nxt; cA = nA; cB = nB; ++ui;
        if constexpr (ALIGN_EPI) { if (wr == 1) PG8_BAR; }
    }
    PG8_WAIT_V(0);
    if constexpr (!ALIGN_EPI) { if (wr == 0) PG8_BAR; }
    PG8_BAR;
    if constexpr (Epi::AFTER_DRAIN) { E.fused(acc, cur, wr, wc, fr, fq, lds, wid, lane); S.done(cur); }
#undef PG8_SA
#undef PG8_SB
#undef PG8_STAGE
#undef PG8_LDA
#undef PG8_LDB
#undef PG8_MMA
#undef PG8_WAIT_V
#undef PG8_WAIT_L
#undef PG8_BAR
#undef PG8_SCHED
}
}

#ifndef MK_DBG
#define MK_DBG 0
#endif
#ifndef MK_COLMAP
#define MK_COLMAP 0
#endif
#ifndef MK_STAG
#define MK_STAG 0
#endif
#ifndef MK_PROBE
#define MK_PROBE 0
#endif
#ifndef MK_WGM_IN
#define MK_WGM_IN 7
#endif
#ifndef MK_WGM_SQ
#define MK_WGM_SQ 2
#endif
#ifndef MK_ALIGN
#define MK_ALIGN true
#endif
#ifndef MK_SP2
#define MK_SP2 true
#endif
namespace mk {
#define GAS __attribute__((address_space(1)))
#define LAS __attribute__((address_space(3)))
typedef unsigned short bf16;
typedef unsigned v4u __attribute__((ext_vector_type(4)));
typedef unsigned v2u __attribute__((ext_vector_type(2)));
typedef float f32x4 __attribute__((ext_vector_type(4)));
typedef float f32x2 __attribute__((ext_vector_type(2)));

constexpr int D = 2048, MX = 16384, MP = 16640, SEQ = 8192, NMETA = 16;
constexpr int NIN = 16400, NINP = 16640;
constexpr int NH = 8, DQK = 128, DV = 256;
constexpr int LSEQ = SEQ + NMETA;
constexpr float LN_EPS = 1e-5f;
constexpr float ALPHA = 1.189207115002721f;
constexpr float QSCALE = 0.08838834764831845f;

constexpr size_t MiB = 1u << 20;
constexpr size_t WS_CTL = 0, CTL_ZERO_BYTES = 512 * 1024;
constexpr size_t CTL_C1 = 256 * 1024;
constexpr size_t CTL_C0 = 264 * 1024;
constexpr size_t CTL_C1P = 512 * 1024, CTL_C0P = 1024 * 1024;
constexpr size_t WS_GIF = 2 * MiB;
constexpr size_t WS_BT_PA = 4 * MiB, WS_BT_PB = 12 * MiB, WS_BT_WO = 20 * MiB, WS_BT_F = 28 * MiB;
constexpr size_t WS_H0 = 36 * MiB;
constexpr size_t WS_BT_IN = 101 * MiB;
constexpr size_t WS_H0F8 = 101 * MiB;
constexpr size_t WS_BT_IN8 = 133 * MiB + 512 * 1024;
static_assert(WS_H0F8 + (size_t)16640 * 2048 <= WS_BT_IN8 && WS_BT_IN8 + (size_t)16640 * 2048 <= 166 * MiB, "fp8 operand copies");
constexpr size_t WS_UBF = 489 * MiB;
constexpr size_t WS_CB = 166 * MiB;
constexpr size_t WS_R = WS_CB;
constexpr size_t WS_Z = 230 * MiB;
constexpr size_t WS_VBF = 521 * MiB;
constexpr size_t WS_YA8 = WS_BT_IN8;
constexpr size_t WS_YB = WS_Z;
constexpr size_t WS_Q = 295 * MiB;
constexpr size_t WS_K = 327 * MiB;
constexpr size_t WS_TMP = WS_Q;
constexpr size_t WS_V = 360 * MiB;
constexpr size_t WS_SIGO = 425 * MiB;
constexpr size_t WS_MERGED = WS_SIGO;
constexpr size_t WS_END = 553 * MiB;
constexpr size_t OUT_SGA = 0, OUT_SGB = 64 * MiB;

constexpr int LDS_BYTES = 147456;

struct Params {
    const float *x, *meta, *ln0_g, *ln0_b, *w_in, *b_if, *conv_w, *mh_w, *p_a, *p_b, *w_o, *ln1_g, *ln1_b, *peer_wq, *peer_keys, *peer_u, *peer_v, *ln2_g, *ln2_b;
    float* out; unsigned char* ws;
};

__device__ __forceinline__ float bf2f(unsigned u) { return __uint_as_float(u << 16); }
__device__ __forceinline__ float bflo(unsigned w) { return __uint_as_float(w << 16); }
__device__ __forceinline__ float bfhi(unsigned w) { return __uint_as_float(w & 0xffff0000u); }
__device__ __forceinline__ unsigned pk2(float lo, float hi) { return pg8::cvt_pk_bf16(lo, hi); }
template <int CTRL> __device__ __forceinline__ float dpp_f(float v) { return __builtin_bit_cast(float, __builtin_amdgcn_update_dpp(0, __builtin_bit_cast(int, v), CTRL, 0xF, 0xF, true)); }
__device__ __forceinline__ float quad_sum(float v) { v += dpp_f<0xB1>(v); v += dpp_f<0x4E>(v); return v; }
__device__ __forceinline__ float oct_sum(float v) { v = quad_sum(v); v += dpp_f<0x141>(v); return v; }
__device__ __forceinline__ float row16_sum(float v) { v = oct_sum(v); v += dpp_f<0x140>(v); return v; }
__device__ __forceinline__ float wave_sum(float v) {
    v = row16_sum(v);
    const float a = __builtin_bit_cast(float, __builtin_amdgcn_readlane(__builtin_bit_cast(int, v), 0)), b = __builtin_bit_cast(float, __builtin_amdgcn_readlane(__builtin_bit_cast(int, v), 16));
    const float c = __builtin_bit_cast(float, __builtin_amdgcn_readlane(__builtin_bit_cast(int, v), 32)), d = __builtin_bit_cast(float, __builtin_amdgcn_readlane(__builtin_bit_cast(int, v), 48));
    return (a + b) + (c + d);
}
__device__ __forceinline__ float sigmoidf_(float x) { return __builtin_amdgcn_rcpf(1.0f + __expf(-x)); }
#define LDS_WAIT() asm volatile("s_waitcnt lgkmcnt(0)" ::: "memory")

__device__ __forceinline__ int in_dest_row(int n) {
    if (n < 2048) return n;
    if (n < 4096) { const int c = n - 2048; return (8 + (c >> 7)) * 256 + (c & 127); }
    if (n < 6144) { const int c = n - 4096; return (8 + (c >> 7)) * 256 + 128 + (c & 127); }
    if (n < 7168) return 24 * 256 + (n - 6144);
    if (n < 8192) return 28 * 256 + (n - 7168);
    if (n < 10240) return 32 * 256 + (n - 8192);
    if (n < 12288) return 40 * 256 + (n - 10240);
    if (n < 12304) return 64 * 256 + (n - 12288);
    if (n < 14352) return 48 * 256 + (n - 12304);
    return 56 * 256 + (n - 14352);
}
template <bool INMAP>
__device__ __forceinline__ void transpose_item(const float* W, int K, int N, bf16* WT, LAS float* scr, int item, int lane) {
    const int nblk = (N + 31) / 32, kb = item / nblk, nb = item % nblk, k0 = 64 * kb, n0 = 32 * nb;
    const int rr = lane >> 3, c4 = (lane & 7) * 4; const bool ok = (n0 + c4) < N;
    f32x4 v[8];
#pragma unroll
    for (int i = 0; i < 8; ++i) v[i] = ok ? *(const f32x4*)(W + (size_t)(k0 + 8 * i + rr) * N + n0 + c4) : (f32x4){0.f, 0.f, 0.f, 0.f};
#pragma unroll
    for (int i = 0; i < 8; ++i) { LAS float* d = scr + (8 * i + rr) * 33 + c4; d[0] = v[i].x; d[1] = v[i].y; d[2] = v[i].z; d[3] = v[i].w; }
    LDS_WAIT();
    const int c = lane & 7;
#pragma unroll
    for (int j = 0; j < 4; ++j) { const int nl = (lane >> 3) + 8 * j; const int n = n0 + nl; const LAS float* s = scr + (8 * c) * 33 + nl;
        v4u o; o.x = pk2(s[0 * 33], s[1 * 33]); o.y = pk2(s[2 * 33], s[3 * 33]); o.z = pk2(s[4 * 33], s[5 * 33]); o.w = pk2(s[6 * 33], s[7 * 33]);
        if (n < N) { const int dr = INMAP ? in_dest_row(n) : n; *(v4u*)(WT + (size_t)dr * K + k0 + 8 * c) = o; } }
    LDS_WAIT();
}
__device__ __forceinline__ unsigned pk4_fp8(float a, float b, float c, float d) { int w = 0; w = __builtin_amdgcn_cvt_pk_fp8_f32(a, b, w, false); w = __builtin_amdgcn_cvt_pk_fp8_f32(c, d, w, true); return (unsigned)w; }
template <bool INMAP>
__device__ __forceinline__ void transpose_item_fp8(const float* W, int K, int N, unsigned char* WT, LAS float* scr, int item, int lane) {
    const int nblk = (N + 31) / 32, kb = item / nblk, nb = item % nblk, k0 = 128 * kb, n0 = 32 * nb;
    const int rr = lane >> 3, c4 = (lane & 7) * 4; const bool ok = (n0 + c4) < N;
    f32x4 v[16];
#pragma unroll
    for (int i = 0; i < 16; ++i) v[i] = ok ? *(const f32x4*)(W + (size_t)(k0 + 8 * i + rr) * N + n0 + c4) : (f32x4){0.f, 0.f, 0.f, 0.f};
#pragma unroll
    for (int i = 0; i < 16; ++i) { LAS float* d = scr + (8 * i + rr) * 33 + c4; d[0] = v[i].x * 64.f; d[1] = v[i].y * 64.f; d[2] = v[i].z * 64.f; d[3] = v[i].w * 64.f; }
    LDS_WAIT();
    const int c = lane & 7;
#pragma unroll
    for (int j = 0; j < 4; ++j) { const int nl = (lane >> 3) + 8 * j; const int n = n0 + nl; const LAS float* s = scr + (16 * c) * 33 + nl;
        v4u o; o.x = pk4_fp8(s[0 * 33], s[1 * 33], s[2 * 33], s[3 * 33]); o.y = pk4_fp8(s[4 * 33], s[5 * 33], s[6 * 33], s[7 * 33]);
        o.z = pk4_fp8(s[8 * 33], s[9 * 33], s[10 * 33], s[11 * 33]); o.w = pk4_fp8(s[12 * 33], s[13 * 33], s[14 * 33], s[15 * 33]);
        if (n < N) *(v4u*)(WT + (size_t)(INMAP ? in_dest_row(n) : n) * K + k0 + 16 * c) = o; }
    LDS_WAIT();
}
__device__ __forceinline__ void ln0_load(const Params& p, int r, int lane, f32x4 (&v)[8]) {
    if (r >= MX + NMETA) {
#pragma unroll
        for (int j = 0; j < 8; ++j) v[j] = (f32x4){0.f, 0.f, 0.f, 0.f};
        return; }
    const float* src = (r < MX) ? p.x + (size_t)r * D : p.meta + (size_t)(r - MX) * D;
    const f32x4* xr = (const f32x4*)src + lane;
#pragma unroll
    for (int j = 0; j < 8; ++j) v[j] = xr[64 * j];
}
__device__ __forceinline__ void ln0_finish(const Params& p, int r, int lane, f32x4 (&v)[8]) {
    bf16* orow = (bf16*)(p.ws + WS_H0) + (size_t)r * D;
    unsigned long long* o8 = (unsigned long long*)orow + lane;
    unsigned* o4 = (unsigned*)(p.ws + WS_H0F8 + (size_t)r * D) + lane;
    if (r >= MX + NMETA) {
#pragma unroll
        for (int j = 0; j < 8; ++j) { o8[64 * j] = 0ull; o4[64 * j] = 0u; }
        return;
    }
    float s = 0.f;
#pragma unroll
    for (int j = 0; j < 8; ++j) s += (v[j].x + v[j].y) + (v[j].z + v[j].w);
    const float mean = wave_sum(s) * (1.f / D); float s2 = 0.f;
#pragma unroll
    for (int j = 0; j < 8; ++j) { v[j] = v[j] - mean; s2 += (v[j].x * v[j].x + v[j].y * v[j].y) + (v[j].z * v[j].z + v[j].w * v[j].w); }
    const float rstd = 1.f / sqrtf(wave_sum(s2) * (1.f / D) + LN_EPS);
#pragma unroll
    for (int j = 0; j < 8; ++j) {
        const f32x4 g = *((const f32x4*)p.ln0_g + lane + 64 * j), b = *((const f32x4*)p.ln0_b + lane + 64 * j);
        const f32x4 y = v[j] * rstd * g + b;
        o8[64 * j] = (unsigned long long)pk2(y.x, y.y) | ((unsigned long long)pk2(y.z, y.w) << 32);
        o4[64 * j] = pk4_fp8(y.x, y.y, y.z, y.w);
    }
}
typedef float f32x16_ __attribute__((ext_vector_type(16)));
__device__ __forceinline__ void wf_item(const Params& p, int item, int lane) {
    const int hp = item >> 8, dt = (item >> 2) & 63, nt = item & 3, d0 = 32 * dt, n0 = 32 * nt;
    const int i = lane & 31, kk = lane >> 5;
    const f32x4* arow = (const f32x4*)(p.peer_wq + (size_t)(d0 + i) * D + hp * 128);
    const f32x4* brow = (const f32x4*)(p.peer_keys + (size_t)hp * 16384 + (size_t)(n0 + i) * 128);
    f32x16_ acc;
#pragma unroll
    for (int g = 0; g < 16; ++g) acc[g] = 0.f;
#pragma unroll 8
    for (int q = 0; q < 32; ++q) {
        const f32x4 a = arow[q], bb = brow[q];
        acc = __builtin_amdgcn_mfma_f32_32x32x2f32(kk ? a.y : a.x, kk ? bb.y : bb.x, acc, 0, 0, 0);
        acc = __builtin_amdgcn_mfma_f32_32x32x2f32(kk ? a.w : a.z, kk ? bb.w : bb.z, acc, 0, 0, 0);
    }
    const int col = hp * 128 + n0 + i;
    bf16* dst = (bf16*)(p.ws + WS_BT_F) + (size_t)col * D + d0;
    float c1p = 0.f, c0p = 0.f;
#pragma unroll
    for (int gg = 0; gg < 4; ++gg) {
        const int dd = d0 + 8 * gg + 4 * kk;
        const f32x4 g1 = *(const f32x4*)(p.ln1_g + dd), b1 = *(const f32x4*)(p.ln1_b + dd);
        const unsigned lo = pk2(g1.x * acc[4 * gg], g1.y * acc[4 * gg + 1]), hi = pk2(g1.z * acc[4 * gg + 2], g1.w * acc[4 * gg + 3]);
        *(v2u*)(dst + 8 * gg + 4 * kk) = (v2u){lo, hi};
        c1p += (bflo(lo) + bfhi(lo)) + (bflo(hi) + bfhi(hi));
        c0p += (b1.x * acc[4 * gg] + b1.y * acc[4 * gg + 1]) + (b1.z * acc[4 * gg + 2] + b1.w * acc[4 * gg + 3]);
    }
    { const auto r1 = __builtin_amdgcn_permlane32_swap(__float_as_uint(c1p), __float_as_uint(c1p), false, false); c1p = __uint_as_float(r1[0]) + __uint_as_float(r1[1]);
      const auto r0 = __builtin_amdgcn_permlane32_swap(__float_as_uint(c0p), __float_as_uint(c0p), false, false); c0p = __uint_as_float(r0[0]) + __uint_as_float(r0[1]); }
    if (kk == 0) { ((float*)(p.ws + CTL_C1P))[dt * 2048 + col] = c1p; ((float*)(p.ws + CTL_C0P))[dt * 2048 + col] = c0p; }
}
__device__ __forceinline__ void phase0(const Params& p, LAS unsigned char* lds) {
    const int tid = pg8::ftid(), lane = tid & 63, wave = tid >> 6;
    const int gw = blockIdx.x * 8 + wave, NGW = gridDim.x * 8;
    LAS float* scr = (LAS float*)(lds + wave * 16896);
    if (!(wave & 1)) for (int it = gw; it < 4096; it += NGW) wf_item(p, it, lane);
    constexpr int I_IN = 16 * 513, I_SQ8 = 16 * 64;
    for (int rep12_ = 0; rep12_ < (((MK_PROBE) >> 12) & 1) + 1; ++rep12_)
    for (int it = gw; it < I_IN + 3 * I_SQ8; it += NGW) {
        int r = it;
        if (r < I_IN) { transpose_item_fp8<true>(p.w_in, D, NIN, p.ws + WS_BT_IN8, scr, r, lane); continue; } r -= I_IN;
        if (r < I_SQ8) { transpose_item_fp8<false>(p.p_a, D, D, p.ws + WS_BT_PA, scr, r, lane); continue; } r -= I_SQ8;
        if (r < I_SQ8) { transpose_item_fp8<false>(p.p_b, D, D, p.ws + WS_BT_PB, scr, r, lane); continue; } r -= I_SQ8;
        transpose_item_fp8<false>(p.w_o, D, D, p.ws + WS_BT_WO, scr, r, lane);
    }
    for (int r = gw; r < 240; r += NGW) { unsigned long long* o8 = (unsigned long long*)(p.ws + WS_BT_IN8 + (size_t)(64 * 256 + 16 + r) * D) + lane;
#pragma unroll
        for (int j = 0; j < 4; ++j) o8[64 * j] = 0ull; }
    for (int rep13_ = 0; rep13_ < (((MK_PROBE) >> 13) & 1) + 1; ++rep13_) {
        f32x4 va[8], vb[8], vc[8], vd[8];
        int r = gw;
        if (r < MP) ln0_load(p, r, lane, va);
        if (r + NGW < MP) ln0_load(p, r + NGW, lane, vb);
        if (r + 2 * NGW < MP) ln0_load(p, r + 2 * NGW, lane, vc);
        if (r + 3 * NGW < MP) ln0_load(p, r + 3 * NGW, lane, vd);
#pragma unroll 1
        for (; r < MP; r += 4 * NGW) {
            ln0_finish(p, r, lane, va); if (r + 4 * NGW < MP) ln0_load(p, r + 4 * NGW, lane, va);
            if (r + NGW < MP) { ln0_finish(p, r + NGW, lane, vb); if (r + 5 * NGW < MP) ln0_load(p, r + 5 * NGW, lane, vb); }
            if (r + 2 * NGW < MP) { ln0_finish(p, r + 2 * NGW, lane, vc); if (r + 6 * NGW < MP) ln0_load(p, r + 6 * NGW, lane, vc); }
            if (r + 3 * NGW < MP) { ln0_finish(p, r + 3 * NGW, lane, vd); if (r + 7 * NGW < MP) ln0_load(p, r + 7 * NGW, lane, vd); }
        }
    }
    for (int rep14_ = 0; rep14_ < (((MK_PROBE) >> 14) & 1) + 1; ++rep14_)
    if (wave & 1) for (int it = gw; it < 4096; it += NGW) wf_item(p, it, lane);
    (void)tid;
}
typedef float v32f __attribute__((ext_vector_type(32)));
typedef float v16f __attribute__((ext_vector_type(16)));
typedef unsigned v6u __attribute__((ext_vector_type(6)));
constexpr int ROW6 = 1536;
__device__ __forceinline__ void uvconv_range(const Params& p, size_t u0, size_t u1, int wk, int nwk) {
    const size_t units = (size_t)16384 * 64;
    const size_t NT = (size_t)nwk * 512;
#pragma unroll 1
    for (size_t i = u0 + (size_t)wk * 512 + pg8::ftid(); i < u1; i += NT) {
        const int t = i >= units; const size_t j = t ? i - units : i;
        const float* src = t ? p.peer_v : p.peer_u; unsigned char* dst = p.ws + (t ? WS_VBF : WS_UBF); const float sc = t ? 2.f : 64.f;
        const size_t row = j >> 6; const int l = (int)(j & 63);
        const f32x4* s4 = (const f32x4*)(src + row * 2048 + l * 32);
        v16f x0, x1;
#pragma unroll
        for (int q = 0; q < 4; ++q) { const f32x4 a = s4[q] * sc, b = s4[4 + q] * sc; x0[4 * q] = a.x; x0[4 * q + 1] = a.y; x0[4 * q + 2] = a.z; x0[4 * q + 3] = a.w; x1[4 * q] = b.x; x1[4 * q + 1] = b.y; x1[4 * q + 2] = b.z; x1[4 * q + 3] = b.w; }
        const v6u w = __builtin_amdgcn_cvt_scalef32_2xpk16_fp6_f32(x0, x1, 1.0f);
        *(v4u*)(dst + row * ROW6 + l * 16) = (v4u){w[0], w[1], w[2], w[3]};
        *(v2u*)(dst + row * ROW6 + 1024 + l * 8) = (v2u){w[4], w[5]};
    }
}
#ifndef MK_UV_EARLY
#define MK_UV_EARLY 786432
#endif
__device__ __forceinline__ size_t uv_early_units() { const int extra = ((MP / 256) * (NINP / 256)) % (int)gridDim.x; return extra ? (size_t)MK_UV_EARLY : (size_t)0; }
__device__ __forceinline__ void phase_uvconv_early(const Params& p) {
    const int extra = ((MP / 256) * (NINP / 256)) % (int)gridDim.x;
    if (extra == 0 || (int)blockIdx.x < extra) return;
    uvconv_range(p, 0, uv_early_units(), (int)blockIdx.x - extra, (int)gridDim.x - extra);
}
__device__ __forceinline__ void phase_uvconv(const Params& p) { uvconv_range(p, uv_early_units(), (size_t)2 * 16384 * 64, (int)blockIdx.x, (int)gridDim.x); }
}

namespace pg8 {
__device__ __forceinline__ void store_pair16(unsigned char* dst, unsigned ax, unsigned ay, unsigned bx, unsigned by) {
    const auto sx = __builtin_amdgcn_permlane16_swap(ax, bx, false, false), sy = __builtin_amdgcn_permlane16_swap(ay, by, false, false);
    *(u32x4*)dst = (u32x4){sx[0], sy[0], sx[1], sy[1]};
}
struct EpiInProj {
    static constexpr bool PERM = true, AFTER_DRAIN = false;
    unsigned char* ws; unsigned char* outb;
    __device__ __forceinline__ void operator()(const f32x4 (&acc)[2][2][4][2], const Unit& u, int wr, int wc, int fr, int fq) const {
        bf16_t* const CB = (bf16_t*)(ws + mk::WS_CB); bf16_t* const Z = (bf16_t*)(ws + mk::WS_Z); bf16_t* const Q = (bf16_t*)(ws + mk::WS_Q); bf16_t* const K = (bf16_t*)(ws + mk::WS_K); bf16_t* const V = (bf16_t*)(ws + mk::WS_V);
        bf16_t* const SIGO = (bf16_t*)(ws + mk::WS_SIGO); bf16_t* const SGA = (bf16_t*)(outb + mk::OUT_SGA); bf16_t* const SGB = (bf16_t*)(outb + mk::OUT_SGB); float* const GIF = (float*)(ws + mk::WS_GIF);
        const int pn = u.pn, pm = u.pm; const bool meta = (pm >= 64);
        int row0 = pm * BM + wr * 64 + fr, cl = wc * 32 + 8 * fq;
        asm volatile("" : "+v"(row0), "+v"(cl));
        if (pn >= 8 && pn < 24) {
            unsigned char* base = (unsigned char*)Z + (size_t)(pn - 8) * 128 + cl + (((cl >> 3) & 1) ? 16 * 2048 - 8 : 0);
#pragma unroll
            for (int ai = 0; ai < 2; ++ai)
#pragma unroll
                for (int m = 0; m < 4; m += 2) { unsigned w[2][2];
#pragma unroll
                    for (int mm = 0; mm < 2; ++mm) { const f32x4 z0 = acc[ai][0][m + mm][0] * acc[ai][1][m + mm][0], z1 = acc[ai][0][m + mm][1] * acc[ai][1][m + mm][1];
                        w[mm][0] = mk::pk4_fp8(z0[0], z0[1], z0[2], z0[3]); w[mm][1] = mk::pk4_fp8(z1[0], z1[1], z1[2], z1[3]); }
                    store_pair16(base + (size_t)(row0 + ai * HALF + m * 16) * 2048, w[0][0], w[0][1], w[1][0], w[1][1]); asm volatile("" ::: "memory"); }
            return;
        }
        if (pn >= 64) {
            if (wc == 0 && fq < 2) {
#pragma unroll
                for (int ai = 0; ai < 2; ++ai)
#pragma unroll
                    for (int m = 0; m < 4; ++m) { float* g = GIF + (size_t)((row0 + ai * HALF + m * 16) * 16 + (cl & 31));     *(f32x4*)g = acc[ai][0][m][0]; *(f32x4*)(g + 4) = acc[ai][0][m][1]; }
            }
            return;
        }
        if (pn < 8) { if (!meta) store_fp8(acc, (unsigned char*)CB, pn, row0, cl, (cl >> 3) & 1); }
        else if (pn < 28) { if (!meta) store_heads<2, 128>(acc, Q, nullptr, pn - 24, pm, row0, cl); }
        else if (pn < 32) store_heads<0, 128>(acc, K, K + (size_t)16 * 8192 * 128, pn - 28, pm, row0, cl);
        else if (pn < 40) store_heads<0, 256>(acc, V, V + (size_t)16 * 8192 * 256, pn - 32, pm, row0, cl);
        else if (meta) return;
        else if (pn < 48) store_heads<1, 256>(acc, SIGO, nullptr, pn - 40, pm, row0, cl);
        else if (pn < 56) store_gate(acc, (unsigned char*)SGA, pn - 48, row0, cl);
        else store_gate(acc, (unsigned char*)SGB, pn - 56, row0, cl);
    }
    __device__ __forceinline__ void store_fp8(const f32x4 (&acc)[2][2][4][2], unsigned char* base, int colt, int row0, int cl, bool odd) const {
        base += (size_t)colt * 256 + cl + (odd ? 16 * 2048 - 8 : 0);
#pragma unroll
        for (int ai = 0; ai < 2; ++ai)
#pragma unroll
            for (int m = 0; m < 4; m += 2) { unsigned char* rowp = base + (size_t)(row0 + ai * HALF + m * 16) * 2048;
#pragma unroll
                for (int bj = 0; bj < 2; ++bj) { unsigned w[2][2];
#pragma unroll
                    for (int mm = 0; mm < 2; ++mm) { const f32x4 v0 = acc[ai][bj][m + mm][0], v1 = acc[ai][bj][m + mm][1]; w[mm][0] = mk::pk4_fp8(v0[0], v0[1], v0[2], v0[3]); w[mm][1] = mk::pk4_fp8(v1[0], v1[1], v1[2], v1[3]); }
                    store_pair16(rowp + bj * HALF, w[0][0], w[0][1], w[1][0], w[1][1]); asm volatile("" ::: "memory"); } }
    }
    __device__ __forceinline__ void store_gate(const f32x4 (&acc)[2][2][4][2], unsigned char* base, int colt, int row0, int cl) const {
        base += (size_t)colt * 256 + cl + (((cl >> 3) & 1) ? 16 * 2048 - 8 : 0);
#pragma unroll
        for (int ai = 0; ai < 2; ++ai)
#pragma unroll
            for (int m = 0; m < 4; m += 2) { unsigned char* rowp = base + (size_t)(row0 + ai * HALF + m * 16) * 2048;
#pragma unroll
                for (int bj = 0; bj < 2; ++bj) { unsigned w[2][2];
#pragma unroll
                    for (int mm = 0; mm < 2; ++mm) { f32x4 v0 = acc[ai][bj][m + mm][0], v1 = acc[ai][bj][m + mm][1];
                        asm volatile("" : "+v"(v0), "+v"(v1));
                        unsigned w0 = 0u, w1 = 0u;
#pragma unroll
                        for (int e = 0; e < 4; ++e) { w0 = __builtin_amdgcn_cvt_pk_u8_f32(__builtin_rintf(255.f * mk::sigmoidf_(v0[e])), e, w0); w1 = __builtin_amdgcn_cvt_pk_u8_f32(__builtin_rintf(255.f * mk::sigmoidf_(v1[e])), e, w1); }
                        asm volatile("" : "+v"(w0), "+v"(w1));
                        w[mm][0] = w0; w[mm][1] = w1; }
                    store_pair16(rowp + bj * HALF, w[0][0], w[0][1], w[1][0], w[1][1]);
                    asm volatile("" ::: "memory"); }
                asm volatile("" ::: "memory"); }
    }
    template <int ACT, int HW> __device__ __forceinline__ void store_heads(const f32x4 (&acc)[2][2][4][2], bf16_t* X, bf16_t* MT, int colt, int pm, int row0, int cl) const {
        const bool meta = pm >= 64; const int b = pm >> 5;
#pragma unroll
        for (int ai = 0; ai < 2; ++ai)
#pragma unroll
            for (int m = 0; m < 4; ++m) { const int row = row0 + ai * HALF + m * 16; const int s = row & 8191, j = row - 16384;
                if (meta && j >= 16) continue;
#pragma unroll
                for (int bj = 0; bj < 2; ++bj) { f32x4 v0 = acc[ai][bj][m][0], v1 = acc[ai][bj][m][1];
                    const int h = (HW == 128) ? 2 * colt + bj : colt, c = (HW == 128) ? cl : bj * HALF + cl;
                    bf16_t* dst = meta ? MT + (size_t)(h * 16 + j) * HW + c : X + ((size_t)(b * 8 + h) * 8192 + s) * HW + c;
                    if (ACT == 1) { asm volatile("" : "+v"(v0), "+v"(v1));
#pragma unroll
                        for (int e = 0; e < 4; ++e) { v0[e] = mk::sigmoidf_(v0[e]); v1[e] = mk::sigmoidf_(v1[e]); } }
                    else if (ACT == 2) { v0 = v0 * mk::QSCALE; v1 = v1 * mk::QSCALE; }
                    u32x4 w; w.x = cvt_pk_bf16(v0[0], v0[1]); w.y = cvt_pk_bf16(v0[2], v0[3]); w.z = cvt_pk_bf16(v1[0], v1[1]); w.w = cvt_pk_bf16(v1[2], v1[3]);
                    *(u32x4*)dst = w;
                    if (ACT == 1) asm volatile("" ::: "memory"); }
                asm volatile("" ::: "memory"); }
    }
    template <int ACT> __device__ __forceinline__ void store(const f32x4 (&acc)[2][2][4][2], bf16_t* base, int ld, int colt, int row0, int cl) const {
        base += (size_t)colt * 256 + cl;
#pragma unroll
        for (int ai = 0; ai < 2; ++ai)
#pragma unroll
            for (int m = 0; m < 4; ++m) { bf16_t* rowp = base + (size_t)(row0 + ai * HALF + m * 16) * ld;
#pragma unroll
                for (int bj = 0; bj < 2; ++bj) { f32x4 v0 = acc[ai][bj][m][0], v1 = acc[ai][bj][m][1];
                    if (ACT == 1) { asm volatile("" : "+v"(v0), "+v"(v1));
#pragma unroll
                        for (int e = 0; e < 4; ++e) { v0[e] = mk::sigmoidf_(v0[e]); v1[e] = mk::sigmoidf_(v1[e]); } }
                    else if (ACT == 2) { v0 = v0 * mk::QSCALE; v1 = v1 * mk::QSCALE; }
                    u32x4 w; w.x = cvt_pk_bf16(v0[0], v0[1]); w.y = cvt_pk_bf16(v0[2], v0[3]); w.z = cvt_pk_bf16(v1[0], v1[1]); w.w = cvt_pk_bf16(v1[2], v1[3]);
                    *(u32x4*)(rowp + bj * HALF) = w;
                    if (ACT == 1) asm volatile("" ::: "memory"); }
                asm volatile("" ::: "memory"); }
    }
};
template <bool SECOND> struct EpiGate {
    static constexpr bool PERM = true, AFTER_DRAIN = false;
    const bf16_t* G; const bf16_t* T; bf16_t* O;
    __device__ __forceinline__ void operator()(const f32x4 (&acc)[2][2][4][2], const Unit& u, int wr, int wc, int fr, int fq) const {
        const int row0 = u.pm * BM + wr * 64 + fr, col0 = u.pn * BM + wc * 32 + 8 * fq;
        constexpr int NB = SECOND ? 1 : 2;
#pragma unroll
        for (int a0 = 0; a0 < 2; a0 += NB) {
            u32x4 gv[NB][4][2], tv[NB][4][2];
#pragma unroll
            for (int aa = 0; aa < NB; ++aa)
#pragma unroll
                for (int m = 0; m < 4; ++m)
#pragma unroll
                    for (int bj = 0; bj < 2; ++bj) { const size_t off = (size_t)(row0 + (a0 + aa) * HALF + m * 16) * 2048 + col0 + bj * HALF;
                        gv[aa][m][bj] = *(const u32x4*)(G + off); if (SECOND) tv[aa][m][bj] = *(const u32x4*)(T + off); else tv[aa][m][bj] = (u32x4){0u, 0u, 0u, 0u}; }
            asm volatile("" ::: "memory");
#pragma unroll
            for (int aa = 0; aa < NB; ++aa)
#pragma unroll
                for (int m = 0; m < 4; ++m)
#pragma unroll
                    for (int bj = 0; bj < 2; ++bj) { const int ai = a0 + aa; const size_t off = (size_t)(row0 + ai * HALF + m * 16) * 2048 + col0 + bj * HALF;
                        const u32x4 g = gv[aa][m][bj], t = tv[aa][m][bj];
                        const f32x4 v0 = acc[ai][bj][m][0], v1 = acc[ai][bj][m][1]; float o[8];
                        o[0] = mk::bflo(g.x) * v0[0] + mk::bflo(t.x); o[1] = mk::bfhi(g.x) * v0[1] + mk::bfhi(t.x);
                        o[2] = mk::bflo(g.y) * v0[2] + mk::bflo(t.y); o[3] = mk::bfhi(g.y) * v0[3] + mk::bfhi(t.y);
                        o[4] = mk::bflo(g.z) * v1[0] + mk::bflo(t.z); o[5] = mk::bfhi(g.z) * v1[1] + mk::bfhi(t.z);
                        o[6] = mk::bflo(g.w) * v1[2] + mk::bflo(t.w); o[7] = mk::bfhi(g.w) * v1[3] + mk::bfhi(t.w);
                        if (SECOND) {
                            typedef unsigned u32x2_ __attribute__((ext_vector_type(2)));
                            *(u32x2_*)((unsigned char*)O + off) = (u32x2_){mk::pk4_fp8(o[0], o[1], o[2], o[3]), mk::pk4_fp8(o[4], o[5], o[6], o[7])};
                        } else {
                            u32x4 w; w.x = cvt_pk_bf16(o[0], o[1]); w.y = cvt_pk_bf16(o[2], o[3]); w.z = cvt_pk_bf16(o[4], o[5]); w.w = cvt_pk_bf16(o[6], o[7]);
                            *(u32x4*)(O + off) = w; } }
            asm volatile("" ::: "memory");
        }
    }
};
struct EpiGate2 {
    static constexpr bool PERM = true, AFTER_DRAIN = false, DUAL = true;
    const unsigned char* GA; const unsigned char* GB; unsigned char* O;
    static constexpr size_t jA = (size_t)(mk::WS_YB - mk::WS_YA8), jB = (size_t)(mk::WS_BT_PB - mk::WS_BT_PA);
    typedef unsigned u32x2_ __attribute__((ext_vector_type(2)));
    static __device__ __forceinline__ float ub(unsigned w, int i) { return (float)((w >> (8 * i)) & 0xffu); }
    __device__ __forceinline__ void mid(f32x4 (&acc)[2][2][4][2], const Unit& u, int wr, int wc, int fr, int fq) const {
        unsigned off0 = (unsigned)((u.pm * BM + wr * 64 + fr) * 2048 + u.pn * BM + wc * 32 + 8 * fq);
        asm volatile("" : "+v"(off0));
        const unsigned char* ga = (const unsigned char*)sgpr_ptr((const char*)GA); const unsigned char* gb = (const unsigned char*)sgpr_ptr((const char*)GB);
        u32x2_ av[2][4][2], bv[2][4][2];
#pragma unroll
        for (int ai = 0; ai < 2; ++ai)
#pragma unroll
            for (int m = 0; m < 4; ++m)
#pragma unroll
                for (int bj = 0; bj < 2; ++bj) { const unsigned off = off0 + (unsigned)((ai * HALF + m * 16) * 2048 + bj * HALF); av[ai][m][bj] = *(const u32x2_*)(ga + off); bv[ai][m][bj] = *(const u32x2_*)(gb + off); }
        asm volatile("" ::: "memory");
#pragma unroll
        for (int ai = 0; ai < 2; ++ai)
#pragma unroll
            for (int m = 0; m < 4; ++m)
#pragma unroll
                for (int bj = 0; bj < 2; ++bj) { const u32x2_ a = av[ai][m][bj], b = bv[ai][m][bj];
                    f32x4 r0, r1;
#pragma unroll
                    for (int e = 0; e < 4; ++e) { r0[e] = ub(a.x, e) * __builtin_amdgcn_rcpf(fmaxf(ub(b.x, e), GMIN)); r1[e] = ub(a.y, e) * __builtin_amdgcn_rcpf(fmaxf(ub(b.y, e), GMIN)); }
                    acc[ai][bj][m][0] = acc[ai][bj][m][0] * r0; acc[ai][bj][m][1] = acc[ai][bj][m][1] * r1; }
        asm volatile("" ::: "memory");
    }
    static constexpr float GMIN = 1.f / 1024.f;
    __device__ __forceinline__ void operator()(const f32x4 (&acc)[2][2][4][2], const Unit& u, int wr, int wc, int fr, int fq) const {
        unsigned off0 = (unsigned)((u.pm * BM + wr * 64 + fr) * 2048 + u.pn * BM + wc * 32 + 8 * fq);
        asm volatile("" : "+v"(off0));
        const unsigned char* gb = (const unsigned char*)sgpr_ptr((const char*)GB); unsigned char* o_ = (unsigned char*)sgpr_ptr((const char*)O);
        u32x2_ bv[2][4][2];
#pragma unroll
        for (int ai = 0; ai < 2; ++ai)
#pragma unroll
            for (int m = 0; m < 4; ++m)
#pragma unroll
                for (int bj = 0; bj < 2; ++bj) bv[ai][m][bj] = *(const u32x2_*)(gb + (off0 + (unsigned)((ai * HALF + m * 16) * 2048 + bj * HALF)));
        asm volatile("" ::: "memory");
#pragma unroll
        for (int ai = 0; ai < 2; ++ai)
#pragma unroll
            for (int m = 0; m < 4; ++m)
#pragma unroll
                for (int bj = 0; bj < 2; ++bj) { const unsigned off = off0 + (unsigned)((ai * HALF + m * 16) * 2048 + bj * HALF);
                    const u32x2_ b = bv[ai][m][bj]; const f32x4 v0 = acc[ai][bj][m][0], v1 = acc[ai][bj][m][1]; float o[8];
#pragma unroll
                    for (int e = 0; e < 4; ++e) { o[e] = fmaxf(ub(b.x, e), GMIN) * (1.f / 255.f) * v0[e]; o[4 + e] = fmaxf(ub(b.y, e), GMIN) * (1.f / 255.f) * v1[e]; }
                    *(u32x2_*)(o_ + off) = (u32x2_){mk::pk4_fp8(o[0], o[1], o[2], o[3]), mk::pk4_fp8(o[4], o[5], o[6], o[7])}; }
    }
};
struct EpiResid {
    static constexpr bool PERM = true, AFTER_DRAIN = false;
    const bf16_t* H0; bf16_t* R;
    __device__ __forceinline__ void operator()(const f32x4 (&acc)[2][2][4][2], const Unit& u, int wr, int wc, int fr, int fq) const {
        const int row0 = u.pm * BM + wr * 64 + fr, col0 = u.pn * BM + wc * 32 + 8 * fq;
        u32x4 hv[2][4][2];
#pragma unroll
        for (int ai = 0; ai < 2; ++ai)
#pragma unroll
            for (int m = 0; m < 4; ++m)
#pragma unroll
                for (int bj = 0; bj < 2; ++bj) hv[ai][m][bj] = *(const u32x4*)(H0 + (size_t)(row0 + ai * HALF + m * 16) * 2048 + col0 + bj * HALF);
        asm volatile("" ::: "memory");
#pragma unroll
        for (int ai = 0; ai < 2; ++ai)
#pragma unroll
            for (int m = 0; m < 4; ++m)
#pragma unroll
                for (int bj = 0; bj < 2; ++bj) { const size_t off = (size_t)(row0 + ai * HALF + m * 16) * 2048 + col0 + bj * HALF;
                    const u32x4 h = hv[ai][m][bj];
                    const f32x4 v0 = acc[ai][bj][m][0], v1 = acc[ai][bj][m][1]; float o[8];
                    o[0] = mk::ALPHA * mk::bflo(h.x) + v0[0]; o[1] = mk::ALPHA * mk::bfhi(h.x) + v0[1];
                    o[2] = mk::ALPHA * mk::bflo(h.y) + v0[2]; o[3] = mk::ALPHA * mk::bfhi(h.y) + v0[3];
                    o[4] = mk::ALPHA * mk::bflo(h.z) + v1[0]; o[5] = mk::ALPHA * mk::bfhi(h.z) + v1[1];
                    o[6] = mk::ALPHA * mk::bflo(h.w) + v1[2]; o[7] = mk::ALPHA * mk::bfhi(h.w) + v1[3];
                    u32x4 w; w.x = cvt_pk_bf16(o[0], o[1]); w.y = cvt_pk_bf16(o[2], o[3]); w.z = cvt_pk_bf16(o[4], o[5]); w.w = cvt_pk_bf16(o[6], o[7]);
                    *(u32x4*)(R + off) = w; }
    }
};
struct EpiScores {
    static constexpr bool PERM = true, AFTER_DRAIN = false;
    _Float16* S;
    __device__ __forceinline__ void operator()(const f32x4 (&acc)[2][2][4][2], const Unit& u, int wr, int wc, int fr, int fq) const {
        typedef _Float16 h8_t __attribute__((ext_vector_type(8)));
        const int row0 = u.pm * BM + wr * 64 + fr, col0 = u.pn * BM + wc * 32 + 8 * fq;
#pragma unroll
        for (int ai = 0; ai < 2; ++ai)
#pragma unroll
            for (int m = 0; m < 4; ++m) { _Float16* rowp = S + (size_t)(row0 + ai * HALF + m * 16) * 2048 + col0;
#pragma unroll
                for (int bj = 0; bj < 2; ++bj) { const f32x4 v0 = acc[ai][bj][m][0], v1 = acc[ai][bj][m][1]; h8_t w;
                    w[0] = (_Float16)v0[0]; w[1] = (_Float16)v0[1]; w[2] = (_Float16)v0[2]; w[3] = (_Float16)v0[3]; w[4] = (_Float16)v1[0]; w[5] = (_Float16)v1[1]; w[6] = (_Float16)v1[2]; w[7] = (_Float16)v1[3];
                    *(h8_t*)(rowp + bj * HALF) = w; } }
    }
};
}

namespace mk {
__device__ __forceinline__ void phase_c1c0(const Params& p) {
    const int gt = blockIdx.x * 512 + pg8::ftid();
    if (gt < 4096) { const int col = gt & 2047; const float* src = (const float*)(p.ws + (gt < 2048 ? CTL_C1P : CTL_C0P)); float a = 0.f;
        for (int i = 0; i < 64; ++i) a += src[i * 2048 + col];
        ((float*)(p.ws + (gt < 2048 ? CTL_C1 : CTL_C0)))[col] = a; }
}
constexpr int CONV_SLICES = 1024 * 256 * 4;
__device__ __forceinline__ void conv_issue(const Params& p, int s, v2u& zm2, v2u& zm1, v2u (&z)[4], v2u (&cb)[4]) {
    const unsigned char* CB = p.ws + WS_CB; const unsigned char* Z = p.ws + WS_Z;
    const int it = s & 262143, qq = s >> 18, c0 = (it & 255) * 8, r0 = (it >> 8) * 16 + 4 * qq;
    const bool first = (r0 & (SEQ - 1)) == 0;
    zm2 = *(const v2u*)(Z + (size_t)(first ? MX + 14 : r0 - 2) * D + c0);
    zm1 = *(const v2u*)(Z + (size_t)(first ? MX + 15 : r0 - 1) * D + c0);
#pragma unroll
    for (int i = 0; i < 4; ++i) { const size_t off = (size_t)(r0 + i) * D + c0; z[i] = *(const v2u*)(Z + off); cb[i] = *(const v2u*)(CB + off); }
}
__device__ __forceinline__ void fp8x8_f32(v2u w, float (&o)[8]) {
    typedef float f2_t __attribute__((ext_vector_type(2)));
    const f2_t a = __builtin_amdgcn_cvt_pk_f32_fp8((int)w.x, false), b = __builtin_amdgcn_cvt_pk_f32_fp8((int)w.x, true), c = __builtin_amdgcn_cvt_pk_f32_fp8((int)w.y, false), d = __builtin_amdgcn_cvt_pk_f32_fp8((int)w.y, true);
    o[0] = a[0]; o[1] = a[1]; o[2] = b[0]; o[3] = b[1]; o[4] = c[0]; o[5] = c[1]; o[6] = d[0]; o[7] = d[1];
}
__device__ __forceinline__ void conv_finish(const Params& p, int s, v2u zm2_, v2u zm1_, const v2u (&zz)[4], const v2u (&cbb)[4]) {
    const int it = s & 262143, qq = s >> 18, c0 = (it & 255) * 8, r0 = (it >> 8) * 16 + 4 * qq;
    const float* cw = p.conv_w + c0; asm volatile("" : "+v"(cw));
    float w0[8], w1[8], w2[8];
    { const f32x4 a0 = *(const f32x4*)cw, a1 = *(const f32x4*)(cw + 4), b0 = *(const f32x4*)(cw + 2048), b1 = *(const f32x4*)(cw + 2052), d0 = *(const f32x4*)(cw + 4096), d1 = *(const f32x4*)(cw + 4100);
#pragma unroll
      for (int e = 0; e < 4; ++e) { w0[e] = a0[e]; w0[4 + e] = a1[e]; w1[e] = b0[e]; w1[4 + e] = b1[e]; w2[e] = d0[e]; w2[4 + e] = d1[e]; } }
    float zm2[8], zm1[8]; fp8x8_f32(zm2_, zm2); fp8x8_f32(zm1_, zm1);
#pragma unroll
    for (int i = 0; i < 4; ++i) {
        const size_t off = (size_t)(r0 + i) * D + c0;
        float z[8], cb[8], y[8]; fp8x8_f32(zz[i], z); fp8x8_f32(cbb[i], cb);
#pragma unroll
        for (int e = 0; e < 8; ++e) { y[e] = cb[e] * (w0[e] * zm2[e] + w1[e] * zm1[e] + w2[e] * z[e]); zm2[e] = zm1[e]; zm1[e] = z[e]; }
        *(v2u*)(p.ws + WS_YA8 + off) = (v2u){pk4_fp8(y[0], y[1], y[2], y[3]), pk4_fp8(y[4], y[5], y[6], y[7])};
    }
}

constexpr float U_SCALE = 64.f, V_SCALE = 2.f;
#ifndef MK_FP6_ORDER
#define MK_FP6_ORDER 1
#endif
__device__ __forceinline__ float gelu_exact(float a) { return 0.5f * a * (1.f + erff(a * 0.70710678118654752f)); }
__device__ __forceinline__ void ce_desc(unsigned& a, unsigned& b) { const unsigned hi = a > b ? a : b, lo = a > b ? b : a; a = hi; b = lo; }
__device__ __forceinline__ void merge16_desc(unsigned (&v)[16]) {
#pragma unroll
    for (int j = 8; j > 0; j >>= 1)
#pragma unroll
        for (int i = 0; i < 16; ++i) { const int l = i ^ j; if (l > i) ce_desc(v[i], v[l]); }
}
__device__ __forceinline__ void sort16_desc(unsigned (&v)[16]) {
#pragma unroll
    for (int k = 2; k <= 16; k <<= 1)
#pragma unroll
        for (int j = k >> 1; j > 0; j >>= 1)
#pragma unroll
            for (int i = 0; i < 16; ++i) { const int l = i ^ j; if (l > i) { if ((i & k) == 0) ce_desc(v[i], v[l]); else ce_desc(v[l], v[i]); } }
}
__device__ __forceinline__ float key_val(unsigned k) { const unsigned m = k & 0xFFFFFF80u; return __uint_as_float((m & 0x80000000u) ? (m & 0x7FFFFFFFu) : ~m); }
__device__ __forceinline__ void phase_peer(const Params& p, LAS unsigned char* lds) {
    const int tid = pg8::ftid(), lane0 = tid & 63, wave = tid >> 6;
    LAS unsigned* K1 = (LAS unsigned*)(lds + wave * 4096);
    LAS unsigned* K2 = (LAS unsigned*)(lds + wave * 4096 + 1024);
    LAS int* Ei = (LAS int*)(lds + wave * 4096 + 3072);
    LAS float* Eg = (LAS float*)(lds + wave * 4096 + 3584);
    LAS float* PAR = (LAS float*)(lds + 32768);
    {
        const float* C1g = (const float*)(p.ws + CTL_C1); const float* C0g = (const float*)(p.ws + CTL_C0);
        for (int i = tid; i < 2048; i += 512) { PAR[i] = p.ln1_g[i]; PAR[2048 + i] = p.ln1_b[i]; PAR[4096 + i] = p.ln2_g[i]; PAR[6144 + i] = p.ln2_b[i]; PAR[8192 + i] = C1g[i]; PAR[10240 + i] = C0g[i]; }
    }
    __syncthreads();
    unsigned ciw = 0u, cjw = 0u;
    { const int sub0 = lane0 & 7; int c = 0; for (int i = 0; i < 16; ++i) { const int nj = 16 / (i + 1); for (int j = 0; j < nj; ++j) { if ((c & 7) == sub0) { ciw |= (unsigned)i << (4 * (c >> 3)); cjw |= (unsigned)j << (4 * (c >> 3)); } ++c; } } }
    const bf16* R = (const bf16*)(p.ws + WS_R);
    const unsigned char* U6 = p.ws + WS_UBF; const unsigned char* V6 = p.ws + WS_VBF;
    const _Float16* SC = (const _Float16*)(p.ws + WS_TMP);
    const int gw = blockIdx.x * 8 + wave, NGW = gridDim.x * 8;
#pragma unroll 1
    for (int r = gw; r < MX; r += NGW) {
        int lane = lane0; asm volatile("" : "+v"(lane));
        const int qd = lane & 3, qbase = lane & ~3;
        float mu, rstd;
        v4u rw_[4];
        {
            v4u (&w)[4] = rw_; float s1 = 0.f;
#pragma unroll
            for (int q = 0; q < 4; ++q) { w[q] = *(const v4u*)(R + (size_t)r * D + lane * 32 + q * 8);
                s1 += ((bflo(w[q].x) + bfhi(w[q].x)) + (bflo(w[q].y) + bfhi(w[q].y))) + ((bflo(w[q].z) + bfhi(w[q].z)) + (bflo(w[q].w) + bfhi(w[q].w))); }
            mu = wave_sum(s1) * (1.f / D); float s2 = 0.f;
#pragma unroll
            for (int q = 0; q < 4; ++q) { const float d0 = bflo(w[q].x) - mu, d1 = bfhi(w[q].x) - mu, d2 = bflo(w[q].y) - mu, d3 = bfhi(w[q].y) - mu, d4 = bflo(w[q].z) - mu, d5 = bfhi(w[q].z) - mu, d6 = bflo(w[q].w) - mu, d7 = bfhi(w[q].w) - mu;
                s2 += ((d0 * d0 + d1 * d1) + (d2 * d2 + d3 * d3)) + ((d4 * d4 + d5 * d5) + (d6 * d6 + d7 * d7)); }
            rstd = 1.f / sqrtf(wave_sum(s2) * (1.f / D) + LN_EPS);
        }
        for (int rep11_ = 0; rep11_ < (((MK_PROBE) >> 11) & 1) + 1; ++rep11_) {
        {
            unsigned v[32];
#pragma unroll
            for (int i = 0; i < 8; ++i) { typedef _Float16 h4_t __attribute__((ext_vector_type(4))); const h4_t th = *(const h4_t*)(SC + (size_t)r * D + lane * 32 + 4 * i);
                const f32x4 t = {(float)th[0], (float)th[1], (float)th[2], (float)th[3]};
                const f32x4 a1 = *(const LAS f32x4*)(PAR + 8192 + lane * 32 + 4 * i), a0 = *(const LAS f32x4*)(PAR + 10240 + lane * 32 + 4 * i);
                const f32x4 y = (t - a1 * mu) * rstd + a0;
#pragma unroll
                for (int c = 0; c < 4; ++c) { const unsigned u = __float_as_uint(y[c]); const unsigned mono = (u & 0x80000000u) ? ~u : (u | 0x80000000u);
                    v[4 * i + c] = (mono & 0xFFFFFF80u) | (unsigned)(127 - (qd * 32 + 4 * i + c)); } }
            unsigned A[16], B[16];
#pragma unroll
            for (int i = 0; i < 16; ++i) { A[i] = v[i]; B[i] = v[16 + i]; }
            sort16_desc(A); sort16_desc(B);
#pragma unroll
            for (int i = 0; i < 16; ++i) A[i] = A[i] > B[15 - i] ? A[i] : B[15 - i];
            merge16_desc(A);
#pragma unroll
            for (int i = 0; i < 16; ++i) B[i] = (unsigned)__builtin_amdgcn_update_dpp(0, (int)A[15 - i], 0xB1, 0xF, 0xF, true);
#pragma unroll
            for (int i = 0; i < 16; ++i) A[i] = A[i] > B[i] ? A[i] : B[i];
            merge16_desc(A);
#pragma unroll
            for (int i = 0; i < 16; ++i) B[i] = (unsigned)__builtin_amdgcn_update_dpp(0, (int)A[15 - i], 0x4E, 0xF, 0xF, true);
#pragma unroll
            for (int i = 0; i < 16; ++i) A[i] = A[i] > B[i] ? A[i] : B[i];
            merge16_desc(A);
            const int g = lane >> 2;
            const unsigned w0 = qd == 0 ? A[0] : qd == 1 ? A[4] : qd == 2 ? A[8] : A[12], w1 = qd == 0 ? A[1] : qd == 1 ? A[5] : qd == 2 ? A[9] : A[13];
            const unsigned w2 = qd == 0 ? A[2] : qd == 1 ? A[6] : qd == 2 ? A[10] : A[14], w3 = qd == 0 ? A[3] : qd == 1 ? A[7] : qd == 2 ? A[11] : A[15];
            *(LAS v4u*)(K1 + g * 16 + 4 * qd) = (v4u){w0, w1, w2, w3};
        }
        LDS_WAIT();
        {
            const int hh = lane >> 3, sub = lane & 7;
            float sa[7]; int ea[7]; unsigned ka[7];
#pragma unroll
            for (int a = 0; a < 7; ++a) { const int ci_ = (ciw >> (4 * a)) & 15, cj_ = (cjw >> (4 * a)) & 15; const bool ok = (sub + 8 * a) < 50;
                const unsigned k0 = K1[(2 * hh) * 16 + ci_], k1 = K1[(2 * hh + 1) * 16 + cj_];
                const float s = key_val(k0) + key_val(k1);
                sa[a] = s; ea[a] = (127 - (int)(k0 & 127u)) * 128 + (127 - (int)(k1 & 127u));
                const unsigned u = __float_as_uint(s); const unsigned mono = (u & 0x80000000u) ? ~u : (u | 0x80000000u);
                ka[a] = ok ? ((mono & 0xFFFFFFC0u) | (unsigned)(63 - (sub + 8 * a))) : 0u;
                K2[hh * 64 + sub + 8 * a] = ka[a]; }
            if (sub == 0) K2[hh * 64 + 56] = 0u;
            LDS_WAIT();
            int rk[7];
#pragma unroll
            for (int a = 0; a < 7; ++a) rk[a] = 0;
#pragma unroll
            for (int q = 0; q < 14; ++q) { const v4u kb = *(const LAS v4u*)(K2 + hh * 64 + 4 * q);
#pragma unroll
                for (int a = 0; a < 7; ++a) rk[a] += (kb.x > ka[a] ? 1 : 0) + (kb.y > ka[a] ? 1 : 0) + (kb.z > ka[a] ? 1 : 0) + (kb.w > ka[a] ? 1 : 0); }
            const float smax = key_val(K1[(2 * hh) * 16]) + key_val(K1[(2 * hh + 1) * 16]);
            float ex[7]; float part = 0.f;
#pragma unroll
            for (int a = 0; a < 7; ++a) { const bool sel = ka[a] != 0u && rk[a] < 16; ex[a] = sel ? __expf(sa[a] - smax) : 0.f; part += ex[a]; }
            part += __builtin_bit_cast(float, __builtin_amdgcn_update_dpp(0, __builtin_bit_cast(int, part), 0xB1, 0xF, 0xF, true));
            part += __builtin_bit_cast(float, __builtin_amdgcn_update_dpp(0, __builtin_bit_cast(int, part), 0x4E, 0xF, 0xF, true));
            part += __builtin_bit_cast(float, __builtin_amdgcn_update_dpp(0, __builtin_bit_cast(int, part), 0x141, 0xF, 0xF, true));
            const float inv = 1.f / part;
#pragma unroll
            for (int a = 0; a < 7; ++a) if (ka[a] != 0u && rk[a] < 16) { Ei[hh * 16 + rk[a]] = ea[a]; Eg[hh * 16 + rk[a]] = ex[a] * inv; }
        }
        LDS_WAIT();
        }
        v32f x;
        {
            float xl[32];
#pragma unroll
            for (int q = 0; q < 4; ++q) {
                const int e0 = lane * 32 + q * 8;
                const v4u w = rw_[q];
                const f32x4 g0 = *(const LAS f32x4*)(PAR + e0), g1 = *(const LAS f32x4*)(PAR + e0 + 4), b0 = *(const LAS f32x4*)(PAR + 2048 + e0), b1 = *(const LAS f32x4*)(PAR + 2048 + e0 + 4);
                xl[8 * q + 0] = (bflo(w.x) - mu) * rstd * g0.x + b0.x; xl[8 * q + 1] = (bfhi(w.x) - mu) * rstd * g0.y + b0.y;
                xl[8 * q + 2] = (bflo(w.y) - mu) * rstd * g0.z + b0.z; xl[8 * q + 3] = (bfhi(w.y) - mu) * rstd * g0.w + b0.w;
                xl[8 * q + 4] = (bflo(w.z) - mu) * rstd * g1.x + b1.x; xl[8 * q + 5] = (bfhi(w.z) - mu) * rstd * g1.y + b1.y;
                xl[8 * q + 6] = (bflo(w.w) - mu) * rstd * g1.z + b1.z; xl[8 * q + 7] = (bfhi(w.w) - mu) * rstd * g1.w + b1.w;
            }
#pragma unroll
            for (int i = 0; i < 32; ++i) x[MK_FP6_ORDER ? ((i & 15) * 2 + (i >> 4)) : i] = xl[i];
        }
        {
            auto loadu = [&](v6u (&w)[4], int e0) {
#pragma unroll
                for (int k = 0; k < 4; ++k) { const int id = __builtin_amdgcn_readfirstlane(Ei[e0 + k]) & 16383; const unsigned char* up = U6 + (size_t)id * ROW6;
                    const v4u a = *(const v4u*)(up + lane * 16); const v2u b = *(const v2u*)(up + 1024 + lane * 8); w[k] = (v6u){a.x, a.y, a.z, a.w, b.x, b.y}; }
            };
            auto compu = [&](const v6u (&w)[4], int e0) {
                float s[4];
#pragma unroll
                for (int k = 0; k < 4; ++k) { const v32f y = __builtin_amdgcn_cvt_scalef32_pk32_f32_fp6(w[k], 1.0f); f32x2 a = (f32x2){0.f, 0.f};
#pragma unroll
                    for (int i = 0; i < 16; ++i) a += (f32x2){y[2 * i], y[2 * i + 1]} * (f32x2){x[2 * i], x[2 * i + 1]};
                    s[k] = a.x + a.y; }
                float u1;
                { const auto r02 = __builtin_amdgcn_permlane32_swap(__float_as_uint(s[0]), __float_as_uint(s[2]), false, false);
                  const auto r13 = __builtin_amdgcn_permlane32_swap(__float_as_uint(s[1]), __float_as_uint(s[3]), false, false);
                  const float a02 = __uint_as_float(r02[0]) + __uint_as_float(r02[1]), a13 = __uint_as_float(r13[0]) + __uint_as_float(r13[1]);
                  const auto rr = __builtin_amdgcn_permlane16_swap(__float_as_uint(a02), __float_as_uint(a13), false, false);
                  u1 = row16_sum(__uint_as_float(rr[0]) + __uint_as_float(rr[1])); }
                if ((lane & 15) == 0) { const int k = lane >> 4; Eg[e0 + k] = Eg[e0 + k] * gelu_exact(u1 * (1.f / U_SCALE)) * (1.f / V_SCALE); }
            };
            v6u wa[4], wb[4], wc[4];
            loadu(wa, 0); loadu(wb, 4);
#pragma unroll 1
            for (int e0 = 0; e0 < 120; e0 += 12) {
                loadu(wc, e0 + 8);
                compu(wa, e0);
                loadu(wa, e0 + 12);
                compu(wb, e0 + 4);
                loadu(wb, e0 + 16);
                compu(wc, e0 + 8);
            }
            compu(wa, 120); compu(wb, 124);
        }
        LDS_WAIT();
        v32f o;
#pragma unroll
        for (int i = 0; i < 32; ++i) o[i] = 0.f;
        {
            auto loadv = [&](v6u (&w)[4], int e0) {
#pragma unroll
                for (int k = 0; k < 4; ++k) { const int id = __builtin_amdgcn_readfirstlane(Ei[e0 + k]) & 16383; const unsigned char* vp = V6 + (size_t)id * ROW6;
                    const v4u a = *(const v4u*)(vp + lane * 16); const v2u b = *(const v2u*)(vp + 1024 + lane * 8); w[k] = (v6u){a.x, a.y, a.z, a.w, b.x, b.y}; }
            };
            auto compv = [&](const v6u (&w)[4], int e0) {
#pragma unroll
                for (int k = 0; k < 4; ++k) { const float wt = Eg[e0 + k]; const v32f y = __builtin_amdgcn_cvt_scalef32_pk32_f32_fp6(w[k], 1.0f); o += y * wt; }
            };
            v6u wa[4], wb[4], wc[4];
            loadv(wa, 0); loadv(wb, 4);
#pragma unroll 1
            for (int e0 = 0; e0 < 120; e0 += 12) {
                loadv(wc, e0 + 8);
                compv(wa, e0);
                loadv(wa, e0 + 12);
                compv(wb, e0 + 4);
                loadv(wb, e0 + 16);
                compv(wc, e0 + 8);
            }
            compv(wa, 120); compv(wb, 124);
        }
        float s1 = 0.f;
#pragma unroll
        for (int i = 0; i < 32; ++i) { o[i] = x[i] * ALPHA + o[i]; s1 += o[i]; }
        const float mean = wave_sum(s1) * (1.f / D); float s2 = 0.f;
#pragma unroll
        for (int i = 0; i < 32; ++i) { o[i] = o[i] - mean; s2 += o[i] * o[i]; }
        const float rstd2 = 1.f / sqrtf(wave_sum(s2) * (1.f / D) + LN_EPS);
#pragma unroll
        for (int q = 0; q < 8; ++q) {
            const int e0 = lane * 32 + q * 4;
            const f32x4 g = *(const LAS f32x4*)(PAR + 4096 + e0), bb = *(const LAS f32x4*)(PAR + 6144 + e0);
            float oo[4];
#pragma unroll
            for (int c = 0; c < 4; ++c) { const int i = q * 4 + c; oo[c] = o[MK_FP6_ORDER ? ((i & 15) * 2 + (i >> 4)) : i]; }
            f32x4 y; y.x = oo[0] * rstd2 * g.x + bb.x; y.y = oo[1] * rstd2 * g.y + bb.y; y.z = oo[2] * rstd2 * g.z + bb.z; y.w = oo[3] * rstd2 * g.w + bb.w;
            *(f32x4*)(p.out + (size_t)r * D + e0) = y;
        }
    }
}

__device__ __forceinline__ void phase_gemm_in(const Params& p, LAS unsigned char* lds) {
    pg8::Gemm g{(const bf16*)(p.ws + WS_H0F8), (const bf16*)(p.ws + WS_BT_IN8), MP, NINP, D / 2};
    pg8::StaticOrder S; S.init(MP, NINP, gridDim.x, blockIdx.x, MK_WGM_IN); S.colmap = MK_COLMAP;
    pg8::EpiInProj E{p.ws, (unsigned char*)p.out};
#if MK_STAG
    { const unsigned long long t0 = wall_clock64(); const unsigned long long d = (unsigned long long)(blockIdx.x & 3) * MK_STAG; while (wall_clock64() - t0 < d) __builtin_amdgcn_s_sleep(8); }
#endif
    pg8::gemm_phase<pg8::EpiInProj, pg8::StaticOrder, true, true, true>(lds, g, S, E);
}
__device__ __forceinline__ void phase_gemm_g2a(const Params& p, LAS unsigned char* lds) {
    pg8::Gemm g{(const bf16*)(p.ws + WS_YA8), (const bf16*)(p.ws + WS_BT_PA), MX, D, D / 2};
    pg8::StaticOrder S; S.init(MX, D, gridDim.x, blockIdx.x, MK_WGM_SQ);
    pg8::EpiGate<false> E{(const bf16*)(MK_DBG == 16 ? p.ws + WS_H0 : MK_DBG == 14 ? p.ws + 489 * MiB : (unsigned char*)p.out + OUT_SGA), nullptr, (bf16*)(p.ws + WS_TMP)};
    pg8::gemm_phase<pg8::EpiGate<false>, pg8::StaticOrder, MK_ALIGN, MK_SP2, true>(lds, g, S, E);
}
__device__ __forceinline__ void phase_gemm_g2b(const Params& p, LAS unsigned char* lds) {
    pg8::Gemm g{(const bf16*)(p.ws + WS_YB), (const bf16*)(p.ws + WS_BT_PB), MX, D, D / 2};
    pg8::StaticOrder S; S.init(MX, D, gridDim.x, blockIdx.x, MK_WGM_SQ);
    pg8::EpiGate<true> E{(const bf16*)((unsigned char*)p.out + OUT_SGB), (const bf16*)(p.ws + WS_TMP), (bf16*)(p.ws + WS_MERGED)};
    pg8::gemm_phase<pg8::EpiGate<true>, pg8::StaticOrder, MK_ALIGN, MK_SP2, true>(lds, g, S, E);
}
__device__ __forceinline__ void phase_gemm_g2(const Params& p, LAS unsigned char* lds) {
    static_assert(WS_YB > WS_YA8 && WS_BT_PB > WS_BT_PA, "the second product's operands sit behind the first's");
    pg8::Gemm g{(const bf16*)(p.ws + WS_YA8), (const bf16*)(p.ws + WS_BT_PA), MX, D, D / 2};
    pg8::StaticOrder S; S.init(MX, D, gridDim.x, blockIdx.x, MK_WGM_SQ);
    pg8::EpiGate2 E{(const unsigned char*)p.out + OUT_SGA, (const unsigned char*)p.out + OUT_SGB, p.ws + WS_MERGED};
    pg8::gemm_phase<pg8::EpiGate2, pg8::StaticOrder, MK_ALIGN, MK_SP2, true>(lds, g, S, E);
}
__device__ __forceinline__ void phase_gemm_g3(const Params& p, LAS unsigned char* lds) {
    pg8::Gemm g{(const bf16*)(p.ws + WS_MERGED), (const bf16*)(p.ws + WS_BT_WO), MX, D, D / 2};
    pg8::StaticOrder S; S.init(MX, D, gridDim.x, blockIdx.x, MK_WGM_SQ);
    pg8::EpiResid E{(const bf16*)(p.ws + WS_H0), (bf16*)(p.ws + WS_R)};
    pg8::gemm_phase<pg8::EpiResid, pg8::StaticOrder, MK_ALIGN, MK_SP2, true>(lds, g, S, E);
}
__device__ __forceinline__ void phase_gemm_pq(const Params& p, LAS unsigned char* lds) {
    pg8::Gemm g{(const bf16*)(p.ws + WS_R), (const bf16*)(p.ws + WS_BT_F), MX, D, D};
    pg8::StaticOrder S; S.init(MX, D, gridDim.x, blockIdx.x, MK_WGM_SQ);
    pg8::EpiScores E{(_Float16*)(p.ws + WS_TMP)};
    pg8::gemm_phase<pg8::EpiScores, pg8::StaticOrder, MK_ALIGN, MK_SP2>(lds, g, S, E);
}


namespace ml {
typedef short s16x4 __attribute__((ext_vector_type(4)));
typedef short bf16x8 __attribute__((ext_vector_type(8)));
typedef float f32x16 __attribute__((ext_vector_type(16)));
using mk::v4u; using mk::f32x4; using mk::bf16; using mk::Params;
constexpr int QROW = 272, KROW = 320, VROW = 576, PROW = 144, HROW = 528;
constexpr int L_QS = 0, L_QS2 = L_QS + 64 * QROW, L_KS = L_QS2 + 64 * QROW, L_VS = L_KS + 64 * KROW, L_PS = L_VS + 64 * VROW, L_HS = L_PS + 64 * PROW;
constexpr int L_VEC = L_HS + 64 * HROW;
constexpr int VECSET = 6 * 256;
constexpr int L_NS = L_VEC + 2 * VECSET;
constexpr int L_DEN = L_NS + 1024;
constexpr int L_TAB = L_DEN + 256;
constexpr int L_END = L_TAB + 1088;
static_assert(L_END <= mk::LDS_BYTES, "mLSTM LDS map");
constexpr size_t STATE_F = 32768 + 128;
constexpr size_t WS_STATE = mk::WS_BT_IN;
constexpr size_t WS_DT = mk::WS_BT_IN + 16 * 16 * STATE_F * 4;
static_assert(WS_DT + 1024 <= mk::WS_CB, "state region");

__device__ __forceinline__ int crow(int reg, int h) { return (reg & 3) + 8 * (reg >> 2) + 4 * h; }
__device__ __forceinline__ float scan_add(float v, int lane) {
#pragma unroll
    for (int o = 1; o < 64; o <<= 1) { const float t = __shfl_up(v, o); if (lane >= o) v += t; }
    return v;
}
__device__ __forceinline__ float scan_max(float v, int lane) {
#pragma unroll
    for (int o = 1; o < 64; o <<= 1) { const float t = __shfl_up(v, o); if (lane >= o) v = fmaxf(v, t); }
    return v;
}
__device__ __forceinline__ float wave_max(float v) {
#pragma unroll
    for (int o = 1; o < 64; o <<= 1) v = fmaxf(v, __shfl_xor(v, o));
    return v;
}
__device__ __forceinline__ void gate_load(const Params& p, int b, int hd, int ci, int lane, float& ip, float& fp) {
    const float* GIF = (const float*)(p.ws + mk::WS_GIF);
    const int row = (ci == 0) ? mk::MX + (lane & 15) : b * mk::SEQ + (ci - 1) * 64 + lane;
    ip = GIF[(size_t)row * 16 + hd]; fp = GIF[(size_t)row * 16 + 8 + hd];
}
__device__ __forceinline__ void gate_math(const Params& p, int hd, int ci, int lane, float ip, float fp, float& li, float& lf) {
    const bool pad = (ci == 0) && lane >= 16;
    ip += p.b_if[hd]; fp += p.b_if[8 + hd];
    li = pad ? -1e30f : ip;
    lf = pad ? 0.f : (fminf(fp, 0.f) - log1pf(__expf(-fabsf(fp))));
}
__device__ __forceinline__ bf16x8 tr_frag(LAS unsigned char* tile, int rowstride, int k0, int n0, int lane) {
    const int h = lane >> 5, blk = (lane >> 4) & 1, q = (lane & 15) >> 2, pp = lane & 3;
    LAS unsigned char* a = tile + (k0 + 8 * h + q) * rowstride + 2 * (n0 + 16 * blk + 4 * pp);
    const s16x4 lo = __builtin_amdgcn_ds_read_tr16_b64_v4i16((LAS s16x4*)a);
    const s16x4 hi = __builtin_amdgcn_ds_read_tr16_b64_v4i16((LAS s16x4*)(a + 4 * rowstride));
    return __builtin_shufflevector(lo, hi, 0, 1, 2, 3, 4, 5, 6, 7);
}
#define ML_MFMA32(a, b, c) __builtin_amdgcn_mfma_f32_32x32x16_bf16((a), (b), (c), 0, 0, 0)
#define ML_MFMA16(a, b, c) __builtin_amdgcn_mfma_f32_16x16x32_bf16((a), (b), (c), 0, 0, 0)

template <bool FULL>
__device__ __forceinline__ void mlstm_pass(const Params& p, LAS unsigned char* lds) {
    const int tid = pg8::ftid(), lane = tid & 63, w = __builtin_amdgcn_readfirstlane(tid >> 6);
    const int r = lane & 31, h5 = lane >> 5;
    const bf16* Qg = (const bf16*)(p.ws + mk::WS_Q); const bf16* Kg = (const bf16*)(p.ws + mk::WS_K); bf16* Vg = (bf16*)(p.ws + mk::WS_V);
    const bf16* SOg = (const bf16*)(p.ws + mk::WS_SIGO);
    float* STATE = (float*)(p.ws + WS_STATE); float* MU = (float*)(p.ws + WS_DT); float* BLS = MU + 256; const float* MSTART = MU + 512;
    LAS float* DEN = (LAS float*)(lds + L_DEN);
    int kc = 0;
    const int cgt = blockIdx.x * 512 + tid, cNT = gridDim.x * 512;
    for (int item = blockIdx.x; item < 256; item += gridDim.x) {
        const int bh = item >> 4, j = item & 15, b = bh >> 3, hd = bh & 7;
        const int nchunks = (j == 0) ? 9 : 8, ci0 = (j == 0) ? 0 : 8 * j + 1;
        float m_prev = FULL ? MSTART[bh * 16 + j] : -INFINITY;
        float blsum = 0.f;
        f32x16 Cacc[4];
        if (FULL && j > 0) {
            const float* src = STATE + ((size_t)bh * 16 + (j - 1)) * STATE_F;
#pragma unroll
            for (int i = 0; i < 4; ++i)
#pragma unroll
                for (int g = 0; g < 16; ++g) Cacc[i][g] = src[((w * 4 + i) * 16 + g) * 64 + lane];
            if (tid < 128) ((LAS float*)(lds + L_NS))[tid] = src[32768 + tid];
        } else {
#pragma unroll
            for (int i = 0; i < 4; ++i)
#pragma unroll
                for (int g = 0; g < 16; ++g) Cacc[i][g] = 0.f;
            if (tid < 128) ((LAS float*)(lds + L_NS))[tid] = 0.f;
        }
        v4u pq[2], pk[2], pv[4];
        auto issue_loads = [&](int ci, int tl) {
            const bool meta = (ci == 0);
            const bf16* kb = meta ? Kg + (size_t)16 * 8192 * 128 + (size_t)hd * 16 * 128 : Kg + ((size_t)bh * 8192 + (ci - 1) * 64) * 128;
            const bf16* vb = meta ? Vg + (size_t)16 * 8192 * 256 + (size_t)hd * 16 * 256 : Vg + ((size_t)bh * 8192 + (ci - 1) * 64) * 256;
            const bf16* qb = Qg + ((size_t)bh * 8192 + (meta ? 0 : (ci - 1) * 64)) * 128;
#pragma unroll
            for (int u = 0; u < 2; ++u) { const int id = tl + 512 * u, rr = id >> 4;
                const bool ok = !meta || rr < 16;
                pk[u] = ok ? *(const v4u*)(kb + (size_t)id * 8) : (v4u){0u, 0u, 0u, 0u};
                if (FULL) pq[u] = !meta ? *(const v4u*)(qb + (size_t)id * 8) : (v4u){0u, 0u, 0u, 0u}; }
#pragma unroll
            for (int u = 0; u < 4; ++u) { const int id = tl + 512 * u, rr = id >> 5;
                const bool ok = !meta || rr < 16;
                pv[u] = ok ? *(const v4u*)(vb + (size_t)id * 8) : (v4u){0u, 0u, 0u, 0u}; }
        };
        { int tl = tid; asm volatile("" : "+v"(tl)); issue_loads(ci0, tl); }
        float gip = 0.f, gfp = 0.f; if (w == 7) gate_load(p, b, hd, ci0, lane, gip, gfp);
        auto make_vec = [&](int kk) {
            const int cix = ci0 + kk;
            LAS float* VS_ = (LAS float*)(lds + L_VEC + (kk & 1) * VECSET);
            float li, lf; gate_math(p, hd, cix, lane, gip, gfp, li, lf);
            if (kk + 1 < nchunks) gate_load(p, b, hd, cix + 1, lane, gip, gfp);
            const float bb = scan_add(lf, lane); const float g = li - bb; const float G = fmaxf(m_prev, scan_max(g, lane));
            const float Gend = __shfl(G, 63), bl = __shfl(bb, 63);
            VS_[lane] = g; VS_[64 + lane] = G; VS_[128 + lane] = __expf(m_prev - G); VS_[192 + lane] = __expf(g - Gend); VS_[256 + lane] = __expf(-(bb + G));
            const float decay = __expf(m_prev - Gend);
            if (lane == 0) VS_[320] = decay;
            blsum += bl; m_prev = bl + Gend;
        };
        if (w == 7) make_vec(0);
#pragma unroll 1
        for (int k = 0; k < nchunks; ++k) {
            const int ci = ci0 + k; const bool meta = (ci == 0); const bool outp = FULL && !meta;
            int tl = tid; asm volatile("" : "+v"(tl));
            const int row0 = meta ? mk::MX : b * mk::SEQ + (ci - 1) * 64;
            LAS float* VEC = (LAS float*)(lds + L_VEC + (k & 1) * VECSET);
            LAS float* NScur = (LAS float*)(lds + L_NS + (k & 1) * 512); LAS float* NSnxt = (LAS float*)(lds + L_NS + ((k + 1) & 1) * 512);
#pragma unroll
            for (int u = 0; u < 2; ++u) { const int id = tid + 512 * u, rr = id >> 4, cp = id & 15;
                *(LAS v4u*)(lds + L_KS + rr * KROW + 16 * cp) = pk[u];
                if (FULL) *(LAS v4u*)(lds + L_QS + rr * QROW + 16 * cp) = pq[u]; }
#pragma unroll
            for (int u = 0; u < 4; ++u) { const int id = tid + 512 * u, rr = id >> 5, cp = id & 31; *(LAS v4u*)(lds + L_VS + rr * VROW + 16 * cp) = pv[u]; }
            __syncthreads();
            if (!FULL && k + 1 < nchunks) issue_loads(ci + 1, tl);
            mk::v2u czm2 = {0u, 0u}, czm1 = {0u, 0u}, cz[4], ccb[4]; int cs = -1;
            if (!FULL) { const int s_ = tl - tid + cgt + cNT * kc; if (k < 8 && s_ < mk::CONV_SLICES) { cs = s_; mk::conv_issue(p, cs, czm2, czm1, cz, ccb); ++kc; } }
            if (outp) {
#pragma unroll
                for (int u = 0; u < 2; ++u) { const int id = tid + 512 * u, rr = id >> 4, cp = id & 15; const float s = VEC[128 + rr]; const v4u q = pq[u];
                    v4u o; o.x = mk::pk2(mk::bflo(q.x) * s, mk::bfhi(q.x) * s); o.y = mk::pk2(mk::bflo(q.y) * s, mk::bfhi(q.y) * s); o.z = mk::pk2(mk::bflo(q.z) * s, mk::bfhi(q.z) * s); o.w = mk::pk2(mk::bflo(q.w) * s, mk::bfhi(q.w) * s);
                    *(LAS v4u*)(lds + L_QS2 + rr * QROW + 16 * cp) = o; }
            }
            if (outp) {
                const int ti = w >> 1, fr = lane & 15, fq = lane >> 4;
#pragma unroll
                for (int tt = 0; tt < 2; ++tt) { const int tj = 2 * (w & 1) + tt;
                    f32x4 sacc = (f32x4){0.f, 0.f, 0.f, 0.f};
                    if (tj <= ti) {
#pragma unroll
                        for (int kk = 0; kk < 4; ++kk) {
                            const bf16x8 a = *(const LAS bf16x8*)(lds + L_QS + (16 * ti + fr) * QROW + 2 * (32 * kk + 8 * fq));
                            const bf16x8 bb = *(const LAS bf16x8*)(lds + L_KS + (16 * tj + fr) * KROW + 2 * (32 * kk + 8 * fq));
                            sacc = ML_MFMA16(a, bb, sacc);
                        }
                    }
                    const int s = 16 * tj + fr; const float gs = VEC[s];
#pragma unroll
                    for (int i = 0; i < 4; ++i) { const int t = 16 * ti + 4 * fq + i; const float Gt = VEC[64 + t];
                        const float wgt = (s <= t) ? __expf(gs - Gt) : 0.f; const float pv_ = sacc[i] * wgt;
                        *(LAS unsigned short*)(lds + L_PS + t * PROW + 2 * s) = (unsigned short)(mk::pk2(pv_, 0.f) & 0xffffu); }
                }
            }
            __syncthreads();
            if (w == 7 && k + 1 < nchunks) make_vec(k + 1);
            v4u po[4];
            if (outp) {
#pragma unroll
                for (int u = 0; u < 4; ++u) po[u] = *(const v4u*)(SOg + ((size_t)bh * 8192 + (ci - 1) * 64 + (tl >> 3)) * 256 + 32 * (tl & 7) + 8 * u);
            }
            bf16x8 vf[4];
#pragma unroll
            for (int ks = 0; ks < 4; ++ks) vf[ks] = tr_frag(lds + L_VS, VROW, 16 * ks, 32 * w, lane);
            f32x16 Hacc[2];
            if (outp) {
#pragma unroll
                for (int ti = 0; ti < 2; ++ti) {
#pragma unroll
                    for (int g = 0; g < 16; ++g) Hacc[ti][g] = 0.f;
#pragma unroll
                    for (int ks = 0; ks < 4; ++ks) { const bf16x8 a = *(const LAS bf16x8*)(lds + L_PS + (32 * ti + r) * PROW + 2 * (16 * ks + 8 * h5)); Hacc[ti] = ML_MFMA32(a, vf[ks], Hacc[ti]); }
                    asm volatile("" ::: "memory");
                }
#pragma unroll
                for (int i = 0; i < 4; ++i)
#pragma unroll
                    for (int s = 0; s < 2; ++s) {
                        v4u cb; cb.x = mk::pk2(Cacc[i][8 * s], Cacc[i][8 * s + 1]); cb.y = mk::pk2(Cacc[i][8 * s + 2], Cacc[i][8 * s + 3]); cb.z = mk::pk2(Cacc[i][8 * s + 4], Cacc[i][8 * s + 5]); cb.w = mk::pk2(Cacc[i][8 * s + 6], Cacc[i][8 * s + 7]);
                        const bf16x8 bfrag = __builtin_bit_cast(bf16x8, cb);
#pragma unroll
                        for (int ti = 0; ti < 2; ++ti) {
                            const LAS unsigned char* qa = lds + L_QS2 + (32 * ti + r) * QROW + 2 * (32 * i + 16 * s + 4 * h5);
                            const s16x4 lo = *(const LAS s16x4*)qa, hi = *(const LAS s16x4*)(qa + 16);
                            Hacc[ti] = ML_MFMA32(__builtin_shufflevector(lo, hi, 0, 1, 2, 3, 4, 5, 6, 7), bfrag, Hacc[ti]);
                        }
                        asm volatile("" ::: "memory");
                    }
                { const int t = tid >> 3, part = tid & 7;
                  const v4u pr = *(const LAS v4u*)(lds + L_PS + t * PROW + 16 * part);
                  float d = ((mk::bflo(pr.x) + mk::bfhi(pr.x)) + (mk::bflo(pr.y) + mk::bfhi(pr.y))) + ((mk::bflo(pr.z) + mk::bfhi(pr.z)) + (mk::bflo(pr.w) + mk::bfhi(pr.w)));
#pragma unroll
                  for (int u = 0; u < 2; ++u) { const v4u qv = *(const LAS v4u*)(lds + L_QS2 + t * QROW + 32 * part + 16 * u); const LAS float* nn = NScur + 16 * part + 8 * u;
                      d += mk::bflo(qv.x) * nn[0] + mk::bfhi(qv.x) * nn[1] + mk::bflo(qv.y) * nn[2] + mk::bfhi(qv.y) * nn[3] + mk::bflo(qv.z) * nn[4] + mk::bfhi(qv.z) * nn[5] + mk::bflo(qv.w) * nn[6] + mk::bfhi(qv.w) * nn[7]; }
                  d = mk::oct_sum(d);
                  if (part == 0) DEN[t] = d; }
            }
            if (outp) {
#pragma unroll
                for (int ti = 0; ti < 2; ++ti)
#pragma unroll
                    for (int g = 0; g < 16; ++g) *(LAS unsigned short*)(lds + L_HS + (32 * ti + crow(g, h5)) * HROW + 2 * (32 * w + r)) = (unsigned short)(mk::pk2(Hacc[ti][g], 0.f) & 0xffffu);
            }
            if (FULL && k + 1 < nchunks) issue_loads(ci + 1, tl);
            {
                const float decay = VEC[320];
#pragma unroll
                for (int ks = 0; ks < 4; ++ks) { const f32x4 w0 = *(const LAS f32x4*)(VEC + 192 + 16 * ks + 8 * h5), w1 = *(const LAS f32x4*)(VEC + 192 + 16 * ks + 8 * h5 + 4);
                    const v4u x = __builtin_bit_cast(v4u, vf[ks]); v4u o;
                    o.x = mk::pk2(mk::bflo(x.x) * w0.x, mk::bfhi(x.x) * w0.y); o.y = mk::pk2(mk::bflo(x.y) * w0.z, mk::bfhi(x.y) * w0.w);
                    o.z = mk::pk2(mk::bflo(x.z) * w1.x, mk::bfhi(x.z) * w1.y); o.w = mk::pk2(mk::bflo(x.w) * w1.z, mk::bfhi(x.w) * w1.w);
                    vf[ks] = __builtin_bit_cast(bf16x8, o); }
#pragma unroll
                for (int i = 0; i < 4; ++i) {
#pragma unroll
                    for (int g = 0; g < 16; ++g) Cacc[i][g] *= decay;
#pragma unroll
                    for (int ks = 0; ks < 4; ++ks) { const bf16x8 a = tr_frag(lds + L_KS, KROW, 16 * ks, 32 * i, lane); Cacc[i] = ML_MFMA32(a, vf[ks], Cacc[i]); }
                    asm volatile("" ::: "memory");
                }
                if (tid < 128) { float a = decay * NScur[tid];
#pragma unroll 8
                    for (int s = 0; s < 64; ++s) a += VEC[192 + s] * mk::bf2f(*(const LAS unsigned short*)(lds + L_KS + s * KROW + 2 * tid));
                    NSnxt[tid] = a; }
            }
            if (!FULL) { if (cs >= 0) mk::conv_finish(p, cs, czm2, czm1, cz, ccb); }
            __syncthreads();
            if (outp) {
                const int t = tl >> 3, part = tl & 7;
                v4u hv[4]; float ss = 0.f;
#pragma unroll
                for (int u = 0; u < 4; ++u) { hv[u] = *(const LAS v4u*)(lds + L_HS + t * HROW + 2 * (32 * part + 8 * u));
                    const float a0 = mk::bflo(hv[u].x), a1 = mk::bfhi(hv[u].x), a2 = mk::bflo(hv[u].y), a3 = mk::bfhi(hv[u].y), a4 = mk::bflo(hv[u].z), a5 = mk::bfhi(hv[u].z), a6 = mk::bflo(hv[u].w), a7 = mk::bfhi(hv[u].w);
                    ss += ((a0 * a0 + a1 * a1) + (a2 * a2 + a3 * a3)) + ((a4 * a4 + a5 * a5) + (a6 * a6 + a7 * a7)); }
                ss = mk::oct_sum(ss);
                const float inv = 1.f / fmaxf(fabsf(DEN[t]), VEC[256 + t]);
                const float sc = inv / sqrtf(inv * inv * ss * (1.f / 256.f) + mk::LN_EPS);
                const float* nw = p.mh_w + hd * 256 + 32 * part; asm volatile("" : "+v"(nw));
                unsigned char* dst = p.ws + mk::WS_YB + (size_t)(row0 + t) * 2048 + hd * 256 + 32 * part;
                unsigned o8[8];
#pragma unroll
                for (int u = 0; u < 4; ++u) { const f32x4 n0 = *(const f32x4*)(nw + 8 * u), n1 = *(const f32x4*)(nw + 8 * u + 4); const v4u so = po[u], hh = hv[u];
                    o8[2 * u] = mk::pk4_fp8(mk::bflo(so.x) * n0.x * sc * mk::bflo(hh.x), mk::bfhi(so.x) * n0.y * sc * mk::bfhi(hh.x), mk::bflo(so.y) * n0.z * sc * mk::bflo(hh.y), mk::bfhi(so.y) * n0.w * sc * mk::bfhi(hh.y));
                    o8[2 * u + 1] = mk::pk4_fp8(mk::bflo(so.z) * n1.x * sc * mk::bflo(hh.z), mk::bfhi(so.z) * n1.y * sc * mk::bfhi(hh.z), mk::bflo(so.w) * n1.z * sc * mk::bflo(hh.w), mk::bfhi(so.w) * n1.w * sc * mk::bfhi(hh.w)); }
                *(v4u*)dst = (v4u){o8[0], o8[1], o8[2], o8[3]}; *(v4u*)(dst + 16) = (v4u){o8[4], o8[5], o8[6], o8[7]};
            }
        }
        if (!FULL) {
            float* dst = STATE + ((size_t)bh * 16 + j) * STATE_F;
#pragma unroll
            for (int i = 0; i < 4; ++i)
#pragma unroll
                for (int g = 0; g < 16; ++g) dst[((w * 4 + i) * 16 + g) * 64 + lane] = Cacc[i][g];
            if (tid < 128) dst[32768 + tid] = ((LAS float*)(lds + L_NS + (nchunks & 1) * 512))[tid];
            if (tid == 448) { MU[bh * 16 + j] = m_prev; BLS[bh * 16 + j] = blsum; }
        }
        __syncthreads();
    }
    if (!FULL) {
#pragma unroll 1
        for (;; ++kc) { const long long s_ = (long long)cgt + (long long)cNT * kc; if (s_ >= mk::CONV_SLICES) break;
            mk::v2u czm2, czm1, cz[4], ccb[4]; mk::conv_issue(p, (int)s_, czm2, czm1, cz, ccb); mk::conv_finish(p, (int)s_, czm2, czm1, cz, ccb); }
    }
}
__device__ __forceinline__ void mlstm_combine(const Params& p) {
    float* STATE = (float*)(p.ws + WS_STATE); const float* MU = (const float*)(p.ws + WS_DT); const float* BLS = MU + 256; float* MSTART = (float*)(p.ws + WS_DT) + 512;
    const int tid = pg8::ftid();
#pragma unroll 1
    for (int w = blockIdx.x; w < 256; w += gridDim.x) {
        const int bh = w >> 4, sub = w & 15;
        float dj[15], sa[15]; float mm = 0.f;
        if (sub == 0 && tid == 0) MSTART[bh * 16] = 0.f;
#pragma unroll
        for (int j = 0; j < 15; ++j) {
            const float mu = MU[bh * 16 + j], bls = BLS[bh * 16 + j];
            const float mn = bls + fmaxf(mm, mu - bls);
            dj[j] = __expf(mm + bls - mn); sa[j] = __expf(mu - mn); mm = mn;
            if (sub == 0 && tid == 0) MSTART[bh * 16 + j + 1] = mn;
        }
        float a[5][15];
#pragma unroll
        for (int k = 0; k < 5; ++k) { const int el = sub * 512 + tid + k * 8192; const bool ok = el < STATE_F;
#pragma unroll
            for (int j = 0; j < 15; ++j) a[k][j] = ok ? STATE[((size_t)bh * 16 + j) * STATE_F + el] : 0.f; }
#pragma unroll
        for (int k = 0; k < 5; ++k) { float c = 0.f;
#pragma unroll
            for (int j = 0; j < 15; ++j) { c = dj[j] * c + sa[j] * a[k][j]; a[k][j] = c; } }
#pragma unroll
        for (int k = 0; k < 5; ++k) { const int el = sub * 512 + tid + k * 8192;
            if (el < STATE_F) {
#pragma unroll
                for (int j = 0; j < 15; ++j) STATE[((size_t)bh * 16 + j) * STATE_F + el] = a[k][j]; } }
    }
}
}
typedef GAS unsigned gu32;
#define XB_TMO      128
#define XB_XCNT(j)  (256  + 64 * (j))
#define XB_XSUB(j)  (1280 + 64 * (j))
#define XB_XGEN(j)  (2304 + 64 * (j))
#define XB_TOP      3328
#define XB_TOPGEN   3392
#define XCD_BAR_WORDS 3456
#define XB_SPIN_CAP (1u << 18)

__device__ __forceinline__ unsigned xb_ld(unsigned* p)              { return __hip_atomic_load(p, __ATOMIC_RELAXED, __HIP_MEMORY_SCOPE_AGENT); }
__device__ __forceinline__ unsigned xb_add(unsigned* p, unsigned v) { return __hip_atomic_fetch_add(p, v, __ATOMIC_RELAXED, __HIP_MEMORY_SCOPE_AGENT); }
__device__ __forceinline__ unsigned xb_xcc_id() { return (unsigned)__builtin_amdgcn_s_getreg((3 << 11) | 20) & 0xFu; }
#define XB_SPIN(cond, bar) do { unsigned _sp = 0; while (cond) { __builtin_amdgcn_s_sleep(1); \
    if ((++_sp & 255u) == 0u) { if (xb_ld(&(bar)[XB_TMO])) break; if (_sp > XB_SPIN_CAP) { atomicAdd(&(bar)[XB_TMO], 1u); break; } } } } while (0)

struct XcdBarrier {
    unsigned* bar; unsigned x;
    volatile LAS unsigned* st;
};

__device__ __forceinline__ XcdBarrier xcd_barrier_post(unsigned* bar, volatile LAS unsigned* st) {
    XcdBarrier b; b.bar = bar; b.x = xb_xcc_id(); b.st = st;
    if (threadIdx.x == 0) (void)xb_add(&bar[XB_XCNT(b.x)], 1u);
    return b;
}
__device__ __forceinline__ void xcd_barrier_complete(unsigned* bar, unsigned x, unsigned& nloc, unsigned& nx) {
    const unsigned G = gridDim.x * gridDim.y * gridDim.z;
    unsigned sum, cnt, mine, sp = 0u;
    for (;;) {
        sum = 0u; cnt = 0u; mine = 0u;
#pragma unroll 1
        for (unsigned j = 0; j < 16; ++j) { const unsigned c = xb_ld(&bar[XB_XCNT(j)]); sum += c; cnt += (c > 0u) ? 1u : 0u; mine = (j == x) ? c : mine; }
        if (sum == G) break;
        __builtin_amdgcn_s_sleep(1);
        if ((++sp & 255u) == 0u) { if (xb_ld(&bar[XB_TMO])) break; if (sp > XB_SPIN_CAP) { atomicAdd(&bar[XB_TMO], 1u); break; } }
    }
    nloc = mine > 0u ? mine : 1u; nx = cnt > 0u ? cnt : 1u;
}

__device__ __forceinline__ void xcd_barrier(const XcdBarrier& b) {
    asm volatile("s_waitcnt vmcnt(0)" ::: "memory");
    __syncthreads();
    if (threadIdx.x == 0) {
        unsigned* bar = b.bar;
        __builtin_amdgcn_s_waitcnt(0);
        unsigned nloc = b.st[0], nx = b.st[1];
        if (nloc == 0u) { xcd_barrier_complete(bar, b.x, nloc, nx); b.st[0] = nloc; b.st[1] = nx; }
        const unsigned old = xb_add(&bar[XB_XSUB(b.x)], 1u);
        const unsigned gen = old / nloc;
        if (old + 1u == (gen + 1u) * nloc) {
            __builtin_amdgcn_fence(__ATOMIC_RELEASE, "agent");
            asm volatile("s_waitcnt vmcnt(0)" ::: "memory");
            const unsigned og = xb_add(&bar[XB_TOP], 1u);
            const unsigned tg = og / nx;
            if (og + 1u == (tg + 1u) * nx) xb_add(&bar[XB_TOPGEN], 1u);
            else XB_SPIN(xb_ld(&bar[XB_TOPGEN]) == tg, bar);
            __builtin_amdgcn_fence(__ATOMIC_ACQUIRE, "agent");
            xb_add(&bar[XB_XGEN(b.x)], 1u);
            asm volatile("s_waitcnt vmcnt(0)" ::: "memory");
        } else {
            XB_SPIN(xb_ld(&bar[XB_XGEN(b.x)]) == gen, bar);
            __builtin_amdgcn_fence(__ATOMIC_ACQUIRE, "agent");
            asm volatile("s_waitcnt vmcnt(0)" ::: "memory");
        }
    }
    __syncthreads();
}

constexpr int CW_BAR = 4096;
constexpr int LDS_BARST = LDS_BYTES - 64;
static_assert((CW_BAR + XCD_BAR_WORDS) * 4 <= 65536, "barrier words inside the memset region");
__global__ void __launch_bounds__(512, 2) k_fused(Params p) {
    extern __shared__ __attribute__((aligned(16))) unsigned char lds_raw[]; LAS unsigned char* lds = (LAS unsigned char*)lds_raw;
    if (pg8::ftid() < 16) ((LAS unsigned*)(lds + LDS_BARST))[pg8::ftid()] = 0u;
    __syncthreads();
    (void)xcd_barrier_post((unsigned*)(p.ws + WS_CTL) + CW_BAR, (volatile LAS unsigned*)(lds + LDS_BARST));
#define GRID_SYNC() do { XcdBarrier b_; b_.bar = (unsigned*)(p.ws + WS_CTL) + CW_BAR; b_.x = xb_xcc_id(); b_.st = (volatile LAS unsigned*)(lds + LDS_BARST); xcd_barrier(b_); } while (0)
#define MK_REP(bit) for (int rep_ = 0; rep_ < (((MK_PROBE) >> (bit)) & 1) + 1; ++rep_)
    MK_REP(0) { phase0(p, lds); GRID_SYNC(); }
    MK_REP(1) { phase_gemm_in(p, lds); phase_uvconv_early(p); GRID_SYNC(); }
    MK_REP(2) { ml::mlstm_pass<false>(p, lds); } phase_c1c0(p); GRID_SYNC();
    ml::mlstm_combine(p); GRID_SYNC();
    MK_REP(8) { ml::mlstm_pass<true>(p, lds); } GRID_SYNC();
    MK_REP(3) { phase_uvconv(p); }
    MK_REP(4) { phase_gemm_g2(p, lds); } GRID_SYNC();
    MK_REP(5) { phase_gemm_g3(p, lds); GRID_SYNC(); }
    MK_REP(6) { phase_gemm_pq(p, lds); GRID_SYNC(); }
    if ((MK_PROBE >> 7) & 1) { for (int i = 0; i < 8; ++i) GRID_SYNC(); }
    phase_peer(p, lds);
}
}

extern "C" void kernel_launch(void* const* d_in, const int* in_sizes, int n_in, void* d_out, int out_size, void* d_ws, size_t ws_size, hipStream_t stream) {
    using namespace mk;
    static int grid = 0;
    if (grid == 0) {
        if (n_in != 19 || ws_size < WS_END || out_size != MX * D) { fprintf(stderr, "kernel_launch: unexpected shapes (n_in %d, ws %zu, out %d)\n", n_in, ws_size, out_size); grid = -1; return; }
        if (hipFuncSetAttribute((const void*)k_fused, hipFuncAttributeMaxDynamicSharedMemorySize, LDS_BYTES) != hipSuccess) { fprintf(stderr, "kernel_launch: hipFuncSetAttribute failed\n"); grid = -1; return; }
        int dev = 0, cus = 0, per_cu = 0; (void)hipGetDevice(&dev); (void)hipDeviceGetAttribute(&cus, hipDeviceAttributeMultiprocessorCount, dev);
        if (hipOccupancyMaxActiveBlocksPerMultiprocessor(&per_cu, (const void*)k_fused, 512, LDS_BYTES) != hipSuccess || per_cu < 1) { fprintf(stderr, "kernel_launch: occupancy query says %d blocks per CU\n", per_cu); grid = -1; return; }
        grid = cus;
    }
    if (grid < 0) return;
    Params p{};
    const float** pf = (const float**)&p;
    for (int i = 0; i < 19; ++i) pf[i] = (const float*)d_in[i];
    p.out = (float*)d_out; p.ws = (unsigned char*)d_ws;
    if (hipMemsetAsync((char*)d_ws + WS_CTL, 0, 65536, stream) != hipSuccess) { fprintf(stderr, "kernel_launch: hipMemsetAsync of the barrier words failed\n"); return; }
    hipLaunchKernelGGL(k_fused, dim3(grid), dim3(512), LDS_BYTES, stream, p);
}
```

```cpp
#include <hip/hip_runtime.h>
#include <hip/hip_cooperative_groups.h>
#include <cstdio>
#include <cstdint>
namespace pg8 {
__device__ __forceinline__ int ftid() { int t = threadIdx.x; asm volatile("" : "+v"(t)); return t; }
#define PG8_LAS __attribute__((address_space(3)))
typedef unsigned short bf16_t;
typedef short bf16x8 __attribute__((ext_vector_type(8)));
typedef float f32x4 __attribute__((ext_vector_type(4)));
typedef unsigned u32x4 __attribute__((ext_vector_type(4)));
constexpr int BM = 256, BK = 64, HALF = 128, HTB = HALF * BK * 2  , STAGE_BYTES = 8 * HTB, NXCD = 8, WGM = 8;

__host__ __device__ __forceinline__ int lds_byte(int r, int c) { const int st = (r >> 4) * 2 + (c >> 5), rr = r & 15, cc = c & 31, ob = rr * 64 + cc * 2; return st * 1024 + (ob ^ (((ob >> 9) & 1) << 5)); }
__host__ __device__ __forceinline__ void stage_rc(int b, int& R, int& C) { const int st = b / 1024, sb = b % 1024, swz = sb ^ (((sb >> 9) & 1) << 5); R = (st >> 1) * 16 + swz / 64; C = (st & 1) * 32 + (swz % 64) / 2; }
__host__ __device__ __forceinline__ int perm32(int rho) { const int n = rho >> 4, i = rho & 15; return 8 * (i >> 2) + 4 * n + (i & 3); }

struct Unit { int pm, pn; };
struct Gemm { const bf16_t* A; const bf16_t* Bt; int M, N, K; };

struct StaticOrder {
    int nM, nN, nwg, G, c, wgm;
    __host__ __device__ void init(int M, int N, int G_, int c_, int wgm_ = WGM) { nM = M / BM; nN = N / BM; nwg = nM * nN; G = G_; c = c_; wgm = wgm_; }
    __host__ __device__ bool next(int i, Unit& u) const {
        const long L = (long)i * G + c; if (L >= nwg) return false;
        int wgid = (int)L; { const int q = nwg / NXCD, r = nwg % NXCD, xcd = wgid % NXCD, off = wgid / NXCD; wgid = (xcd < r ? xcd * (q + 1) : r * (q + 1) + (xcd - r) * q) + off; }
        const int nig = wgm * nN, gid = wgid / nig, fm = gid * wgm, gsz = (nM - fm) < wgm ? (nM - fm) : wgm;
        u.pm = fm + ((wgid % nig) % gsz); u.pn = (wgid % nig) / gsz;
        if (colmap) { const int s = u.pn; u.pn = s < 4 ? 24 + s : s < 29 ? 36 + s : s < 41 ? s - 1 : s - 41; }
        return true;
    }
    int colmap = 0;
    __device__ __forceinline__ void a_ready(const Unit&) const {}
    __device__ __forceinline__ void done(const Unit&) const {}
};

typedef __bf16 bf16x2_t __attribute__((ext_vector_type(2)));
__device__ __forceinline__ unsigned cvt_pk_bf16(float lo, float hi) { bf16x2_t v; v[0] = (__bf16)lo; v[1] = (__bf16)hi; return __builtin_bit_cast(unsigned, v); }
typedef float f32x2 __attribute__((ext_vector_type(2)));
__device__ __forceinline__ f32x2 gelu_pk(f32x2 v) {
    const f32x2 av = __builtin_elementwise_abs(v), d = av * 0.2316418882f + 1.0f;
    f32x2 t; t.x = __builtin_amdgcn_rcpf(d.x); t.y = __builtin_amdgcn_rcpf(d.y);
    f32x2 q = t * 0.5307027145f + (-0.7265760135f); q = q * t + 0.7107068705f; q = q * t + (-0.142248368f); q = q * t + 0.127414796f; q = q * t;
    const f32x2 s = (v * v) * (-0.72134752044f);
    f32x2 e; e.x = __builtin_amdgcn_exp2f(s.x); e.y = __builtin_amdgcn_exp2f(s.y);
    const f32x2 m = v * (q * e), r = v - m;
    f32x2 o; o.x = v.x < 0.f ? m.x : r.x; o.y = v.y < 0.f ? m.y : r.y; return o;
}

template <int ACT  > struct EpiBf16 {
    static constexpr bool PERM = true, AFTER_DRAIN = false; static_assert(ACT == 0 || ACT == 1, "EpiBf16: ACT is 0 (none) or 1 (gelu_pk)");
    bf16_t* O; int ldc; const float* bias; int split_cols; size_t split_stride; float scale0;
    __device__ __forceinline__ void operator()(const f32x4 (&acc)[2][2][4][2], const Unit& u, int wr, int wc, int fr, int fq) const {
        const int row0 = u.pm * BM + wr * 64 + fr; int colt = u.pn * BM; bf16_t* base = O;
        float sc = 1.f; if (split_cols) { const int t = colt / split_cols; base += (size_t)t * split_stride; colt -= t * split_cols; if (t == 0) sc = scale0; }
        const int col0 = colt + wc * 32 + 8 * fq, bcol0 = u.pn * BM + wc * 32 + 8 * fq;
        f32x4 bv[2][2];
#pragma unroll
        for (int bj = 0; bj < 2; ++bj)
#pragma unroll
            for (int n = 0; n < 2; ++n) bv[bj][n] = bias ? *(const f32x4*)(bias + bcol0 + bj * HALF + 4 * n) : (f32x4){0.f, 0.f, 0.f, 0.f};
#pragma unroll
        for (int ai = 0; ai < 2; ++ai)
#pragma unroll
            for (int m = 0; m < 4; ++m) { bf16_t* rowp = base + (size_t)(row0 + ai * HALF + m * 16) * ldc + col0;
#pragma unroll
                for (int bj = 0; bj < 2; ++bj) { f32x4 v0 = acc[ai][bj][m][0] + bv[bj][0], v1 = acc[ai][bj][m][1] + bv[bj][1];
                    if (ACT == 1) { f32x2 a = gelu_pk((f32x2){v0[0], v0[1]}), b = gelu_pk((f32x2){v0[2], v0[3]}), c = gelu_pk((f32x2){v1[0], v1[1]}), d = gelu_pk((f32x2){v1[2], v1[3]});
                        v0 = (f32x4){a.x, a.y, b.x, b.y}; v1 = (f32x4){c.x, c.y, d.x, d.y}; }
                    v0 = v0 * sc; v1 = v1 * sc; u32x4 w; w.x = cvt_pk_bf16(v0[0], v0[1]); w.y = cvt_pk_bf16(v0[2], v0[3]); w.z = cvt_pk_bf16(v1[0], v1[1]); w.w = cvt_pk_bf16(v1[2], v1[3]);
                    *(u32x4*)(rowp + bj * HALF) = w; } }
    }
};
typedef int i32x4 __attribute__((ext_vector_type(4)));
__device__ __forceinline__ const char* sgpr_ptr(const char* p) { const unsigned long long u = (unsigned long long)p; const unsigned lo = __builtin_amdgcn_readfirstlane((unsigned)u), hi = __builtin_amdgcn_readfirstlane((unsigned)(u >> 32)); return (const char*)(((unsigned long long)hi << 32) | lo); }
typedef int i32x8 __attribute__((ext_vector_type(8)));
template <bool FP8> __device__ __forceinline__ f32x4 mma_step(const i32x8& b, const i32x8& a, f32x4 c) {
    if constexpr (FP8) {
        return __builtin_amdgcn_mfma_scale_f32_16x16x128_f8f6f4(b, a, c, 0, 0, 0, 0x79797979, 0, 0x7f7f7f7f);
    } else {
        const bf16x8 b0 = __builtin_bit_cast(bf16x8, (i32x4)__builtin_shufflevector(b, b, 0, 1, 2, 3)), b1 = __builtin_bit_cast(bf16x8, (i32x4)__builtin_shufflevector(b, b, 4, 5, 6, 7));
        const bf16x8 a0 = __builtin_bit_cast(bf16x8, (i32x4)__builtin_shufflevector(a, a, 0, 1, 2, 3)), a1 = __builtin_bit_cast(bf16x8, (i32x4)__builtin_shufflevector(a, a, 4, 5, 6, 7));
        c = __builtin_amdgcn_mfma_f32_16x16x32_bf16(b0, a0, c, 0, 0, 0);
        return __builtin_amdgcn_mfma_f32_16x16x32_bf16(b1, a1, c, 0, 0, 0);
    }
}
template <class E, class = void> struct epi_dual { static constexpr bool v = false; };
template <class E> struct epi_dual<E, decltype((void)E::DUAL)> { static constexpr bool v = E::DUAL; };
template <class Epi, class Sched, bool ALIGN_EPI = false, bool SP2 = false, bool FP8 = false>
__device__ __forceinline__ void gemm_phase(PG8_LAS unsigned char* lds, const Gemm g, const Sched& S, const Epi& E) {
    const int tid = ftid(), wid = __builtin_amdgcn_readfirstlane(tid >> 6), lane = tid & 63, wr = wid >> 2, wc = wid & 3, fr = lane & 15, fq = lane >> 4;
    constexpr bool DUAL = epi_dual<Epi>::v;
    const int K = g.K, nth = K / BK;
    size_t jA = 0, jB = 0; if constexpr (DUAL) { jA = Epi::jA; jB = Epi::jB; }
    unsigned voffA, voffB;
    { int R, C; stage_rc(tid * 16, R, C); const int Rb = Epi::PERM ? ((R & ~31) + perm32(R & 31)) : R; voffA = (unsigned)(R * K + C) * 2u; voffB = (unsigned)(Rb * K + C) * 2u; }
    const size_t pstep = (size_t)64 * K * 2;
    const size_t kstep = (size_t)(BK * 2);
    const size_t hstep = (size_t)HALF * K * 2;
    const size_t tstep = 2 * hstep;
    const unsigned ldsw = (unsigned)wid * 1024u;
    const int aoff = lds_byte(wr * 64 + fr, fq * 8), boff = lds_byte(wc * 32 + fr, fq * 8);
#define PG8_SA(b, h) (((b) * 2 + (h)) * HTB)
#define PG8_SB(b, h) ((4 + (b) * 2 + (h)) * HTB)
#define PG8_STAGE(bufoff, gbase, voff) do { _Pragma("unroll") for (int _i = 0; _i < 2; ++_i) { const char* gb_ = sgpr_ptr((const char*)(gbase) + _i * pstep); unsigned vo_ = (voff); asm volatile("" : "+v"(vo_)); \
        __builtin_amdgcn_global_load_lds((const unsigned*)(gb_ + vo_), (PG8_LAS unsigned*)(lds + (bufoff) + ldsw + _i * 8192), 16, 0, 0); } } while (0)
#define PG8_LDA(dst, b, h) do { _Pragma("unroll") for (int m = 0; m < 4; ++m) { const i32x4 lo_ = *(const PG8_LAS i32x4*)(lds + PG8_SA(b, h) + aoff + m * 2048), hi_ = *(const PG8_LAS i32x4*)(lds + PG8_SA(b, h) + aoff + m * 2048 + 1024); dst[m] = __builtin_shufflevector(lo_, hi_, 0, 1, 2, 3, 4, 5, 6, 7); } } while (0)
#define PG8_LDB(dst, b, h) do { _Pragma("unroll") for (int n = 0; n < 2; ++n) { const i32x4 lo_ = *(const PG8_LAS i32x4*)(lds + PG8_SB(b, h) + boff + n * 2048), hi_ = *(const PG8_LAS i32x4*)(lds + PG8_SB(b, h) + boff + n * 2048 + 1024); dst[n] = __builtin_shufflevector(lo_, hi_, 0, 1, 2, 3, 4, 5, 6, 7); } } while (0)
#define PG8_MMA(ai, bj, At, Bt) do { __builtin_amdgcn_s_setprio(1); _Pragma("unroll") for (int m = 0; m < 4; ++m) _Pragma("unroll") for (int n = 0; n < 2; ++n) \
        acc[ai][bj][m][n] = mma_step<FP8>(Bt[n], At[m], acc[ai][bj][m][n]); __builtin_amdgcn_s_setprio(0); } while (0)
#define PG8_WAIT_V(n) asm volatile("s_waitcnt vmcnt(" #n ")" ::: "memory")
#define PG8_WAIT_L(n) asm volatile("s_waitcnt lgkmcnt(" #n ")" ::: "memory")
#define PG8_BAR __builtin_amdgcn_s_barrier()
#define PG8_SCHED __builtin_amdgcn_sched_barrier(0)
    Unit cur, nxt; int ui = 0;
    if (!S.next(0, cur)) return;
    f32x4 acc[2][2][4][2];
#pragma unroll
    for (int a = 0; a < 2; ++a)
#pragma unroll
        for (int b = 0; b < 2; ++b)
#pragma unroll
            for (int m = 0; m < 4; ++m)
#pragma unroll
                for (int n = 0; n < 2; ++n) acc[a][b][m][n] = (f32x4){0.f, 0.f, 0.f, 0.f};
    i32x8 At[4], B0[2], B1[2];
    const char* cA = (const char*)g.A + (size_t)cur.pm * tstep; const char* cB = (const char*)g.Bt + (size_t)cur.pn * tstep;
    S.a_ready(cur);
    if constexpr (SP2) {
        PG8_STAGE(PG8_SB(0, 0), cB, voffB); PG8_STAGE(PG8_SB(0, 1), cB + hstep, voffB); PG8_STAGE(PG8_SA(0, 0), cA, voffA); PG8_STAGE(PG8_SA(0, 1), cA + hstep, voffA);
        if (wr == 1) PG8_BAR;
        PG8_WAIT_V(2); PG8_BAR;
        PG8_STAGE(PG8_SB(1, 0), cB + kstep, voffB); PG8_STAGE(PG8_SA(1, 0), cA + kstep, voffA); PG8_STAGE(PG8_SB(1, 1), cB + hstep + kstep, voffB);
        PG8_WAIT_V(6); PG8_BAR;
    } else {
        PG8_STAGE(PG8_SB(0, 0), cB, voffB); PG8_STAGE(PG8_SA(0, 0), cA, voffA); PG8_STAGE(PG8_SB(0, 1), cB + hstep, voffB); PG8_STAGE(PG8_SA(0, 1), cA + hstep, voffA);
        if (wr == 1) PG8_BAR;
        PG8_WAIT_V(4); PG8_BAR;
        PG8_STAGE(PG8_SB(1, 0), cB + kstep, voffB); PG8_STAGE(PG8_SA(1, 0), cA + kstep, voffA); PG8_STAGE(PG8_SB(1, 1), cB + hstep + kstep, voffB);
        PG8_WAIT_V(6); PG8_BAR;
    }
    for (;;) {
        const bool has_next = S.next(ui + 1, nxt);
        const char* nA = has_next ? (const char*)g.A + (size_t)nxt.pm * tstep : cA; const char* nB = has_next ? (const char*)g.Bt + (size_t)nxt.pn * tstep : cB;
        const char* hA = cA; const char* hB = cB;
#pragma unroll 1
        for (int h = 0; h < (DUAL ? 2 : 1); ++h) {
        const bool lasth = !DUAL || h == 1;
        const char* xA = lasth ? nA : cA + jA; const char* xB = lasth ? nB : cB + jB;
        for (int t = 0; t < nth; t += 2) {
            const bool last = (t == nth - 2);
            const char* a1 = hA + (size_t)(t + 1) * kstep;
            const char* a2 = last ? xA : hA + (size_t)(t + 2) * kstep; const char* b2 = last ? xB : hB + (size_t)(t + 2) * kstep;
            const char* a3 = a2 + kstep; const char* b3 = b2 + kstep;
            if (last && lasth && has_next) S.a_ready(nxt);
            if constexpr (SP2) {
            PG8_LDB(B0, 0, 0); PG8_LDB(B1, 0, 1); PG8_SCHED; PG8_LDA(At, 0, 0); PG8_STAGE(PG8_SA(1, 1), a1 + hstep, voffA);
            PG8_WAIT_V(8); PG8_WAIT_L(0); PG8_BAR; PG8_MMA(0, 0, At, B0); PG8_MMA(0, 1, At, B1); PG8_BAR; PG8_SCHED;
            PG8_LDA(At, 0, 1); PG8_STAGE(PG8_SB(0, 0), b2, voffB); PG8_STAGE(PG8_SB(0, 1), b2 + hstep, voffB); PG8_STAGE(PG8_SA(0, 0), a2, voffA);
            PG8_WAIT_V(8); PG8_WAIT_L(0); PG8_BAR; PG8_MMA(1, 0, At, B0); PG8_MMA(1, 1, At, B1); PG8_BAR; PG8_SCHED;
            PG8_LDB(B0, 1, 0); PG8_LDB(B1, 1, 1); PG8_SCHED; PG8_LDA(At, 1, 0); PG8_STAGE(PG8_SA(0, 1), a2 + hstep, voffA);
            PG8_WAIT_V(8); PG8_WAIT_L(0); PG8_BAR; PG8_MMA(0, 0, At, B0); PG8_MMA(0, 1, At, B1); PG8_BAR; PG8_SCHED;
            PG8_LDA(At, 1, 1); PG8_STAGE(PG8_SB(1, 0), b3, voffB); PG8_STAGE(PG8_SB(1, 1), b3 + hstep, voffB); PG8_STAGE(PG8_SA(1, 0), a3, voffA);
            PG8_WAIT_V(8); PG8_WAIT_L(0); PG8_BAR; PG8_MMA(1, 0, At, B0); PG8_MMA(1, 1, At, B1); PG8_BAR; PG8_SCHED;
            } else {
            PG8_LDB(B0, 0, 0); PG8_SCHED; PG8_LDA(At, 0, 0); PG8_STAGE(PG8_SA(1, 1), a1 + hstep, voffA);
            PG8_WAIT_L(8); PG8_BAR; PG8_WAIT_L(0); PG8_MMA(0, 0, At, B0); PG8_BAR; PG8_SCHED;
            PG8_LDB(B1, 0, 1); PG8_STAGE(PG8_SB(0, 0), b2, voffB);
            PG8_BAR; PG8_WAIT_L(0); PG8_MMA(0, 1, At, B1); PG8_BAR;
            PG8_LDA(At, 0, 1); PG8_STAGE(PG8_SA(0, 0), a2, voffA);
            PG8_BAR; PG8_WAIT_L(0); PG8_MMA(1, 0, At, B0); PG8_BAR; PG8_SCHED;
            PG8_STAGE(PG8_SB(0, 1), b2 + hstep, voffB);
            PG8_WAIT_V(6); PG8_BAR; PG8_MMA(1, 1, At, B1); PG8_BAR;
            PG8_LDB(B0, 1, 0); PG8_SCHED; PG8_LDA(At, 1, 0); PG8_STAGE(PG8_SA(0, 1), a2 + hstep, voffA);
            PG8_WAIT_L(8); PG8_BAR; PG8_WAIT_L(0); PG8_MMA(0, 0, At, B0); PG8_BAR; PG8_SCHED;
            PG8_LDB(B1, 1, 1); PG8_STAGE(PG8_SB(1, 0), b3, voffB);
            PG8_BAR; PG8_WAIT_L(0); PG8_MMA(0, 1, At, B1); PG8_BAR;
            PG8_LDA(At, 1, 1); PG8_STAGE(PG8_SA(1, 0), a3, voffA);
            PG8_BAR; PG8_WAIT_L(0); PG8_MMA(1, 0, At, B0); PG8_BAR; PG8_SCHED;
            PG8_STAGE(PG8_SB(1, 1), b3 + hstep, voffB);
            PG8_WAIT_V(6); PG8_BAR; PG8_MMA(1, 1, At, B1); PG8_BAR;
            }
        }
        if constexpr (DUAL) { if (h == 0) { E.mid(acc, cur, wr, wc, fr, fq); hA = cA + jA; hB = cB + jB; } }
        }
        if constexpr (ALIGN_EPI) { if (wr == 0) PG8_BAR; }
        if constexpr (!Epi::AFTER_DRAIN) { E(acc, cur, wr, wc, fr, fq); S.done(cur); }
#ifdef MK_PROBE
#if (MK_PROBE >> 9) & 1
        if constexpr (!Epi::AFTER_DRAIN) { asm volatile("" ::: "memory"); E(acc, cur, wr, wc, fr, fq); }
#endif
#if (MK_PROBE >> 10) & 1
        if constexpr (!Epi::AFTER_DRAIN) { if (g.N > 4096) { asm volatile("" ::: "memory"); E(acc, cur, wr, wc, fr, fq); } }
#endif
#endif
        if (!has_next) break;
#pragma unroll
        for (int a = 0; a < 2; ++a)
#pragma unroll
            for (int b = 0; b < 2; ++b)
#pragma unroll
                for (int m = 0; m < 4; ++m)
#pragma unroll
                    for (int n = 0; n < 2; ++n) acc[a][b][m][n] = (f32x4){0.f, 0.f, 0.f, 0.f};
        cur = nxt; cA = nA; cB = nB; ++ui;
        if constexpr (ALIGN_EPI) { if (wr == 1) PG8_BAR; }
    }
    PG8_WAIT_V(0);
    if constexpr (!ALIGN_EPI) { if (wr == 0) PG8_BAR; }
    PG8_BAR;
    if constexpr (Epi::AFTER_DRAIN) { E.fused(acc, cur, wr, wc, fr, fq, lds, wid, lane); S.done(cur); }
#undef PG8_SA
#undef PG8_SB
#undef PG8_STAGE
#undef PG8_LDA
#undef PG8_LDB
#undef PG8_MMA
#undef PG8_WAIT_V
#undef PG8_WAIT_L
#undef PG8_BAR
#undef PG8_SCHED
}
}

#ifndef MK_DBG
#define MK_DBG 0
#endif
#ifndef MK_XQ_ORDER
#define MK_XQ_ORDER 0
#endif
#ifndef MK_AFMT
#define MK_AFMT 2
#endif
#ifndef MK_DBGA
#define MK_DBGA 0
#endif
#ifndef MK_PEER_OVL
#define MK_PEER_OVL 0
#endif
#ifndef MK_PEER_DEPTH
#define MK_PEER_DEPTH 4
#endif
#ifndef MK_PEER_SPLIT
#define MK_PEER_SPLIT 3
#endif
#ifndef MK_COLMAP
#define MK_COLMAP 0
#endif
#ifndef MK_STAG
#define MK_STAG 0
#endif
#ifndef MK_PROBE
#define MK_PROBE 0
#endif
#ifndef MK_WGM_IN
#define MK_WGM_IN 7
#endif
#ifndef MK_WGM_SQ
#define MK_WGM_SQ 2
#endif
#ifndef MK_ALIGN
#define MK_ALIGN true
#endif
#ifndef MK_SP2
#define MK_SP2 true
#endif
namespace mk {
#define GAS __attribute__((address_space(1)))
#define LAS __attribute__((address_space(3)))
typedef unsigned short bf16;
typedef unsigned v4u __attribute__((ext_vector_type(4)));
typedef unsigned v2u __attribute__((ext_vector_type(2)));
typedef float f32x4 __attribute__((ext_vector_type(4)));
typedef float f32x2 __attribute__((ext_vector_type(2)));

constexpr int D = 2048, MX = 16384, MP = 16640, SEQ = 8192, NMETA = 16;
constexpr int NIN = 16400, NINP = 16640;
constexpr int NH = 8, DQK = 128, DV = 256;
constexpr int LSEQ = SEQ + NMETA;
constexpr float LN_EPS = 1e-5f;
constexpr float ALPHA = 1.189207115002721f;
constexpr float QSCALE = 0.08838834764831845f;

constexpr size_t MiB = 1u << 20;
constexpr size_t WS_CTL = 0, CTL_ZERO_BYTES = 512 * 1024;
constexpr size_t CTL_C1 = 256 * 1024;
constexpr size_t CTL_C0 = 264 * 1024;
constexpr size_t CTL_C1P = 512 * 1024, CTL_C0P = 1024 * 1024;
constexpr size_t WS_GIF = 2 * MiB;
constexpr size_t WS_BT_PA = 4 * MiB, WS_BT_PB = 12 * MiB, WS_BT_WO = 20 * MiB, WS_BT_F = 28 * MiB;
constexpr size_t WS_H0 = 36 * MiB;
constexpr size_t WS_BT_IN = 101 * MiB;
constexpr size_t WS_H0F8 = 101 * MiB;
constexpr size_t WS_BT_IN8 = 133 * MiB + 512 * 1024;
static_assert(WS_H0F8 + (size_t)16640 * 2048 <= WS_BT_IN8 && WS_BT_IN8 + (size_t)16640 * 2048 <= 166 * MiB, "fp8 operand copies");
constexpr size_t WS_UBF = 489 * MiB;
constexpr size_t WS_CB = 166 * MiB;
constexpr size_t WS_R = WS_CB;
constexpr size_t WS_Z = 230 * MiB;
constexpr size_t WS_VBF = 521 * MiB;
constexpr size_t WS_YA8 = WS_BT_IN8;
constexpr size_t WS_YB = WS_Z;
constexpr size_t WS_Q = 295 * MiB;
constexpr size_t WS_K = 327 * MiB;
constexpr size_t WS_TMP = WS_Q;
constexpr size_t WS_V = 360 * MiB;
constexpr size_t WS_SIGO = 425 * MiB;
constexpr size_t WS_MERGED = WS_SIGO;
constexpr size_t WS_END = 553 * MiB;
constexpr size_t OUT_SGA = 0, OUT_SGB = 64 * MiB;

constexpr int LDS_BYTES = 147456;

struct Params {
    const float *x, *meta, *ln0_g, *ln0_b, *w_in, *b_if, *conv_w, *mh_w, *p_a, *p_b, *w_o, *ln1_g, *ln1_b, *peer_wq, *peer_keys, *peer_u, *peer_v, *ln2_g, *ln2_b;
    float* out; unsigned char* ws;
};

__device__ __forceinline__ float bf2f(unsigned u) { return __uint_as_float(u << 16); }
__device__ __forceinline__ float bflo(unsigned w) { return __uint_as_float(w << 16); }
__device__ __forceinline__ float bfhi(unsigned w) { return __uint_as_float(w & 0xffff0000u); }
__device__ __forceinline__ unsigned pk2(float lo, float hi) { return pg8::cvt_pk_bf16(lo, hi); }
template <int CTRL> __device__ __forceinline__ float dpp_f(float v) { return __builtin_bit_cast(float, __builtin_amdgcn_update_dpp(0, __builtin_bit_cast(int, v), CTRL, 0xF, 0xF, true)); }
__device__ __forceinline__ float quad_sum(float v) { v += dpp_f<0xB1>(v); v += dpp_f<0x4E>(v); return v; }
__device__ __forceinline__ float oct_sum(float v) { v = quad_sum(v); v += dpp_f<0x141>(v); return v; }
__device__ __forceinline__ float row16_sum(float v) { v = oct_sum(v); v += dpp_f<0x140>(v); return v; }
__device__ __forceinline__ float wave_sum(float v) {
    v = row16_sum(v);
    const float a = __builtin_bit_cast(float, __builtin_amdgcn_readlane(__builtin_bit_cast(int, v), 0)), b = __builtin_bit_cast(float, __builtin_amdgcn_readlane(__builtin_bit_cast(int, v), 16));
    const float c = __builtin_bit_cast(float, __builtin_amdgcn_readlane(__builtin_bit_cast(int, v), 32)), d = __builtin_bit_cast(float, __builtin_amdgcn_readlane(__builtin_bit_cast(int, v), 48));
    return (a + b) + (c + d);
}
__device__ __forceinline__ float sigmoidf_(float x) { return __builtin_amdgcn_rcpf(1.0f + __expf(-x)); }
#define LDS_WAIT() asm volatile("s_waitcnt lgkmcnt(0)" ::: "memory")
constexpr int PEER_SLOT_TAB = 32768 + 6 * 2048 * 4;
typedef int i32x8_ __attribute__((ext_vector_type(8)));
constexpr float XQ_SCALE = 1.f;
#define PAR_IDX(e) (((((e) >> 2) & 7) * 64 + ((e) >> 5)) * 4 + ((e) & 3))

__device__ __forceinline__ int in_dest_row(int n) {
    if (n < 2048) return n;
    if (n < 4096) { const int c = n - 2048; return (8 + (c >> 7)) * 256 + (c & 127); }
    if (n < 6144) { const int c = n - 4096; return (8 + (c >> 7)) * 256 + 128 + (c & 127); }
    if (n < 7168) return 24 * 256 + (n - 6144);
    if (n < 8192) return 28 * 256 + (n - 7168);
    if (n < 10240) return 32 * 256 + (n - 8192);
    if (n < 12288) return 40 * 256 + (n - 10240);
    if (n < 12304) return 64 * 256 + (n - 12288);
    if (n < 14352) return 48 * 256 + (n - 12304);
    return 56 * 256 + (n - 14352);
}
template <bool INMAP>
__device__ __forceinline__ void transpose_item(const float* W, int K, int N, bf16* WT, LAS float* scr, int item, int lane) {
    const int nblk = (N + 31) / 32, kb = item / nblk, nb = item % nblk, k0 = 64 * kb, n0 = 32 * nb;
    const int rr = lane >> 3, c4 = (lane & 7) * 4; const bool ok = (n0 + c4) < N;
    f32x4 v[8];
#pragma unroll
    for (int i = 0; i < 8; ++i) v[i] = ok ? *(const f32x4*)(W + (size_t)(k0 + 8 * i + rr) * N + n0 + c4) : (f32x4){0.f, 0.f, 0.f, 0.f};
#pragma unroll
    for (int i = 0; i < 8; ++i) { LAS float* d = scr + (8 * i + rr) * 33 + c4; d[0] = v[i].x; d[1] = v[i].y; d[2] = v[i].z; d[3] = v[i].w; }
    LDS_WAIT();
    const int c = lane & 7;
#pragma unroll
    for (int j = 0; j < 4; ++j) { const int nl = (lane >> 3) + 8 * j; const int n = n0 + nl; const LAS float* s = scr + (8 * c) * 33 + nl;
        v4u o; o.x = pk2(s[0 * 33], s[1 * 33]); o.y = pk2(s[2 * 33], s[3 * 33]); o.z = pk2(s[4 * 33], s[5 * 33]); o.w = pk2(s[6 * 33], s[7 * 33]);
        if (n < N) { const int dr = INMAP ? in_dest_row(n) : n; *(v4u*)(WT + (size_t)dr * K + k0 + 8 * c) = o; } }
    LDS_WAIT();
}
__device__ __forceinline__ unsigned pk4_fp8(float a, float b, float c, float d) { int w = 0; w = __builtin_amdgcn_cvt_pk_fp8_f32(a, b, w, false); w = __builtin_amdgcn_cvt_pk_fp8_f32(c, d, w, true); return (unsigned)w; }
template <bool INMAP>
__device__ __forceinline__ void transpose_item_fp8(const float* W, int K, int N, unsigned char* WT, LAS float* scr, int item, int lane) {
    const int nblk = (N + 31) / 32, kb = item / nblk, nb = item % nblk, k0 = 128 * kb, n0 = 32 * nb;
    const int rr = lane >> 3, c4 = (lane & 7) * 4; const bool ok = (n0 + c4) < N;
    f32x4 v[16];
#pragma unroll
    for (int i = 0; i < 16; ++i) v[i] = ok ? *(const f32x4*)(W + (size_t)(k0 + 8 * i + rr) * N + n0 + c4) : (f32x4){0.f, 0.f, 0.f, 0.f};
#pragma unroll
    for (int i = 0; i < 16; ++i) { LAS float* d = scr + (8 * i + rr) * 33 + c4; d[0] = v[i].x * 64.f; d[1] = v[i].y * 64.f; d[2] = v[i].z * 64.f; d[3] = v[i].w * 64.f; }
    LDS_WAIT();
    const int c = lane & 7;
#pragma unroll
    for (int j = 0; j < 4; ++j) { const int nl = (lane >> 3) + 8 * j; const int n = n0 + nl; const LAS float* s = scr + (16 * c) * 33 + nl;
        v4u o; o.x = pk4_fp8(s[0 * 33], s[1 * 33], s[2 * 33], s[3 * 33]); o.y = pk4_fp8(s[4 * 33], s[5 * 33], s[6 * 33], s[7 * 33]);
        o.z = pk4_fp8(s[8 * 33], s[9 * 33], s[10 * 33], s[11 * 33]); o.w = pk4_fp8(s[12 * 33], s[13 * 33], s[14 * 33], s[15 * 33]);
        if (n < N) *(v4u*)(WT + (size_t)(INMAP ? in_dest_row(n) : n) * K + k0 + 16 * c) = o; }
    LDS_WAIT();
}
__device__ __forceinline__ void ln0_load(const Params& p, int r, int lane, f32x4 (&v)[8]) {
    if (r >= MX + NMETA) {
#pragma unroll
        for (int j = 0; j < 8; ++j) v[j] = (f32x4){0.f, 0.f, 0.f, 0.f};
        return; }
    const float* src = (r < MX) ? p.x + (size_t)r * D : p.meta + (size_t)(r - MX) * D;
    const f32x4* xr = (const f32x4*)src + lane;
#pragma unroll
    for (int j = 0; j < 8; ++j) v[j] = xr[64 * j];
}
__device__ __forceinline__ void ln0_finish(const Params& p, int r, int lane, f32x4 (&v)[8]) {
    bf16* orow = (bf16*)(p.ws + WS_H0) + (size_t)r * D;
    unsigned long long* o8 = (unsigned long long*)orow + lane;
    unsigned* o4 = (unsigned*)(p.ws + WS_H0F8 + (size_t)r * D) + lane;
    if (r >= MX + NMETA) {
#pragma unroll
        for (int j = 0; j < 8; ++j) { o8[64 * j] = 0ull; o4[64 * j] = 0u; }
        return;
    }
    float s = 0.f;
#pragma unroll
    for (int j = 0; j < 8; ++j) s += (v[j].x + v[j].y) + (v[j].z + v[j].w);
    const float mean = wave_sum(s) * (1.f / D); float s2 = 0.f;
#pragma unroll
    for (int j = 0; j < 8; ++j) { v[j] = v[j] - mean; s2 += (v[j].x * v[j].x + v[j].y * v[j].y) + (v[j].z * v[j].z + v[j].w * v[j].w); }
    const float rstd = 1.f / sqrtf(wave_sum(s2) * (1.f / D) + LN_EPS);
#pragma unroll
    for (int j = 0; j < 8; ++j) {
        const f32x4 g = *((const f32x4*)p.ln0_g + lane + 64 * j), b = *((const f32x4*)p.ln0_b + lane + 64 * j);
        const f32x4 y = v[j] * rstd * g + b;
        o8[64 * j] = (unsigned long long)pk2(y.x, y.y) | ((unsigned long long)pk2(y.z, y.w) << 32);
        o4[64 * j] = pk4_fp8(y.x, y.y, y.z, y.w);
    }
}
typedef float f32x16_ __attribute__((ext_vector_type(16)));
__device__ __forceinline__ void wf_item(const Params& p, int item, int lane) {
    const int hp = item >> 8, dt = (item >> 2) & 63, nt = item & 3, d0 = 32 * dt, n0 = 32 * nt;
    const int i = lane & 31, kk = lane >> 5;
    const f32x4* arow = (const f32x4*)(p.peer_wq + (size_t)(d0 + i) * D + hp * 128);
    const f32x4* brow = (const f32x4*)(p.peer_keys + (size_t)hp * 16384 + (size_t)(n0 + i) * 128);
    f32x16_ acc;
#pragma unroll
    for (int g = 0; g < 16; ++g) acc[g] = 0.f;
#pragma unroll 8
    for (int q = 0; q < 32; ++q) {
        const f32x4 a = arow[q], bb = brow[q];
        acc = __builtin_amdgcn_mfma_f32_32x32x2f32(kk ? a.y : a.x, kk ? bb.y : bb.x, acc, 0, 0, 0);
        acc = __builtin_amdgcn_mfma_f32_32x32x2f32(kk ? a.w : a.z, kk ? bb.w : bb.z, acc, 0, 0, 0);
    }
    const int col = hp * 128 + n0 + i;
    bf16* dst = (bf16*)(p.ws + WS_BT_F) + (size_t)col * D + d0;
    float c1p = 0.f, c0p = 0.f;
#pragma unroll
    for (int gg = 0; gg < 4; ++gg) {
        const int dd = d0 + 8 * gg + 4 * kk;
        const f32x4 g1 = *(const f32x4*)(p.ln1_g + dd), b1 = *(const f32x4*)(p.ln1_b + dd);
        const unsigned lo = pk2(g1.x * acc[4 * gg], g1.y * acc[4 * gg + 1]), hi = pk2(g1.z * acc[4 * gg + 2], g1.w * acc[4 * gg + 3]);
        *(v2u*)(dst + 8 * gg + 4 * kk) = (v2u){lo, hi};
        c1p += (bflo(lo) + bfhi(lo)) + (bflo(hi) + bfhi(hi));
        c0p += (b1.x * acc[4 * gg] + b1.y * acc[4 * gg + 1]) + (b1.z * acc[4 * gg + 2] + b1.w * acc[4 * gg + 3]);
    }
    { const auto r1 = __builtin_amdgcn_permlane32_swap(__float_as_uint(c1p), __float_as_uint(c1p), false, false); c1p = __uint_as_float(r1[0]) + __uint_as_float(r1[1]);
      const auto r0 = __builtin_amdgcn_permlane32_swap(__float_as_uint(c0p), __float_as_uint(c0p), false, false); c0p = __uint_as_float(r0[0]) + __uint_as_float(r0[1]); }
    if (kk == 0) { ((float*)(p.ws + CTL_C1P))[dt * 2048 + col] = c1p; ((float*)(p.ws + CTL_C0P))[dt * 2048 + col] = c0p; }
}
__device__ __forceinline__ void phase0(const Params& p, LAS unsigned char* lds) {
    const int tid = pg8::ftid(), lane = tid & 63, wave = tid >> 6;
    const int gw = blockIdx.x * 8 + wave, NGW = gridDim.x * 8;
    LAS float* scr = (LAS float*)(lds + wave * 16896);
    if (!(wave & 1)) for (int it = gw; it < 4096; it += NGW) wf_item(p, it, lane);
    constexpr int I_IN = 16 * 513, I_SQ8 = 16 * 64;
    for (int rep12_ = 0; rep12_ < (((MK_PROBE) >> 12) & 1) + 1; ++rep12_)
    for (int it = gw; it < I_IN + 3 * I_SQ8; it += NGW) {
        int r = it;
        if (r < I_IN) { transpose_item_fp8<true>(p.w_in, D, NIN, p.ws + WS_BT_IN8, scr, r, lane); continue; } r -= I_IN;
        if (r < I_SQ8) { transpose_item_fp8<false>(p.p_a, D, D, p.ws + WS_BT_PA, scr, r, lane); continue; } r -= I_SQ8;
        if (r < I_SQ8) { transpose_item_fp8<false>(p.p_b, D, D, p.ws + WS_BT_PB, scr, r, lane); continue; } r -= I_SQ8;
        transpose_item_fp8<false>(p.w_o, D, D, p.ws + WS_BT_WO, scr, r, lane);
    }
    for (int r = gw; r < 240; r += NGW) { unsigned long long* o8 = (unsigned long long*)(p.ws + WS_BT_IN8 + (size_t)(64 * 256 + 16 + r) * D) + lane;
#pragma unroll
        for (int j = 0; j < 4; ++j) o8[64 * j] = 0ull; }
    for (int rep13_ = 0; rep13_ < (((MK_PROBE) >> 13) & 1) + 1; ++rep13_) {
        f32x4 va[8], vb[8], vc[8], vd[8];
        int r = gw;
        if (r < MP) ln0_load(p, r, lane, va);
        if (r + NGW < MP) ln0_load(p, r + NGW, lane, vb);
        if (r + 2 * NGW < MP) ln0_load(p, r + 2 * NGW, lane, vc);
        if (r + 3 * NGW < MP) ln0_load(p, r + 3 * NGW, lane, vd);
#pragma unroll 1
        for (; r < MP; r += 4 * NGW) {
            ln0_finish(p, r, lane, va); if (r + 4 * NGW < MP) ln0_load(p, r + 4 * NGW, lane, va);
            if (r + NGW < MP) { ln0_finish(p, r + NGW, lane, vb); if (r + 5 * NGW < MP) ln0_load(p, r + 5 * NGW, lane, vb); }
            if (r + 2 * NGW < MP) { ln0_finish(p, r + 2 * NGW, lane, vc); if (r + 6 * NGW < MP) ln0_load(p, r + 6 * NGW, lane, vc); }
            if (r + 3 * NGW < MP) { ln0_finish(p, r + 3 * NGW, lane, vd); if (r + 7 * NGW < MP) ln0_load(p, r + 7 * NGW, lane, vd); }
        }
    }
    for (int rep14_ = 0; rep14_ < (((MK_PROBE) >> 14) & 1) + 1; ++rep14_)
    if (wave & 1) for (int it = gw; it < 4096; it += NGW) wf_item(p, it, lane);
    (void)tid;
}
typedef float v32f __attribute__((ext_vector_type(32)));
typedef float v16f __attribute__((ext_vector_type(16)));
typedef unsigned v6u __attribute__((ext_vector_type(6)));
constexpr int ROW6 = 1536;
__device__ __forceinline__ void uvconv_range(const Params& p, size_t u0, size_t u1, int wk, int nwk) {
    const size_t units = (size_t)16384 * 64;
    const size_t NT = (size_t)nwk * 512;
#pragma unroll 1
    for (size_t i = u0 + (size_t)wk * 512 + pg8::ftid(); i < u1; i += NT) {
        const int t = i >= units; const size_t j = t ? i - units : i;
        const float* src = t ? p.peer_v : p.peer_u; unsigned char* dst = p.ws + (t ? WS_VBF : WS_UBF); const float sc = t ? 2.f : 64.f;
        const size_t row = j >> 6; const int l = (int)(j & 63);
        const f32x4* s4 = (const f32x4*)(src + row * 2048 + l * 32);
        v16f x0, x1;
#pragma unroll
        for (int q = 0; q < 4; ++q) { const f32x4 a = s4[q] * sc, b = s4[4 + q] * sc; x0[4 * q] = a.x; x0[4 * q + 1] = a.y; x0[4 * q + 2] = a.z; x0[4 * q + 3] = a.w; x1[4 * q] = b.x; x1[4 * q + 1] = b.y; x1[4 * q + 2] = b.z; x1[4 * q + 3] = b.w; }
        const v6u w = __builtin_amdgcn_cvt_scalef32_2xpk16_fp6_f32(x0, x1, 1.0f);
        *(v4u*)(dst + row * ROW6 + l * 16) = (v4u){w[0], w[1], w[2], w[3]};
        *(v2u*)(dst + row * ROW6 + 1024 + l * 8) = (v2u){w[4], w[5]};
    }
}
__device__ __forceinline__ void uvconv_unit_load(const Params& p, size_t i, f32x4 (&v)[8]) {
    const size_t units = (size_t)16384 * 64;
    const int t = i >= units; const size_t j = t ? i - units : i;
    const f32x4* s4 = (const f32x4*)((t ? p.peer_v : p.peer_u) + (j >> 6) * 2048 + (size_t)(j & 63) * 32);
#pragma unroll
    for (int q = 0; q < 8; ++q) v[q] = s4[q];
}
__device__ __forceinline__ void uvconv_unit_store(const Params& p, size_t i, const f32x4 (&v)[8]) {
    const size_t units = (size_t)16384 * 64;
    const int t = i >= units; const size_t j = t ? i - units : i;
    unsigned char* dst = p.ws + (t ? WS_VBF : WS_UBF); const float sc = t ? 2.f : 64.f;
    const size_t row = j >> 6; const int l = (int)(j & 63);
    v16f x0, x1;
#pragma unroll
    for (int q = 0; q < 4; ++q) { const f32x4 a = v[q] * sc, b = v[4 + q] * sc; x0[4 * q] = a.x; x0[4 * q + 1] = a.y; x0[4 * q + 2] = a.z; x0[4 * q + 3] = a.w; x1[4 * q] = b.x; x1[4 * q + 1] = b.y; x1[4 * q + 2] = b.z; x1[4 * q + 3] = b.w; }
    const v6u w = __builtin_amdgcn_cvt_scalef32_2xpk16_fp6_f32(x0, x1, 1.0f);
    *(v4u*)(dst + row * ROW6 + l * 16) = (v4u){w[0], w[1], w[2], w[3]};
    *(v2u*)(dst + row * ROW6 + 1024 + l * 8) = (v2u){w[4], w[5]};
}
#ifndef MK_UV_EARLY
#define MK_UV_EARLY 786432
#endif
__device__ __forceinline__ size_t uv_early_units() { const int extra = ((MP / 256) * (NINP / 256)) % (int)gridDim.x; return extra ? (size_t)MK_UV_EARLY : (size_t)0; }
__device__ __forceinline__ void phase_uvconv_early(const Params& p) {
    const int extra = ((MP / 256) * (NINP / 256)) % (int)gridDim.x;
    if (extra == 0 || (int)blockIdx.x < extra) return;
    uvconv_range(p, 0, uv_early_units(), (int)blockIdx.x - extra, (int)gridDim.x - extra);
}
#ifndef MK_UV_IN_SEL
#define MK_UV_IN_SEL 1
#endif
__device__ __forceinline__ void phase_uvconv(const Params& p) { if (!MK_UV_IN_SEL) uvconv_range(p, uv_early_units(), (size_t)2 * 16384 * 64, (int)blockIdx.x, (int)gridDim.x); }
}

namespace pg8 {
struct EpiInProj {
    static constexpr bool PERM = true, AFTER_DRAIN = false;
    unsigned char* ws; unsigned char* outb;
    __device__ __forceinline__ void operator()(const f32x4 (&acc)[2][2][4][2], const Unit& u, int wr, int wc, int fr, int fq) const {
        bf16_t* const CB = (bf16_t*)(ws + mk::WS_CB); bf16_t* const Z = (bf16_t*)(ws + mk::WS_Z); bf16_t* const Q = (bf16_t*)(ws + mk::WS_Q); bf16_t* const K = (bf16_t*)(ws + mk::WS_K); bf16_t* const V = (bf16_t*)(ws + mk::WS_V);
        bf16_t* const SIGO = (bf16_t*)(ws + mk::WS_SIGO); bf16_t* const SGA = (bf16_t*)(outb + mk::OUT_SGA); bf16_t* const SGB = (bf16_t*)(outb + mk::OUT_SGB); float* const GIF = (float*)(ws + mk::WS_GIF);
        const int pn = u.pn, pm = u.pm; const bool meta = (pm >= 64);
        int row0 = pm * BM + wr * 64 + fr, cl = wc * 32 + 8 * fq;
        asm volatile("" : "+v"(row0), "+v"(cl));
        if (pn >= 8 && pn < 24) {
            typedef unsigned u32x2_ __attribute__((ext_vector_type(2)));
            unsigned char* base = (unsigned char*)Z + (size_t)(pn - 8) * 128 + cl;
#pragma unroll
            for (int ai = 0; ai < 2; ++ai)
#pragma unroll
                for (int m = 0; m < 4; ++m) { const f32x4 z0 = acc[ai][0][m][0] * acc[ai][1][m][0], z1 = acc[ai][0][m][1] * acc[ai][1][m][1];
                    *(u32x2_*)(base + (size_t)(row0 + ai * HALF + m * 16) * 2048) = (u32x2_){mk::pk4_fp8(z0[0], z0[1], z0[2], z0[3]), mk::pk4_fp8(z1[0], z1[1], z1[2], z1[3])}; }
            return;
        }
        if (pn >= 64) {
            if (wc == 0 && fq < 2) {
#pragma unroll
                for (int ai = 0; ai < 2; ++ai)
#pragma unroll
                    for (int m = 0; m < 4; ++m) { float* g = GIF + (size_t)((row0 + ai * HALF + m * 16) * 16 + (cl & 31));     *(f32x4*)g = acc[ai][0][m][0]; *(f32x4*)(g + 4) = acc[ai][0][m][1]; }
            }
            return;
        }
        if (pn < 8) { if (!meta) store_fp8(acc, (unsigned char*)CB, pn, row0, cl); }
        else if (pn < 28) { if (!meta) store_heads<2, 128>(acc, Q, nullptr, pn - 24, pm, row0, cl); }
        else if (pn < 32) store_heads<0, 128>(acc, K, K + (size_t)16 * 8192 * 128, pn - 28, pm, row0, cl);
        else if (pn < 40) store_heads<0, 256>(acc, V, V + (size_t)16 * 8192 * 256, pn - 32, pm, row0, cl);
        else if (meta) return;
        else if (pn < 48) store_heads<1, 256>(acc, SIGO, nullptr, pn - 40, pm, row0, cl);
        else if (pn < 56) store_gate(acc, (unsigned char*)SGA, pn - 48, row0, cl);
        else store_gate(acc, (unsigned char*)SGB, pn - 56, row0, cl);
    }
    __device__ __forceinline__ void store_fp8(const f32x4 (&acc)[2][2][4][2], unsigned char* base, int colt, int row0, int cl) const {
        typedef unsigned u32x2_ __attribute__((ext_vector_type(2)));
        base += (size_t)colt * 256 + cl;
#pragma unroll
        for (int ai = 0; ai < 2; ++ai)
#pragma unroll
            for (int m = 0; m < 4; ++m) { unsigned char* rowp = base + (size_t)(row0 + ai * HALF + m * 16) * 2048;
#pragma unroll
                for (int bj = 0; bj < 2; ++bj) { const f32x4 v0 = acc[ai][bj][m][0], v1 = acc[ai][bj][m][1];
                    *(u32x2_*)(rowp + bj * HALF) = (u32x2_){mk::pk4_fp8(v0[0], v0[1], v0[2], v0[3]), mk::pk4_fp8(v1[0], v1[1], v1[2], v1[3])}; } }
    }
    __device__ __forceinline__ void store_gate(const f32x4 (&acc)[2][2][4][2], unsigned char* base, int colt, int row0, int cl) const {
        typedef unsigned u32x2_ __attribute__((ext_vector_type(2)));
        base += (size_t)colt * 256 + cl;
#pragma unroll
        for (int ai = 0; ai < 2; ++ai)
#pragma unroll
            for (int m = 0; m < 4; ++m) { unsigned char* rowp = base + (size_t)(row0 + ai * HALF + m * 16) * 2048;
#pragma unroll
                for (int bj = 0; bj < 2; ++bj) { f32x4 v0 = acc[ai][bj][m][0], v1 = acc[ai][bj][m][1];
                    asm volatile("" : "+v"(v0), "+v"(v1));
                    unsigned w0 = 0u, w1 = 0u;
#pragma unroll
                    for (int e = 0; e < 4; ++e) { w0 = __builtin_amdgcn_cvt_pk_u8_f32(__builtin_rintf(255.f * mk::sigmoidf_(v0[e])), e, w0); w1 = __builtin_amdgcn_cvt_pk_u8_f32(__builtin_rintf(255.f * mk::sigmoidf_(v1[e])), e, w1); }
                    *(u32x2_*)(rowp + bj * HALF) = (u32x2_){w0, w1};
                    asm volatile("" ::: "memory"); }
                asm volatile("" ::: "memory"); }
    }
    template <int ACT, int HW> __device__ __forceinline__ void store_heads(const f32x4 (&acc)[2][2][4][2], bf16_t* X, bf16_t* MT, int colt, int pm, int row0, int cl) const {
        const bool meta = pm >= 64; const int b = pm >> 5;
#pragma unroll
        for (int ai = 0; ai < 2; ++ai)
#pragma unroll
            for (int m = 0; m < 4; ++m) { const int row = row0 + ai * HALF + m * 16; const int s = row & 8191, j = row - 16384;
                if (meta && j >= 16) continue;
#pragma unroll
                for (int bj = 0; bj < 2; ++bj) { f32x4 v0 = acc[ai][bj][m][0], v1 = acc[ai][bj][m][1];
                    const int h = (HW == 128) ? 2 * colt + bj : colt, c = (HW == 128) ? cl : bj * HALF + cl;
                    bf16_t* dst = meta ? MT + (size_t)(h * 16 + j) * HW + c : X + ((size_t)(b * 8 + h) * 8192 + s) * HW + c;
                    if (ACT == 1) { asm volatile("" : "+v"(v0), "+v"(v1));
#pragma unroll
                        for (int e = 0; e < 4; ++e) { v0[e] = mk::sigmoidf_(v0[e]); v1[e] = mk::sigmoidf_(v1[e]); } }
                    else if (ACT == 2) { v0 = v0 * mk::QSCALE; v1 = v1 * mk::QSCALE; }
                    u32x4 w; w.x = cvt_pk_bf16(v0[0], v0[1]); w.y = cvt_pk_bf16(v0[2], v0[3]); w.z = cvt_pk_bf16(v1[0], v1[1]); w.w = cvt_pk_bf16(v1[2], v1[3]);
                    *(u32x4*)dst = w;
                    if (ACT == 1) asm volatile("" ::: "memory"); }
                asm volatile("" ::: "memory"); }
    }
    template <int ACT> __device__ __forceinline__ void store(const f32x4 (&acc)[2][2][4][2], bf16_t* base, int ld, int colt, int row0, int cl) const {
        base += (size_t)colt * 256 + cl;
#pragma unroll
        for (int ai = 0; ai < 2; ++ai)
#pragma unroll
            for (int m = 0; m < 4; ++m) { bf16_t* rowp = base + (size_t)(row0 + ai * HALF + m * 16) * ld;
#pragma unroll
                for (int bj = 0; bj < 2; ++bj) { f32x4 v0 = acc[ai][bj][m][0], v1 = acc[ai][bj][m][1];
                    if (ACT == 1) { asm volatile("" : "+v"(v0), "+v"(v1));
#pragma unroll
                        for (int e = 0; e < 4; ++e) { v0[e] = mk::sigmoidf_(v0[e]); v1[e] = mk::sigmoidf_(v1[e]); } }
                    else if (ACT == 2) { v0 = v0 * mk::QSCALE; v1 = v1 * mk::QSCALE; }
                    u32x4 w; w.x = cvt_pk_bf16(v0[0], v0[1]); w.y = cvt_pk_bf16(v0[2], v0[3]); w.z = cvt_pk_bf16(v1[0], v1[1]); w.w = cvt_pk_bf16(v1[2], v1[3]);
                    *(u32x4*)(rowp + bj * HALF) = w;
                    if (ACT == 1) asm volatile("" ::: "memory"); }
                asm volatile("" ::: "memory"); }
    }
};
template <bool SECOND> struct EpiGate {
    static constexpr bool PERM = true, AFTER_DRAIN = false;
    const bf16_t* G; const bf16_t* T; bf16_t* O;
    __device__ __forceinline__ void operator()(const f32x4 (&acc)[2][2][4][2], const Unit& u, int wr, int wc, int fr, int fq) const {
        const int row0 = u.pm * BM + wr * 64 + fr, col0 = u.pn * BM + wc * 32 + 8 * fq;
        constexpr int NB = SECOND ? 1 : 2;
#pragma unroll
        for (int a0 = 0; a0 < 2; a0 += NB) {
            u32x4 gv[NB][4][2], tv[NB][4][2];
#pragma unroll
            for (int aa = 0; aa < NB; ++aa)
#pragma unroll
                for (int m = 0; m < 4; ++m)
#pragma unroll
                    for (int bj = 0; bj < 2; ++bj) { const size_t off = (size_t)(row0 + (a0 + aa) * HALF + m * 16) * 2048 + col0 + bj * HALF;
                        gv[aa][m][bj] = *(const u32x4*)(G + off); if (SECOND) tv[aa][m][bj] = *(const u32x4*)(T + off); else tv[aa][m][bj] = (u32x4){0u, 0u, 0u, 0u}; }
            asm volatile("" ::: "memory");
#pragma unroll
            for (int aa = 0; aa < NB; ++aa)
#pragma unroll
                for (int m = 0; m < 4; ++m)
#pragma unroll
                    for (int bj = 0; bj < 2; ++bj) { const int ai = a0 + aa; const size_t off = (size_t)(row0 + ai * HALF + m * 16) * 2048 + col0 + bj * HALF;
                        const u32x4 g = gv[aa][m][bj], t = tv[aa][m][bj];
                        const f32x4 v0 = acc[ai][bj][m][0], v1 = acc[ai][bj][m][1]; float o[8];
                        o[0] = mk::bflo(g.x) * v0[0] + mk::bflo(t.x); o[1] = mk::bfhi(g.x) * v0[1] + mk::bfhi(t.x);
                        o[2] = mk::bflo(g.y) * v0[2] + mk::bflo(t.y); o[3] = mk::bfhi(g.y) * v0[3] + mk::bfhi(t.y);
                        o[4] = mk::bflo(g.z) * v1[0] + mk::bflo(t.z); o[5] = mk::bfhi(g.z) * v1[1] + mk::bfhi(t.z);
                        o[6] = mk::bflo(g.w) * v1[2] + mk::bflo(t.w); o[7] = mk::bfhi(g.w) * v1[3] + mk::bfhi(t.w);
                        if (SECOND) {
                            typedef unsigned u32x2_ __attribute__((ext_vector_type(2)));
                            *(u32x2_*)((unsigned char*)O + off) = (u32x2_){mk::pk4_fp8(o[0], o[1], o[2], o[3]), mk::pk4_fp8(o[4], o[5], o[6], o[7])};
                        } else {
                            u32x4 w; w.x = cvt_pk_bf16(o[0], o[1]); w.y = cvt_pk_bf16(o[2], o[3]); w.z = cvt_pk_bf16(o[4], o[5]); w.w = cvt_pk_bf16(o[6], o[7]);
                            *(u32x4*)(O + off) = w; } }
            asm volatile("" ::: "memory");
        }
    }
};
struct EpiGate2 {
    static constexpr bool PERM = true, AFTER_DRAIN = false, DUAL = true;
    const unsigned char* GA; const unsigned char* GB; unsigned char* O;
    static constexpr size_t jA = (size_t)(mk::WS_YB - mk::WS_YA8), jB = (size_t)(mk::WS_BT_PB - mk::WS_BT_PA);
    typedef unsigned u32x2_ __attribute__((ext_vector_type(2)));
    static __device__ __forceinline__ float ub(unsigned w, int i) { return (float)((w >> (8 * i)) & 0xffu); }
    __device__ __forceinline__ void mid(f32x4 (&acc)[2][2][4][2], const Unit& u, int wr, int wc, int fr, int fq) const {
        unsigned off0 = (unsigned)((u.pm * BM + wr * 64 + fr) * 2048 + u.pn * BM + wc * 32 + 8 * fq);
        asm volatile("" : "+v"(off0));
        const GAS unsigned char* ga = (const GAS unsigned char*)sgpr_ptr((const char*)GA); const GAS unsigned char* gb = (const GAS unsigned char*)sgpr_ptr((const char*)GB);
        u32x2_ av[2][4][2], bv[2][4][2];
#pragma unroll
        for (int ai = 0; ai < 2; ++ai)
#pragma unroll
            for (int m = 0; m < 4; ++m)
#pragma unroll
                for (int bj = 0; bj < 2; ++bj) { const unsigned off = off0 + (unsigned)((ai * HALF + m * 16) * 2048 + bj * HALF); av[ai][m][bj] = *(const GAS u32x2_*)(ga + off); bv[ai][m][bj] = *(const GAS u32x2_*)(gb + off); }
        asm volatile("" ::: "memory");
#pragma unroll
        for (int ai = 0; ai < 2; ++ai)
#pragma unroll
            for (int m = 0; m < 4; ++m)
#pragma unroll
                for (int bj = 0; bj < 2; ++bj) { const u32x2_ a = av[ai][m][bj], b = bv[ai][m][bj];
                    f32x4 r0, r1;
#pragma unroll
                    for (int e = 0; e < 4; ++e) { r0[e] = ub(a.x, e) * __builtin_amdgcn_rcpf(fmaxf(ub(b.x, e), GMIN)); r1[e] = ub(a.y, e) * __builtin_amdgcn_rcpf(fmaxf(ub(b.y, e), GMIN)); }
                    acc[ai][bj][m][0] = acc[ai][bj][m][0] * r0; acc[ai][bj][m][1] = acc[ai][bj][m][1] * r1; }
        asm volatile("" ::: "memory");
    }
    static constexpr float GMIN = 1.f / 1024.f;
    __device__ __forceinline__ void operator()(const f32x4 (&acc)[2][2][4][2], const Unit& u, int wr, int wc, int fr, int fq) const {
        unsigned off0 = (unsigned)((u.pm * BM + wr * 64 + fr) * 2048 + u.pn * BM + wc * 32 + 8 * fq);
        asm volatile("" : "+v"(off0));
        const GAS unsigned char* gb = (const GAS unsigned char*)sgpr_ptr((const char*)GB); GAS unsigned char* o_ = (GAS unsigned char*)sgpr_ptr((const char*)O);
        u32x2_ bv[2][4][2];
#pragma unroll
        for (int ai = 0; ai < 2; ++ai)
#pragma unroll
            for (int m = 0; m < 4; ++m)
#pragma unroll
                for (int bj = 0; bj < 2; ++bj) bv[ai][m][bj] = *(const GAS u32x2_*)(gb + (off0 + (unsigned)((ai * HALF + m * 16) * 2048 + bj * HALF)));
        asm volatile("" ::: "memory");
#pragma unroll
        for (int ai = 0; ai < 2; ++ai)
#pragma unroll
            for (int m = 0; m < 4; ++m)
#pragma unroll
                for (int bj = 0; bj < 2; ++bj) { const unsigned off = off0 + (unsigned)((ai * HALF + m * 16) * 2048 + bj * HALF);
                    const u32x2_ b = bv[ai][m][bj]; const f32x4 v0 = acc[ai][bj][m][0], v1 = acc[ai][bj][m][1]; float o[8];
#pragma unroll
                    for (int e = 0; e < 4; ++e) { o[e] = fmaxf(ub(b.x, e), GMIN) * (1.f / 255.f) * v0[e]; o[4 + e] = fmaxf(ub(b.y, e), GMIN) * (1.f / 255.f) * v1[e]; }
                    *(GAS u32x2_*)(o_ + off) = (u32x2_){mk::pk4_fp8(o[0], o[1], o[2], o[3]), mk::pk4_fp8(o[4], o[5], o[6], o[7])}; }
    }
};
struct EpiResid {
    static constexpr bool PERM = true, AFTER_DRAIN = false;
    const bf16_t* H0; bf16_t* R;
    __device__ __forceinline__ void operator()(const f32x4 (&acc)[2][2][4][2], const Unit& u, int wr, int wc, int fr, int fq) const {
        const int row0 = u.pm * BM + wr * 64 + fr, col0 = u.pn * BM + wc * 32 + 8 * fq;
        u32x4 hv[2][4][2];
#pragma unroll
        for (int ai = 0; ai < 2; ++ai)
#pragma unroll
            for (int m = 0; m < 4; ++m)
#pragma unroll
                for (int bj = 0; bj < 2; ++bj) hv[ai][m][bj] = *(const u32x4*)(H0 + (size_t)(row0 + ai * HALF + m * 16) * 2048 + col0 + bj * HALF);
        asm volatile("" ::: "memory");
#pragma unroll
        for (int ai = 0; ai < 2; ++ai)
#pragma unroll
            for (int m = 0; m < 4; ++m)
#pragma unroll
                for (int bj = 0; bj < 2; ++bj) { const size_t off = (size_t)(row0 + ai * HALF + m * 16) * 2048 + col0 + bj * HALF;
                    const u32x4 h = hv[ai][m][bj];
                    const f32x4 v0 = acc[ai][bj][m][0], v1 = acc[ai][bj][m][1]; float o[8];
                    o[0] = mk::ALPHA * mk::bflo(h.x) + v0[0]; o[1] = mk::ALPHA * mk::bfhi(h.x) + v0[1];
                    o[2] = mk::ALPHA * mk::bflo(h.y) + v0[2]; o[3] = mk::ALPHA * mk::bfhi(h.y) + v0[3];
                    o[4] = mk::ALPHA * mk::bflo(h.z) + v1[0]; o[5] = mk::ALPHA * mk::bfhi(h.z) + v1[1];
                    o[6] = mk::ALPHA * mk::bflo(h.w) + v1[2]; o[7] = mk::ALPHA * mk::bfhi(h.w) + v1[3];
                    u32x4 w; w.x = cvt_pk_bf16(o[0], o[1]); w.y = cvt_pk_bf16(o[2], o[3]); w.z = cvt_pk_bf16(o[4], o[5]); w.w = cvt_pk_bf16(o[6], o[7]);
                    *(u32x4*)(R + off) = w; }
    }
};
struct EpiScores {
    static constexpr bool PERM = true, AFTER_DRAIN = false;
    _Float16* S;
    __device__ __forceinline__ void operator()(const f32x4 (&acc)[2][2][4][2], const Unit& u, int wr, int wc, int fr, int fq) const {
        typedef _Float16 h8_t __attribute__((ext_vector_type(8)));
        const int row0 = u.pm * BM + wr * 64 + fr, col0 = u.pn * BM + wc * 32 + 8 * fq;
#pragma unroll
        for (int ai = 0; ai < 2; ++ai)
#pragma unroll
            for (int m = 0; m < 4; ++m) { _Float16* rowp = S + (size_t)(row0 + ai * HALF + m * 16) * 2048 + col0;
#pragma unroll
                for (int bj = 0; bj < 2; ++bj) { const f32x4 v0 = acc[ai][bj][m][0], v1 = acc[ai][bj][m][1]; h8_t w;
                    w[0] = (_Float16)v0[0]; w[1] = (_Float16)v0[1]; w[2] = (_Float16)v0[2]; w[3] = (_Float16)v0[3]; w[4] = (_Float16)v1[0]; w[5] = (_Float16)v1[1]; w[6] = (_Float16)v1[2]; w[7] = (_Float16)v1[3];
                    *(h8_t*)(rowp + bj * HALF) = w; } }
    }
};
}

namespace mk {
__device__ __forceinline__ void phase_c1c0(const Params& p) {
    const int gt = blockIdx.x * 512 + pg8::ftid();
    if (gt < 4096) { const int col = gt & 2047; const float* src = (const float*)(p.ws + (gt < 2048 ? CTL_C1P : CTL_C0P)); float a = 0.f;
        for (int i = 0; i < 64; ++i) a += src[i * 2048 + col];
        ((float*)(p.ws + (gt < 2048 ? CTL_C1 : CTL_C0)))[col] = a; }
}
constexpr int CONV_SLICES = 1024 * 256 * 4;
__device__ __forceinline__ void conv_issue(const Params& p, int s, v2u& zm2, v2u& zm1, v2u (&z)[4], v2u (&cb)[4]) {
    const unsigned char* CB = p.ws + WS_CB; const unsigned char* Z = p.ws + WS_Z;
    const int it = s & 262143, qq = s >> 18, c0 = (it & 255) * 8, r0 = (it >> 8) * 16 + 4 * qq;
    const bool first = (r0 & (SEQ - 1)) == 0;
    zm2 = *(const v2u*)(Z + (size_t)(first ? MX + 14 : r0 - 2) * D + c0);
    zm1 = *(const v2u*)(Z + (size_t)(first ? MX + 15 : r0 - 1) * D + c0);
#pragma unroll
    for (int i = 0; i < 4; ++i) { const size_t off = (size_t)(r0 + i) * D + c0; z[i] = *(const v2u*)(Z + off); cb[i] = *(const v2u*)(CB + off); }
}
__device__ __forceinline__ void fp8x8_f32(v2u w, float (&o)[8]) {
    typedef float f2_t __attribute__((ext_vector_type(2)));
    const f2_t a = __builtin_amdgcn_cvt_pk_f32_fp8((int)w.x, false), b = __builtin_amdgcn_cvt_pk_f32_fp8((int)w.x, true), c = __builtin_amdgcn_cvt_pk_f32_fp8((int)w.y, false), d = __builtin_amdgcn_cvt_pk_f32_fp8((int)w.y, true);
    o[0] = a[0]; o[1] = a[1]; o[2] = b[0]; o[3] = b[1]; o[4] = c[0]; o[5] = c[1]; o[6] = d[0]; o[7] = d[1];
}
__device__ __forceinline__ void conv_finish(const Params& p, int s, v2u zm2_, v2u zm1_, const v2u (&zz)[4], const v2u (&cbb)[4]) {
    const int it = s & 262143, qq = s >> 18, c0 = (it & 255) * 8, r0 = (it >> 8) * 16 + 4 * qq;
    const GAS float* cw = (const GAS float*)(p.conv_w + c0); asm volatile("" : "+v"(cw));
    float w0[8], w1[8], w2[8];
    { const f32x4 a0 = *(const GAS f32x4*)cw, a1 = *(const GAS f32x4*)(cw + 4), b0 = *(const GAS f32x4*)(cw + 2048), b1 = *(const GAS f32x4*)(cw + 2052), d0 = *(const GAS f32x4*)(cw + 4096), d1 = *(const GAS f32x4*)(cw + 4100);
#pragma unroll
      for (int e = 0; e < 4; ++e) { w0[e] = a0[e]; w0[4 + e] = a1[e]; w1[e] = b0[e]; w1[4 + e] = b1[e]; w2[e] = d0[e]; w2[4 + e] = d1[e]; } }
    float zm2[8], zm1[8]; fp8x8_f32(zm2_, zm2); fp8x8_f32(zm1_, zm1);
#pragma unroll
    for (int i = 0; i < 4; ++i) {
        const size_t off = (size_t)(r0 + i) * D + c0;
        float z[8], cb[8], y[8]; fp8x8_f32(zz[i], z); fp8x8_f32(cbb[i], cb);
#pragma unroll
        for (int e = 0; e < 8; ++e) { y[e] = cb[e] * (w0[e] * zm2[e] + w1[e] * zm1[e] + w2[e] * z[e]); zm2[e] = zm1[e]; zm1[e] = z[e]; }
        *(v2u*)(p.ws + WS_YA8 + off) = (v2u){pk4_fp8(y[0], y[1], y[2], y[3]), pk4_fp8(y[4], y[5], y[6], y[7])};
    }
}

constexpr float U_SCALE = 64.f, V_SCALE = 2.f;
#ifndef MK_FP6_ORDER
#define MK_FP6_ORDER 1
#endif
__device__ __forceinline__ float gelu_exact(float a) { return 0.5f * a * (1.f + erff(a * 0.70710678118654752f)); }
__device__ __forceinline__ void ce_desc(unsigned& a, unsigned& b) { const unsigned hi = a > b ? a : b, lo = a > b ? b : a; a = hi; b = lo; }
__device__ __forceinline__ void merge16_desc(unsigned (&v)[16]) {
#pragma unroll
    for (int j = 8; j > 0; j >>= 1)
#pragma unroll
        for (int i = 0; i < 16; ++i) { const int l = i ^ j; if (l > i) ce_desc(v[i], v[l]); }
}
__device__ __forceinline__ void sort16_desc(unsigned (&v)[16]) {
#pragma unroll
    for (int k = 2; k <= 16; k <<= 1)
#pragma unroll
        for (int j = k >> 1; j > 0; j >>= 1)
#pragma unroll
            for (int i = 0; i < 16; ++i) { const int l = i ^ j; if (l > i) { if ((i & k) == 0) ce_desc(v[i], v[l]); else ce_desc(v[l], v[i]); } }
}
__device__ __forceinline__ void sort8_desc(unsigned (&v)[8]) {
#pragma unroll
    for (int k = 2; k <= 8; k <<= 1)
#pragma unroll
        for (int j = k >> 1; j > 0; j >>= 1)
#pragma unroll
            for (int i = 0; i < 8; ++i) { const int l = i ^ j; if (l > i) { if ((i & k) == 0) ce_desc(v[i], v[l]); else ce_desc(v[l], v[i]); } }
}
__device__ __forceinline__ void merge8_desc(unsigned (&v)[8]) {
#pragma unroll
    for (int j = 4; j > 0; j >>= 1)
#pragma unroll
        for (int i = 0; i < 8; ++i) { const int l = i ^ j; if (l > i) ce_desc(v[i], v[l]); }
}
#define PEER_XSTEP(v, CTRL, MIRROR, low) do { unsigned n_[8]; _Pragma("unroll") for (int r_ = 0; r_ < 8; ++r_) { \
        const unsigned p_ = (unsigned)__builtin_amdgcn_update_dpp(0, (int)(v)[(MIRROR) ? 7 - r_ : r_], (CTRL), 0xF, 0xF, true); \
        const unsigned hi_ = (v)[r_] > p_ ? (v)[r_] : p_, lo_ = (v)[r_] > p_ ? p_ : (v)[r_]; n_[r_] = (low) ? hi_ : lo_; } \
    _Pragma("unroll") for (int r_ = 0; r_ < 8; ++r_) (v)[r_] = n_[r_]; } while (0)
__device__ __forceinline__ float key2_val(unsigned k) { const unsigned m = k & 0xFFFFFFC0u; return __uint_as_float((m & 0x80000000u) ? (m & 0x7FFFFFFFu) : ~m); }
__device__ __forceinline__ float key_val(unsigned k) { const unsigned m = k & 0xFFFFFF80u; return __uint_as_float((m & 0x80000000u) ? (m & 0x7FFFFFFFu) : ~m); }
__device__ __forceinline__ void peer_fill_par(const Params& p, LAS unsigned char* lds) {
    const int tid = pg8::ftid();
    LAS float* PAR = (LAS float*)(lds + 32768);
    const float* C1g = (const float*)(p.ws + CTL_C1); const float* C0g = (const float*)(p.ws + CTL_C0);
    for (int i = tid; i < 2048; i += 512) { const int pi_ = PAR_IDX(i); PAR[pi_] = p.ln1_g[i]; PAR[2048 + pi_] = p.ln1_b[i]; PAR[4096 + pi_] = p.ln2_g[i]; PAR[6144 + pi_] = p.ln2_b[i]; PAR[8192 + pi_] = C1g[i]; PAR[10240 + pi_] = C0g[i]; }
    if (tid < 64) {
        int c = 0, val = 0;
        for (int i = 0; i < 16; ++i) { const int nj = 16 / (i + 1); for (int j = 0; j < nj; ++j) { if (c == tid) val = (i << 4) | j; ++c; } }
        ((LAS int*)(lds + PEER_SLOT_TAB))[tid] = val;
    }
    __syncthreads();
}
__device__ __forceinline__ void phase_peer_sel(const Params& p, LAS unsigned char* lds, const int t0, const int t1, const int w0, const int nw, const bool uv = false) {
    int* const EIx = (int*)(p.ws + WS_V); float* const EGx = (float*)(p.ws + WS_V + 8 * MiB); float* const STx = (float*)(p.ws + WS_V + 16 * MiB); int* const OFFx = (int*)(p.ws + WS_V + 18 * MiB);
    const int tid = pg8::ftid(), lane0 = tid & 63, wave = tid >> 6;
    LAS unsigned* K1 = (LAS unsigned*)(lds + wave * 4096);
    LAS unsigned* K2 = (LAS unsigned*)(lds + wave * 4096 + 1024);
    LAS int* Ei = (LAS int*)(lds + wave * 4096 + 3072);
    LAS float* Eg = (LAS float*)(lds + wave * 4096 + 3584);
    LAS float* PAR = (LAS float*)(lds + 32768);
    if (wave < w0 || wave >= w0 + nw) return;
    unsigned ciw = 0u, cjw = 0u;
    { const int sub0 = lane0 & 7; int c = 0; for (int i = 0; i < 16; ++i) { const int nj = 16 / (i + 1); for (int j = 0; j < nj; ++j) { if ((c & 7) == sub0) { ciw |= (unsigned)i << (4 * (c >> 3)); cjw |= (unsigned)j << (4 * (c >> 3)); } ++c; } } }
    const bf16* R = (const bf16*)(p.ws + WS_R);
    const unsigned char* U6 = p.ws + WS_UBF; const unsigned char* V6 = p.ws + WS_VBF;
    const _Float16* SC = (const _Float16*)(p.ws + WS_TMP);
    const int gw = t0 + (int)blockIdx.x * nw + (wave - w0), NGW = (int)gridDim.x * nw;
    struct SelIn { v4u rw[4]; v2u sc[8]; };
    const size_t uvNT = (size_t)gridDim.x * 512, uv0 = uv_early_units() + (size_t)blockIdx.x * 512 + tid, uv1 = (size_t)2 * 16384 * 64;
    const int nit = gw < t1 ? (t1 - gw + NGW - 1) / NGW : 0;
    const int qmax = (int)((uv1 - uv_early_units() + uvNT - 1) / uvNT);
    int it_ = 0;
#pragma unroll 1
    for (int r = gw; r < t1; r += NGW) {
        int lane = lane0; asm volatile("" : "+v"(lane));
        const int qd = lane & 3, qbase = lane & ~3; (void)qbase;
        f32x4 uvv[8]; const size_t uvi = uv0 + (size_t)it_ * uvNT; const bool uvok = uv && MK_UV_IN_SEL && it_ < qmax && uvi < uv1;
        if (uvok) uvconv_unit_load(p, uvi, uvv);
        SelIn in_;
#pragma unroll
        for (int q = 0; q < 4; ++q) in_.rw[q] = *(const v4u*)(R + (size_t)r * D + lane * 32 + q * 8);
#pragma unroll
        for (int i = 0; i < 8; ++i) in_.sc[i] = *(const v2u*)(SC + (size_t)r * D + lane * 32 + 4 * i);
        float mu, rstd;
        {
            v4u (&w)[4] = in_.rw; float s1 = 0.f;
#pragma unroll
            for (int q = 0; q < 4; ++q) {
                s1 += ((bflo(w[q].x) + bfhi(w[q].x)) + (bflo(w[q].y) + bfhi(w[q].y))) + ((bflo(w[q].z) + bfhi(w[q].z)) + (bflo(w[q].w) + bfhi(w[q].w))); }
            mu = wave_sum(s1) * (1.f / D); float s2 = 0.f;
#pragma unroll
            for (int q = 0; q < 4; ++q) { const float d0 = bflo(w[q].x) - mu, d1 = bfhi(w[q].x) - mu, d2 = bflo(w[q].y) - mu, d3 = bfhi(w[q].y) - mu, d4 = bflo(w[q].z) - mu, d5 = bfhi(w[q].z) - mu, d6 = bflo(w[q].w) - mu, d7 = bfhi(w[q].w) - mu;
                s2 += ((d0 * d0 + d1 * d1) + (d2 * d2 + d3 * d3)) + ((d4 * d4 + d5 * d5) + (d6 * d6 + d7 * d7)); }
            rstd = 1.f / sqrtf(wave_sum(s2) * (1.f / D) + LN_EPS);
        }
        {
            unsigned v[32];
#pragma unroll
            for (int i = 0; i < 8; ++i) { typedef _Float16 h4_t __attribute__((ext_vector_type(4))); const h4_t th = __builtin_bit_cast(h4_t, in_.sc[i]);
                const f32x4 t = {(float)th[0], (float)th[1], (float)th[2], (float)th[3]};
                const f32x4 a1 = *(const LAS f32x4*)(PAR + 8192 + (i * 64 + lane) * 4), a0 = *(const LAS f32x4*)(PAR + 10240 + (i * 64 + lane) * 4);
                const f32x4 y = (t - a1 * mu) * rstd + a0;
#pragma unroll
                for (int c = 0; c < 4; ++c) { const unsigned u = __float_as_uint(y[c]); const unsigned mono = (u & 0x80000000u) ? ~u : (u | 0x80000000u);
                    v[4 * i + c] = (mono & 0xFFFFFF80u) | (unsigned)(127 - (qd * 32 + 4 * i + c)); } }
            unsigned A[16], B[16];
#pragma unroll
            for (int i = 0; i < 16; ++i) { A[i] = v[i]; B[i] = v[16 + i]; }
            sort16_desc(A); sort16_desc(B);
#pragma unroll
            for (int i = 0; i < 16; ++i) A[i] = A[i] > B[15 - i] ? A[i] : B[15 - i];
            merge16_desc(A);
#pragma unroll
            for (int i = 0; i < 16; ++i) B[i] = (unsigned)__builtin_amdgcn_update_dpp(0, (int)A[15 - i], 0xB1, 0xF, 0xF, true);
#pragma unroll
            for (int i = 0; i < 16; ++i) A[i] = A[i] > B[i] ? A[i] : B[i];
            merge16_desc(A);
#pragma unroll
            for (int i = 0; i < 16; ++i) B[i] = (unsigned)__builtin_amdgcn_update_dpp(0, (int)A[15 - i], 0x4E, 0xF, 0xF, true);
#pragma unroll
            for (int i = 0; i < 16; ++i) A[i] = A[i] > B[i] ? A[i] : B[i];
            merge16_desc(A);
            const int g = lane >> 2;
            const unsigned w0 = qd == 0 ? A[0] : qd == 1 ? A[4] : qd == 2 ? A[8] : A[12], w1 = qd == 0 ? A[1] : qd == 1 ? A[5] : qd == 2 ? A[9] : A[13];
            const unsigned w2 = qd == 0 ? A[2] : qd == 1 ? A[6] : qd == 2 ? A[10] : A[14], w3 = qd == 0 ? A[3] : qd == 1 ? A[7] : qd == 2 ? A[11] : A[15];
            *(LAS v4u*)(K1 + g * 16 + 4 * qd) = (v4u){w0, w1, w2, w3};
        }
        LDS_WAIT();
        {
            const int hh = lane >> 3, sub = lane & 7;
            unsigned kv[8];
#pragma unroll
            for (int a = 0; a < 7; ++a) { const int ci_ = (ciw >> (4 * a)) & 15, cj_ = (cjw >> (4 * a)) & 15; const bool ok = (sub + 8 * a) < 50;
                const unsigned k0 = K1[(2 * hh) * 16 + ci_], k1 = K1[(2 * hh + 1) * 16 + cj_];
                const float s = key_val(k0) + key_val(k1);
                const unsigned u = __float_as_uint(s); const unsigned mono = (u & 0x80000000u) ? ~u : (u | 0x80000000u);
                kv[a] = ok ? ((mono & 0xFFFFFFC0u) | (unsigned)(63 - (sub + 8 * a))) : 0u; }
            kv[7] = 0u;
            sort8_desc(kv);
            PEER_XSTEP(kv, 0xB1, true, (sub & 1) == 0);  merge8_desc(kv);
            PEER_XSTEP(kv, 0x1B, true, (sub & 3) < 2);   PEER_XSTEP(kv, 0xB1, false, (sub & 1) == 0); merge8_desc(kv);
            PEER_XSTEP(kv, 0x141, true, sub < 4);        PEER_XSTEP(kv, 0x4E, false, (sub & 2) == 0); PEER_XSTEP(kv, 0xB1, false, (sub & 1) == 0); merge8_desc(kv);
            const float smax = key2_val((unsigned)__shfl((int)kv[0], lane & ~7));
            float ex[8]; int eid[8]; float part = 0.f;
            LAS const int* TAB = (LAS const int*)(lds + PEER_SLOT_TAB);
#pragma unroll
            for (int r_ = 0; r_ < 8; ++r_) {
                const int tb = TAB[63 - (int)(kv[r_] & 63u)];
                const unsigned k0 = K1[(2 * hh) * 16 + (tb >> 4)], k1 = K1[(2 * hh + 1) * 16 + (tb & 15)];
                eid[r_] = (127 - (int)(k0 & 127u)) * 128 + (127 - (int)(k1 & 127u));
                ex[r_] = sub < 2 ? __expf(key2_val(kv[r_]) - smax) : 0.f; part += ex[r_]; }
            part += __builtin_bit_cast(float, __builtin_amdgcn_update_dpp(0, __builtin_bit_cast(int, part), 0xB1, 0xF, 0xF, true));
            const float inv = 1.f / part;
            if (sub < 2) {
#pragma unroll
                for (int r_ = 0; r_ < 8; ++r_) { Ei[hh * 16 + 8 * sub + r_] = eid[r_]; Eg[hh * 16 + 8 * sub + r_] = ex[r_] * inv; }
            }
        }
        {
            unsigned char* XQ = p.ws + WS_SIGO;
            float xs_[32];
#pragma unroll
            for (int q = 0; q < 4; ++q) {
                const v4u w = in_.rw[q]; const int p0_ = ((2 * q) * 64 + lane) * 4, p1_ = ((2 * q + 1) * 64 + lane) * 4;
                const f32x4 g0 = *(const LAS f32x4*)(PAR + p0_), g1 = *(const LAS f32x4*)(PAR + p1_), b0 = *(const LAS f32x4*)(PAR + 2048 + p0_), b1 = *(const LAS f32x4*)(PAR + 2048 + p1_);
                float xv[8];
                xv[0] = (bflo(w.x) - mu) * rstd * g0.x + b0.x; xv[1] = (bfhi(w.x) - mu) * rstd * g0.y + b0.y; xv[2] = (bflo(w.y) - mu) * rstd * g0.z + b0.z; xv[3] = (bfhi(w.y) - mu) * rstd * g0.w + b0.w;
                xv[4] = (bflo(w.z) - mu) * rstd * g1.x + b1.x; xv[5] = (bfhi(w.z) - mu) * rstd * g1.y + b1.y; xv[6] = (bflo(w.w) - mu) * rstd * g1.z + b1.z; xv[7] = (bfhi(w.w) - mu) * rstd * g1.w + b1.w;
#pragma unroll
                for (int e = 0; e < 8; ++e) xs_[8 * q + e] = xv[e] * XQ_SCALE;
            }
            v16f x0, x1;
#pragma unroll
            for (int i = 0; i < 16; ++i) { x0[i] = xs_[i]; x1[i] = xs_[16 + i]; }
            const v6u wq_ = __builtin_amdgcn_cvt_scalef32_2xpk16_fp6_f32(x0, x1, 1.0f);
            *(v4u*)(XQ + (size_t)r * ROW6 + lane * 16) = (v4u){wq_[0], wq_[1], wq_[2], wq_[3]};
            *(v2u*)(XQ + (size_t)r * ROW6 + 1024 + lane * 8) = (v2u){wq_[4], wq_[5]};
        }
        LDS_WAIT();
        {
            const int ea = Ei[lane] & 16383, eb = Ei[lane + 64] & 16383; const float ga = Eg[lane], gb = Eg[lane + 64];
            const int sa = ea >> 11, sb = eb >> 11;
            int pa = 0, pb = 0, run = 0, offv = 0;
#pragma unroll
            for (int s = 0; s < 8; ++s) {
                const unsigned long long ba = __ballot(sa == s), bb = __ballot(sb == s);
                const int ca = __popcll(ba), cb = __popcll(bb);
                const int la = (int)__builtin_amdgcn_mbcnt_hi((unsigned)(ba >> 32), __builtin_amdgcn_mbcnt_lo((unsigned)ba, 0u)), lb = (int)__builtin_amdgcn_mbcnt_hi((unsigned)(bb >> 32), __builtin_amdgcn_mbcnt_lo((unsigned)bb, 0u));
                if (sa == s) pa = run + la;
                if (sb == s) pb = run + ca + lb;
                if (lane == s) offv = run;
                run += ca + cb;
            }
            if (lane == 8) offv = 128;
            EIx[(size_t)r * 128 + pa] = ea; EGx[(size_t)r * 128 + pa] = ga; EIx[(size_t)r * 128 + pb] = eb; EGx[(size_t)r * 128 + pb] = gb;
            if (lane < 9) OFFx[(size_t)r * 16 + lane] = offv;
            if (lane == 0) { STx[32 * (size_t)r] = mu; STx[32 * (size_t)r + 1] = rstd; }
        }
        LDS_WAIT();
        if (uvok) uvconv_unit_store(p, uvi, uvv);
        if (uv && MK_UV_IN_SEL) {
#pragma unroll 1
            for (int q = it_ + nit; q < qmax; q += nit) { const size_t i2 = uv0 + (size_t)q * uvNT; if (i2 < uv1) { f32x4 v2_[8]; uvconv_unit_load(p, i2, v2_); uvconv_unit_store(p, i2, v2_); } }
        }
        ++it_;
    }
    if (uv && MK_UV_IN_SEL && nit == 0) {
#pragma unroll 1
        for (int q = 0; q < qmax; ++q) { const size_t i2 = uv0 + (size_t)q * uvNT; if (i2 < uv1) { f32x4 v2_[8]; uvconv_unit_load(p, i2, v2_); uvconv_unit_store(p, i2, v2_); } }
    }
}
__device__ __forceinline__ void phase_peer_us(const Params& p, LAS unsigned char* lds, const int t0, const int t1, const int w0, const int nw, const int fold = 0) {
    int* const EIx = (int*)(p.ws + WS_V); float* const EGx = (float*)(p.ws + WS_V + 8 * MiB); float* const STx = (float*)(p.ws + WS_V + 16 * MiB); int* const OFFx = (int*)(p.ws + WS_V + 18 * MiB); float* const WGx = (float*)(p.ws + WS_V + (fold ? 36 : 20) * MiB);
    const int tid = pg8::ftid(), lane0 = tid & 63, wave = tid >> 6;
    LAS unsigned* K1 = (LAS unsigned*)(lds + wave * 4096);
    LAS unsigned* K2 = (LAS unsigned*)(lds + wave * 4096 + 1024);
    LAS int* Ei = (LAS int*)(lds + wave * 4096 + 3072);
    LAS float* Eg = (LAS float*)(lds + wave * 4096 + 3584);
    LAS float* PAR = (LAS float*)(lds + 32768);
    unsigned ciw = 0u, cjw = 0u;
    { const int sub0 = lane0 & 7; int c = 0; for (int i = 0; i < 16; ++i) { const int nj = 16 / (i + 1); for (int j = 0; j < nj; ++j) { if ((c & 7) == sub0) { ciw |= (unsigned)i << (4 * (c >> 3)); cjw |= (unsigned)j << (4 * (c >> 3)); } ++c; } } }
    const bf16* R = (const bf16*)(p.ws + WS_R);
    const unsigned char* U6 = p.ws + WS_UBF; const unsigned char* V6 = p.ws + WS_VBF;
    const _Float16* SC = (const _Float16*)(p.ws + WS_TMP);
    const int gw = blockIdx.x * 8 + wave, NGW = gridDim.x * 8;
    LAS int* const Ei1 = (LAS int*)(lds + wave * 4096); LAS float* const Eg1 = (LAS float*)(lds + wave * 4096 + 512);
    const int sl = (int)blockIdx.x & 7;
    if (wave < w0 || wave >= w0 + nw) return;
    const int W = (((int)gridDim.x - sl + 7) >> 3) * nw;
    const int widx = t0 + ((int)blockIdx.x >> 3) * nw + (wave - w0);
    struct It { unsigned x0, x1, x2, x3, x4, x5; int id; float g; int st, cnt; int oa, ob; };
    const unsigned char* XQ = p.ws + WS_SIGO;
    LAS float* const Ea0 = (LAS float*)(lds + wave * 4096 + 1024); LAS float* const Ea1 = (LAS float*)(lds + wave * 4096 + 1536);
    auto offs_raw = [&](const int r, It& t) __attribute__((always_inline)) { t.oa = OFFx[(size_t)r * 16 + sl]; t.ob = OFFx[(size_t)r * 16 + sl + 1]; };
    auto iload = [&](const int r, const int lane, It& t) __attribute__((always_inline)) {
        const int st = __builtin_amdgcn_readfirstlane(t.oa), cnt = __builtin_amdgcn_readfirstlane(t.ob) - st;
        { const v4u a_ = *(const v4u*)(XQ + (size_t)r * ROW6 + lane * 16); const v2u b_ = *(const v2u*)(XQ + (size_t)r * ROW6 + 1024 + lane * 8); t.x0 = a_.x; t.x1 = a_.y; t.x2 = a_.z; t.x3 = a_.w; t.x4 = b_.x; t.x5 = b_.y; }
        const bool ok = lane < cnt;
        t.id = ok ? EIx[(size_t)r * 128 + st + lane] : 0; t.g = ok ? EGx[(size_t)r * 128 + st + lane] : 0.f;
        t.st = st; t.cnt = cnt;
    };
    auto loadu = [&](v6u (&w)[4], int e0, LAS int* ei, int cn, int lane) __attribute__((always_inline)) {
        (void)cn;
        typedef int i4_t __attribute__((ext_vector_type(4)));
        const i4_t ids = *(const LAS i4_t*)(ei + e0);
        unsigned o16 = (unsigned)lane * 16u, o8 = 1024u + (unsigned)lane * 8u; asm volatile("" : "+v"(o16), "+v"(o8));
#pragma unroll
        for (int k = 0; k < 4; ++k) { const int id = (__builtin_amdgcn_readfirstlane(ids[k]) & 16383) & ~(fold << 10); const GAS unsigned char* up = (const GAS unsigned char*)pg8::sgpr_ptr((const char*)(U6 + (size_t)id * ROW6));
            const v4u a = *(const GAS v4u*)(up + o16); const v2u b = *(const GAS v2u*)(up + o8); w[k] = (v6u){a.x, a.y, a.z, a.w, b.x, b.y}; }
    };
    auto compu = [&](const v6u (&w)[4], int e0, LAS float* ea, const i32x8_& xq, int lane) __attribute__((always_inline)) {
        float s[4];
        const bool dg_ = (lane >> 4) == ((lane & 15) >> 2);
        const float m0_ = (dg_ && (lane & 3) == 0) ? (1.f / XQ_SCALE) : 0.f, m1_ = (dg_ && (lane & 3) == 1) ? (1.f / XQ_SCALE) : 0.f, m2_ = (dg_ && (lane & 3) == 2) ? (1.f / XQ_SCALE) : 0.f, m3_ = (dg_ && (lane & 3) == 3) ? (1.f / XQ_SCALE) : 0.f;
#pragma unroll
        for (int k = 0; k < 4; ++k) {
            const i32x8_ av = {(int)w[k][0], (int)w[k][1], (int)w[k][2], (int)w[k][3], (int)w[k][4], (int)w[k][5], 0, 0};
            const f32x4 c = __builtin_amdgcn_mfma_scale_f32_16x16x128_f8f6f4(av, xq, (f32x4){0.f, 0.f, 0.f, 0.f}, 2  , 2  , 0, 0x7f7f7f7f, 0, 0x7f7f7f7f);
            s[k] = (m0_ * c[0] + m1_ * c[1]) + (m2_ * c[2] + m3_ * c[3]); }
        float u1;
        { const auto r02 = __builtin_amdgcn_permlane32_swap(__float_as_uint(s[0]), __float_as_uint(s[2]), false, false);
          const auto r13 = __builtin_amdgcn_permlane32_swap(__float_as_uint(s[1]), __float_as_uint(s[3]), false, false);
          const float a02 = __uint_as_float(r02[0]) + __uint_as_float(r02[1]), a13 = __uint_as_float(r13[0]) + __uint_as_float(r13[1]);
          const auto rr = __builtin_amdgcn_permlane16_swap(__float_as_uint(a02), __float_as_uint(a13), false, false);
          u1 = row16_sum(__uint_as_float(rr[0]) + __uint_as_float(rr[1])); }
        if ((lane & 15) == 0) ea[e0 + (lane >> 4)] = u1;
    };
    if (widx >= t1) return;
    It A, B;
    v6u p0[4], p1[4], p2[4], q0[4], q1[4], q2[4];
    {
        int l0 = lane0; asm volatile("" : "+v"(l0));
        offs_raw(widx, A); if (widx + W < t1) offs_raw(widx + W, B);
        iload(widx, l0, A);
        Ei[l0] = (l0 < A.cnt) ? A.id : __builtin_amdgcn_readfirstlane(A.id); Eg[l0] = A.g;
        LDS_WAIT();
        const int acnt_ = __builtin_amdgcn_readfirstlane(A.cnt); const int c0 = acnt_ < 64 ? acnt_ : 64;
        if (c0 > 0) loadu(p0, 0, Ei, c0, l0);
        if (c0 > 4) loadu(p1, 4, Ei, c0, l0);
        if (c0 > 8) loadu(p2, 8, Ei, c0, l0);
    }
    auto item = [&](const int r, const int par, It& cur, It& nxt, v6u (&wa)[4], v6u (&wb)[4], v6u (&wc)[4], v6u (&na)[4], v6u (&nb)[4], v6u (&nc)[4]) __attribute__((always_inline)) {
        int lane = lane0; asm volatile("" : "+v"(lane));
        LAS int* const eiC = par ? Ei1 : Ei; LAS float* const egC = par ? Eg1 : Eg; LAS int* const eiN = par ? Ei : Ei1; LAS float* const egN = par ? Eg : Eg1; LAS float* const eaC = par ? Ea1 : Ea0;
        const int st = __builtin_amdgcn_readfirstlane(cur.st), cntall = __builtin_amdgcn_readfirstlane(cur.cnt);
        const int cnt = cntall < 64 ? cntall : 64;
        if (r + W < t1) iload(r + W, lane, nxt);
        if (r + 2 * W < t1) offs_raw(r + 2 * W, cur);
        const i32x8_ xq = {(int)cur.x0, (int)cur.x1, (int)cur.x2, (int)cur.x3, (int)cur.x4, (int)cur.x5, 0, 0};
#pragma unroll 1
        for (int e0 = 0; e0 < cnt; e0 += 12) {
            compu(wa, e0, eaC, xq, lane);
            if (e0 + 12 < cnt) loadu(wa, e0 + 12, eiC, cnt, lane);
            if (e0 + 4 < cnt) { compu(wb, e0 + 4, eaC, xq, lane); if (e0 + 16 < cnt) loadu(wb, e0 + 16, eiC, cnt, lane); }
            if (e0 + 8 < cnt) { compu(wc, e0 + 8, eaC, xq, lane); if (e0 + 20 < cnt) loadu(wc, e0 + 20, eiC, cnt, lane); }
        }
        if (r + W < t1) {
            const int ncnt_ = __builtin_amdgcn_readfirstlane(nxt.cnt); const int cn = ncnt_ < 64 ? ncnt_ : 64;
            eiN[lane] = (lane < ncnt_) ? nxt.id : __builtin_amdgcn_readfirstlane(nxt.id); egN[lane] = nxt.g;
            LDS_WAIT();
            if (cn > 0) loadu(na, 0, eiN, cn, lane);
            if (cn > 4) loadu(nb, 4, eiN, cn, lane);
            if (cn > 8) loadu(nc, 8, eiN, cn, lane);
        }
        LDS_WAIT();
        if (lane < cnt) WGx[(size_t)r * 128 + st + lane] = egC[lane] * gelu_exact(eaC[lane] * (1.f / U_SCALE)) * (1.f / V_SCALE);
#pragma unroll 1
        for (int c0 = 64; c0 < cntall; c0 += 64) {
            const int cn = (cntall - c0) < 64 ? (cntall - c0) : 64;
            LDS_WAIT();
            { const int id_ = lane < cn ? EIx[(size_t)r * 128 + st + c0 + lane] : 0; eiC[lane] = lane < cn ? id_ : __builtin_amdgcn_readfirstlane(id_); } egC[lane] = lane < cn ? EGx[(size_t)r * 128 + st + c0 + lane] : 0.f;
            LDS_WAIT();
#pragma unroll 1
            for (int e0 = 0; e0 < cn; e0 += 4) { loadu(wa, e0, eiC, cn, lane); compu(wa, e0, eaC, xq, lane); }
            LDS_WAIT();
            if (lane < cn) WGx[(size_t)r * 128 + st + c0 + lane] = egC[lane] * gelu_exact(eaC[lane] * (1.f / U_SCALE)) * (1.f / V_SCALE);
        }
        LDS_WAIT();
    };
#pragma unroll 1
    for (int r = widx; r < t1; r += 2 * W) {
        item(r, 0, A, B, p0, p1, p2, q0, q1, q2);
        if (r + W < t1) item(r + W, 1, B, A, q0, q1, q2, p0, p1, p2);
    }
}
template <int PART>
__device__ __forceinline__ void phase_peer(const Params& p, LAS unsigned char* lds, const int t0 = 0, const int t1 = MX, const int w0 = 0, const int nw = 8) {
    int* const EIx = (int*)(p.ws + WS_V); float* const EGx = (float*)(p.ws + WS_V + 8 * MiB); float* const STx = (float*)(p.ws + WS_V + 16 * MiB);
    const int tid = pg8::ftid(), lane0 = tid & 63, wave = tid >> 6;
    LAS unsigned* K1 = (LAS unsigned*)(lds + wave * 4096);
    LAS unsigned* K2 = (LAS unsigned*)(lds + wave * 4096 + 1024);
    LAS int* Ei = (LAS int*)(lds + wave * 4096 + 3072);
    LAS float* Eg = (LAS float*)(lds + wave * 4096 + 3584);
    LAS float* PAR = (LAS float*)(lds + 32768);
    if constexpr (PART != 1) {
    {
        const float* C1g = (const float*)(p.ws + CTL_C1); const float* C0g = (const float*)(p.ws + CTL_C0);
        for (int i = tid; i < 2048; i += 512) { const int pi_ = PAR_IDX(i); PAR[pi_] = p.ln1_g[i]; PAR[2048 + pi_] = p.ln1_b[i]; PAR[4096 + pi_] = p.ln2_g[i]; PAR[6144 + pi_] = p.ln2_b[i]; PAR[8192 + pi_] = C1g[i]; PAR[10240 + pi_] = C0g[i]; }
    }
    __syncthreads();
    }
    if constexpr (PART == 1) { if (wave < w0 || wave >= w0 + nw) return; }
    unsigned ciw = 0u, cjw = 0u;
    { const int sub0 = lane0 & 7; int c = 0; for (int i = 0; i < 16; ++i) { const int nj = 16 / (i + 1); for (int j = 0; j < nj; ++j) { if ((c & 7) == sub0) { ciw |= (unsigned)i << (4 * (c >> 3)); cjw |= (unsigned)j << (4 * (c >> 3)); } ++c; } } }
    const bf16* R = (const bf16*)(p.ws + WS_R);
    const unsigned char* U6 = p.ws + WS_UBF; const unsigned char* V6 = p.ws + WS_VBF;
    const _Float16* SC = (const _Float16*)(p.ws + WS_TMP);
    const int gw = t0 + (int)blockIdx.x * nw + (wave - w0), NGW = (int)gridDim.x * nw;
    struct TokIn { v4u rw[4]; v2u sc[8]; float mu, rstd; int e0, e1; float g0, g1; };
    auto tok_load = [&](int r, int lane, TokIn& t) __attribute__((always_inline)) {
#pragma unroll
        for (int q = 0; q < 4; ++q) t.rw[q] = *(const v4u*)(R + (size_t)r * D + lane * 32 + q * 8);
        if constexpr (PART != 1) {
#pragma unroll
            for (int i = 0; i < 8; ++i) t.sc[i] = *(const v2u*)(SC + (size_t)r * D + lane * 32 + 4 * i);
        } else {
            t.mu = STx[32 * (size_t)r]; t.rstd = STx[32 * (size_t)r + 1];
            t.e0 = EIx[(size_t)r * 128 + lane]; t.e1 = EIx[(size_t)r * 128 + 64 + lane]; { const float* WG_ = (MK_PEER_SPLIT == 3) ? (const float*)(p.ws + WS_V + 20 * MiB) : EGx; t.g0 = WG_[(size_t)r * 128 + lane]; t.g1 = WG_[(size_t)r * 128 + 64 + lane]; }
        }
    };
    TokIn cur, nxt;
    if constexpr (PART != 2) { if (gw < t1) { int l0 = lane0; asm volatile("" : "+v"(l0)); tok_load(gw, l0, cur); } }
#pragma unroll 1
    for (int r = gw; r < t1; r += NGW) {
        int lane = lane0; asm volatile("" : "+v"(lane));
        const int qd = lane & 3, qbase = lane & ~3;
        if constexpr (PART == 2) tok_load(r, lane, cur);
        float mu, rstd;
        v4u (&rw_)[4] = cur.rw;
        {
            v4u (&w)[4] = rw_; float s1 = 0.f;
#pragma unroll
            for (int q = 0; q < 4; ++q) {
                s1 += ((bflo(w[q].x) + bfhi(w[q].x)) + (bflo(w[q].y) + bfhi(w[q].y))) + ((bflo(w[q].z) + bfhi(w[q].z)) + (bflo(w[q].w) + bfhi(w[q].w))); }
            if constexpr (PART == 1) { mu = cur.mu; rstd = cur.rstd; }
            else {
            mu = wave_sum(s1) * (1.f / D); float s2 = 0.f;
#pragma unroll
            for (int q = 0; q < 4; ++q) { const float d0 = bflo(w[q].x) - mu, d1 = bfhi(w[q].x) - mu, d2 = bflo(w[q].y) - mu, d3 = bfhi(w[q].y) - mu, d4 = bflo(w[q].z) - mu, d5 = bfhi(w[q].z) - mu, d6 = bflo(w[q].w) - mu, d7 = bfhi(w[q].w) - mu;
                s2 += ((d0 * d0 + d1 * d1) + (d2 * d2 + d3 * d3)) + ((d4 * d4 + d5 * d5) + (d6 * d6 + d7 * d7)); }
            rstd = 1.f / sqrtf(wave_sum(s2) * (1.f / D) + LN_EPS);
            }
        }
        if constexpr (PART == 1) {
            Ei[lane] = cur.e0; Ei[lane + 64] = cur.e1; Eg[lane] = cur.g0; Eg[lane + 64] = cur.g1;
        }
        if constexpr (PART != 1)
        for (int rep11_ = 0; rep11_ < (((MK_PROBE) >> 11) & 1) + 1; ++rep11_) {
        {
            unsigned v[32];
#pragma unroll
            for (int i = 0; i < 8; ++i) { typedef _Float16 h4_t __attribute__((ext_vector_type(4))); const h4_t th = __builtin_bit_cast(h4_t, cur.sc[i]);
                const f32x4 t = {(float)th[0], (float)th[1], (float)th[2], (float)th[3]};
                const f32x4 a1 = *(const LAS f32x4*)(PAR + 8192 + (i * 64 + lane) * 4), a0 = *(const LAS f32x4*)(PAR + 10240 + (i * 64 + lane) * 4);
                const f32x4 y = (t - a1 * mu) * rstd + a0;
#pragma unroll
                for (int c = 0; c < 4; ++c) { const unsigned u = __float_as_uint(y[c]); const unsigned mono = (u & 0x80000000u) ? ~u : (u | 0x80000000u);
                    v[4 * i + c] = (mono & 0xFFFFFF80u) | (unsigned)(127 - (qd * 32 + 4 * i + c)); } }
            unsigned A[16], B[16];
#pragma unroll
            for (int i = 0; i < 16; ++i) { A[i] = v[i]; B[i] = v[16 + i]; }
            sort16_desc(A); sort16_desc(B);
#pragma unroll
            for (int i = 0; i < 16; ++i) A[i] = A[i] > B[15 - i] ? A[i] : B[15 - i];
            merge16_desc(A);
#pragma unroll
            for (int i = 0; i < 16; ++i) B[i] = (unsigned)__builtin_amdgcn_update_dpp(0, (int)A[15 - i], 0xB1, 0xF, 0xF, true);
#pragma unroll
            for (int i = 0; i < 16; ++i) A[i] = A[i] > B[i] ? A[i] : B[i];
            merge16_desc(A);
#pragma unroll
            for (int i = 0; i < 16; ++i) B[i] = (unsigned)__builtin_amdgcn_update_dpp(0, (int)A[15 - i], 0x4E, 0xF, 0xF, true);
#pragma unroll
            for (int i = 0; i < 16; ++i) A[i] = A[i] > B[i] ? A[i] : B[i];
            merge16_desc(A);
            const int g = lane >> 2;
            const unsigned w0 = qd == 0 ? A[0] : qd == 1 ? A[4] : qd == 2 ? A[8] : A[12], w1 = qd == 0 ? A[1] : qd == 1 ? A[5] : qd == 2 ? A[9] : A[13];
            const unsigned w2 = qd == 0 ? A[2] : qd == 1 ? A[6] : qd == 2 ? A[10] : A[14], w3 = qd == 0 ? A[3] : qd == 1 ? A[7] : qd == 2 ? A[11] : A[15];
            *(LAS v4u*)(K1 + g * 16 + 4 * qd) = (v4u){w0, w1, w2, w3};
        }
        LDS_WAIT();
        {
            const int hh = lane >> 3, sub = lane & 7;
            float sa[7]; int ea[7]; unsigned ka[7];
#pragma unroll
            for (int a = 0; a < 7; ++a) { const int ci_ = (ciw >> (4 * a)) & 15, cj_ = (cjw >> (4 * a)) & 15; const bool ok = (sub + 8 * a) < 50;
                const unsigned k0 = K1[(2 * hh) * 16 + ci_], k1 = K1[(2 * hh + 1) * 16 + cj_];
                const float s = key_val(k0) + key_val(k1);
                sa[a] = s; ea[a] = (127 - (int)(k0 & 127u)) * 128 + (127 - (int)(k1 & 127u));
                const unsigned u = __float_as_uint(s); const unsigned mono = (u & 0x80000000u) ? ~u : (u | 0x80000000u);
                ka[a] = ok ? ((mono & 0xFFFFFFC0u) | (unsigned)(63 - (sub + 8 * a))) : 0u;
                K2[hh * 64 + sub + 8 * a] = ka[a]; }
            if (sub == 0) K2[hh * 64 + 56] = 0u;
            LDS_WAIT();
            int rk[7];
#pragma unroll
            for (int a = 0; a < 7; ++a) rk[a] = 0;
#pragma unroll
            for (int q = 0; q < 14; ++q) { const v4u kb = *(const LAS v4u*)(K2 + hh * 64 + 4 * q);
#pragma unroll
                for (int a = 0; a < 7; ++a) rk[a] += (kb.x > ka[a] ? 1 : 0) + (kb.y > ka[a] ? 1 : 0) + (kb.z > ka[a] ? 1 : 0) + (kb.w > ka[a] ? 1 : 0); }
            const float smax = key_val(K1[(2 * hh) * 16]) + key_val(K1[(2 * hh + 1) * 16]);
            float ex[7]; float part = 0.f;
#pragma unroll
            for (int a = 0; a < 7; ++a) { const bool sel = ka[a] != 0u && rk[a] < 16; ex[a] = sel ? __expf(sa[a] - smax) : 0.f; part += ex[a]; }
            part += __builtin_bit_cast(float, __builtin_amdgcn_update_dpp(0, __builtin_bit_cast(int, part), 0xB1, 0xF, 0xF, true));
            part += __builtin_bit_cast(float, __builtin_amdgcn_update_dpp(0, __builtin_bit_cast(int, part), 0x4E, 0xF, 0xF, true));
            part += __builtin_bit_cast(float, __builtin_amdgcn_update_dpp(0, __builtin_bit_cast(int, part), 0x141, 0xF, 0xF, true));
            const float inv = 1.f / part;
#pragma unroll
            for (int a = 0; a < 7; ++a) if (ka[a] != 0u && rk[a] < 16) { Ei[hh * 16 + rk[a]] = ea[a]; Eg[hh * 16 + rk[a]] = ex[a] * inv; }
        }
        LDS_WAIT();
        }
        v32f x;
        auto make_x = [&]() __attribute__((always_inline)) {
            float xl[32];
#pragma unroll
            for (int q = 0; q < 4; ++q) {
                const int e0 = lane * 32 + q * 8;
                const v4u w = rw_[q];
                const int p0_ = ((2 * q) * 64 + lane) * 4, p1_ = ((2 * q + 1) * 64 + lane) * 4; (void)e0;
                const f32x4 g0 = *(const LAS f32x4*)(PAR + p0_), g1 = *(const LAS f32x4*)(PAR + p1_), b0 = *(const LAS f32x4*)(PAR + 2048 + p0_), b1 = *(const LAS f32x4*)(PAR + 2048 + p1_);
                xl[8 * q + 0] = (bflo(w.x) - mu) * rstd * g0.x + b0.x; xl[8 * q + 1] = (bfhi(w.x) - mu) * rstd * g0.y + b0.y;
                xl[8 * q + 2] = (bflo(w.y) - mu) * rstd * g0.z + b0.z; xl[8 * q + 3] = (bfhi(w.y) - mu) * rstd * g0.w + b0.w;
                xl[8 * q + 4] = (bflo(w.z) - mu) * rstd * g1.x + b1.x; xl[8 * q + 5] = (bfhi(w.z) - mu) * rstd * g1.y + b1.y;
                xl[8 * q + 6] = (bflo(w.w) - mu) * rstd * g1.z + b1.z; xl[8 * q + 7] = (bfhi(w.w) - mu) * rstd * g1.w + b1.w;
            }
#pragma unroll
            for (int i = 0; i < 32; ++i) x[MK_FP6_ORDER ? ((i & 15) * 2 + (i >> 4)) : i] = xl[i];
        };
        if constexpr (PART != 1) make_x();
        if constexpr (PART != 1) {
            auto loadu = [&](v6u (&w)[4], int e0) {
#pragma unroll
                for (int k = 0; k < 4; ++k) { const int id = __builtin_amdgcn_readfirstlane(Ei[e0 + k]) & 16383; const unsigned char* up = U6 + (size_t)id * ROW6;
                    const v4u a = *(const v4u*)(up + lane * 16); const v2u b = *(const v2u*)(up + 1024 + lane * 8); w[k] = (v6u){a.x, a.y, a.z, a.w, b.x, b.y}; }
            };
            auto compu = [&](const v6u (&w)[4], int e0) {
                float s[4];
#pragma unroll
                for (int k = 0; k < 4; ++k) { const v32f y = __builtin_amdgcn_cvt_scalef32_pk32_f32_fp6(w[k], 1.0f); f32x2 a4[4] = {(f32x2){0.f, 0.f}, (f32x2){0.f, 0.f}, (f32x2){0.f, 0.f}, (f32x2){0.f, 0.f}};
#pragma unroll
                    for (int i = 0; i < 16; ++i) a4[i & 3] += (f32x2){y[2 * i], y[2 * i + 1]} * (f32x2){x[2 * i], x[2 * i + 1]};
                    const f32x2 a = (a4[0] + a4[1]) + (a4[2] + a4[3]); s[k] = a.x + a.y; }
                float u1;
                { const auto r02 = __builtin_amdgcn_permlane32_swap(__float_as_uint(s[0]), __float_as_uint(s[2]), false, false);
                  const auto r13 = __builtin_amdgcn_permlane32_swap(__float_as_uint(s[1]), __float_as_uint(s[3]), false, false);
                  const float a02 = __uint_as_float(r02[0]) + __uint_as_float(r02[1]), a13 = __uint_as_float(r13[0]) + __uint_as_float(r13[1]);
                  const auto rr = __builtin_amdgcn_permlane16_swap(__float_as_uint(a02), __float_as_uint(a13), false, false);
                  u1 = row16_sum(__uint_as_float(rr[0]) + __uint_as_float(rr[1])); }
                if ((lane & 15) == 0) { const int k = lane >> 4; Eg[e0 + k] = Eg[e0 + k] * gelu_exact(u1 * (1.f / U_SCALE)) * (1.f / V_SCALE); }
            };
#if MK_PEER_DEPTH == 4
            v6u wa[4], wb[4], wc[4], wd[4];
            loadu(wa, 0); loadu(wb, 4); loadu(wc, 8);
            if constexpr (PART == 0) { if (r + NGW < t1) tok_load(r + NGW, lane, nxt); }
#pragma unroll 1
            for (int e0 = 0; e0 < 112; e0 += 16) {
                loadu(wd, e0 + 12);
                compu(wa, e0);
                loadu(wa, e0 + 16);
                compu(wb, e0 + 4);
                loadu(wb, e0 + 20);
                compu(wc, e0 + 8);
                loadu(wc, e0 + 24);
                compu(wd, e0 + 12);
            }
            loadu(wd, 124); compu(wa, 112); compu(wb, 116); compu(wc, 120); compu(wd, 124);
#else
            v6u wa[4], wb[4], wc[4];
            loadu(wa, 0); loadu(wb, 4);
#pragma unroll 1
            for (int e0 = 0; e0 < 120; e0 += 12) {
                loadu(wc, e0 + 8);
                compu(wa, e0);
                loadu(wa, e0 + 12);
                compu(wb, e0 + 4);
                loadu(wb, e0 + 16);
                compu(wc, e0 + 8);
            }
            compu(wa, 120); compu(wb, 124);
#endif
        }
        LDS_WAIT();
        if constexpr (PART == 0) {
            EIx[(size_t)r * 128 + lane] = Ei[lane]; EIx[(size_t)r * 128 + 64 + lane] = Ei[lane + 64];
            EGx[(size_t)r * 128 + lane] = Eg[lane]; EGx[(size_t)r * 128 + 64 + lane] = Eg[lane + 64];
            if (lane == 0) { STx[32 * (size_t)r] = mu; STx[32 * (size_t)r + 1] = rstd; }
            (void)x;
            cur = nxt;
        } else {
        v32f o;
#pragma unroll
        for (int i = 0; i < 32; ++i) o[i] = 0.f;
        {
            auto loadv = [&](v6u (&w)[4], int e0) {
#pragma unroll
                for (int k = 0; k < 4; ++k) { const int id = __builtin_amdgcn_readfirstlane(Ei[e0 + k]) & 16383; const unsigned char* vp = V6 + (size_t)id * ROW6;
                    const v4u a = *(const v4u*)(vp + lane * 16); const v2u b = *(const v2u*)(vp + 1024 + lane * 8); w[k] = (v6u){a.x, a.y, a.z, a.w, b.x, b.y}; }
            };
            auto compv = [&](const v6u (&w)[4], int e0) {
#pragma unroll
                for (int k = 0; k < 4; ++k) { const float wt = Eg[e0 + k]; const v32f y = __builtin_amdgcn_cvt_scalef32_pk32_f32_fp6(w[k], 1.0f); o += y * wt; }
            };
#if MK_PEER_DEPTH == 4
            v6u wa[4], wb[4], wc[4], wd[4];
            loadv(wa, 0); loadv(wb, 4); loadv(wc, 8);
            if constexpr (PART == 1) { if (r + NGW < t1) tok_load(r + NGW, lane, nxt); }
#pragma unroll 1
            for (int e0 = 0; e0 < 112; e0 += 16) {
                loadv(wd, e0 + 12);
                compv(wa, e0);
                loadv(wa, e0 + 16);
                compv(wb, e0 + 4);
                loadv(wb, e0 + 20);
                compv(wc, e0 + 8);
                loadv(wc, e0 + 24);
                compv(wd, e0 + 12);
            }
            loadv(wd, 124); compv(wa, 112); compv(wb, 116); compv(wc, 120); compv(wd, 124);
#else
            v6u wa[4], wb[4], wc[4];
            loadv(wa, 0); loadv(wb, 4);
#pragma unroll 1
            for (int e0 = 0; e0 < 120; e0 += 12) {
                loadv(wc, e0 + 8);
                compv(wa, e0);
                loadv(wa, e0 + 12);
                compv(wb, e0 + 4);
                loadv(wb, e0 + 16);
                compv(wc, e0 + 8);
            }
            compv(wa, 120); compv(wb, 124);
#endif
        }
        if constexpr (PART == 1) make_x();
        float s1 = 0.f;
#pragma unroll
        for (int i = 0; i < 32; ++i) { o[i] = x[i] * ALPHA + o[i]; s1 += o[i]; }
        const float mean = wave_sum(s1) * (1.f / D); float s2 = 0.f;
#pragma unroll
        for (int i = 0; i < 32; ++i) { o[i] = o[i] - mean; s2 += o[i] * o[i]; }
        const float rstd2 = 1.f / sqrtf(wave_sum(s2) * (1.f / D) + LN_EPS);
#pragma unroll
        for (int q = 0; q < 8; ++q) {
            const int e0 = lane * 32 + q * 4;
            const f32x4 g = *(const LAS f32x4*)(PAR + 4096 + (q * 64 + lane) * 4), bb = *(const LAS f32x4*)(PAR + 6144 + (q * 64 + lane) * 4);
            float oo[4];
#pragma unroll
            for (int c = 0; c < 4; ++c) { const int i = q * 4 + c; oo[c] = o[MK_FP6_ORDER ? ((i & 15) * 2 + (i >> 4)) : i]; }
            f32x4 y; y.x = oo[0] * rstd2 * g.x + bb.x; y.y = oo[1] * rstd2 * g.y + bb.y; y.z = oo[2] * rstd2 * g.z + bb.z; y.w = oo[3] * rstd2 * g.w + bb.w;
            *(f32x4*)(p.out + (size_t)r * D + e0) = y;
        }
        if constexpr (PART == 1) cur = nxt;
        }
    }
}


#ifndef MK_VPAIR
#define MK_VPAIR 1
#endif
__device__ __forceinline__ void phase_peer_v2(const Params& p, LAS unsigned char* lds) {
    const int* const EIx = (const int*)(p.ws + WS_V); const float* const STx = (const float*)(p.ws + WS_V + 16 * MiB); const int* const OFFx = (const int*)(p.ws + WS_V + 18 * MiB); const float* const WGx = (const float*)(p.ws + WS_V + 20 * MiB);
    const int tid = pg8::ftid(), lane0 = tid & 63, wave = tid >> 6;
    LAS int* const EiA = (LAS int*)(lds + wave * 4096);
    LAS int* const EiB = (LAS int*)(lds + wave * 4096 + 512);
    LAS float* const GA = (LAS float*)(lds + wave * 4096 + 1024);
    LAS float* const GB = (LAS float*)(lds + wave * 4096 + 1536);
    LAS float* PAR = (LAS float*)(lds + 32768);
    const bf16* R = (const bf16*)(p.ws + WS_R);
    const unsigned char* V6 = p.ws + WS_VBF;
    const int gw = (int)blockIdx.x * 8 + wave, NGW = (int)gridDim.x * 8, NP = MX / 2;
    if (gw >= NP) return;
    auto loadv = [&](v6u (&w)[4], LAS int* ei, const int e0, const int lane) __attribute__((always_inline)) {
        typedef int i4_t __attribute__((ext_vector_type(4)));
        const i4_t ids = *(const LAS i4_t*)(ei + e0);
        unsigned o16 = (unsigned)lane * 16u, o8 = 1024u + (unsigned)lane * 8u; asm volatile("" : "+v"(o16), "+v"(o8));
#pragma unroll
        for (int k = 0; k < 4; ++k) { const int id = __builtin_amdgcn_readfirstlane(ids[k]) & 16383; const GAS unsigned char* vp = (const GAS unsigned char*)pg8::sgpr_ptr((const char*)(V6 + (size_t)id * ROW6));
            const v4u a = *(const GAS v4u*)(vp + o16); const v2u b = *(const GAS v2u*)(vp + o8); w[k] = (v6u){a.x, a.y, a.z, a.w, b.x, b.y}; }
    };
    auto compv = [&](const v6u (&w)[4], LAS float* gg, const int e0, v32f& o) __attribute__((always_inline)) {
        const f32x4 wv_ = *(const LAS f32x4*)(gg + e0);
#pragma unroll
        for (int k = 0; k < 4; ++k) { const v32f y = __builtin_amdgcn_cvt_scalef32_pk32_f32_fp6(w[k], 1.0f); o += y * wv_[k]; }
    };
    auto stage = [&](const int jp, LAS int* base, const int lane) __attribute__((always_inline)) {
        const size_t r0 = 2 * (size_t)jp, r1 = r0 + 1;
        const unsigned la = (unsigned)__builtin_amdgcn_readfirstlane((int)(unsigned)(__UINTPTR_TYPE__)base);
#define VP_DMA(gp, off) asm volatile("s_mov_b32 m0, %1\n\ts_nop 0\n\tglobal_load_lds_dword %0, off" :: "v"((const void*)(gp)), "s"(la + (off) * 4u) : "memory")
        VP_DMA(EIx + r0 * 128 + lane, 0); VP_DMA(EIx + r0 * 128 + 64 + lane, 64); VP_DMA(EIx + r1 * 128 + lane, 128); VP_DMA(EIx + r1 * 128 + 64 + lane, 192);
        VP_DMA(WGx + r0 * 128 + lane, 256); VP_DMA(WGx + r0 * 128 + 64 + lane, 320); VP_DMA(WGx + r1 * 128 + lane, 384); VP_DMA(WGx + r1 * 128 + 64 + lane, 448);
#undef VP_DMA
    };
    v6u wa[4], wb[4], wc[4], wd[4];
    {
        int l0 = lane0; asm volatile("" : "+v"(l0));
        LAS int* const b0 = (LAS int*)(lds + wave * 4096);
        stage(gw, b0, l0); asm volatile("s_waitcnt vmcnt(0)" ::: "memory");
        loadv(wa, b0, 0, l0); loadv(wb, b0 + 128, 0, l0); loadv(wc, b0, 4, l0);
    }
    int par = 0;
#pragma unroll 1
    for (int j = gw; j < NP; j += NGW) {
        int lane = lane0; asm volatile("" : "+v"(lane));
        LAS int* const EiA = (LAS int*)(lds + wave * 4096 + par * 2048); LAS int* const EiB = EiA + 128; LAS float* const GA = (LAS float*)(EiA + 256); LAS float* const GB = GA + 128;
        par ^= 1;
        LAS int* const nbase = (LAS int*)(lds + wave * 4096 + par * 2048);
        { const int jn = (j + NGW < NP) ? j + NGW : NP - 1; stage(jn, nbase, lane); }
        v32f o0, o1; v4u rw0[4], rw1[4]; float mu0, rs0, mu1, rs1;
#pragma unroll
        for (int i = 0; i < 32; ++i) { o0[i] = 0.f; o1[i] = 0.f; }
        {
#pragma unroll 1
            for (int e0 = 0; e0 < 120; e0 += 8) {
                loadv(wd, EiB, e0 + 4, lane);
                compv(wa, GA, e0, o0);
                loadv(wa, EiA, e0 + 8, lane);
                compv(wb, GB, e0, o1);
                loadv(wb, EiB, e0 + 8, lane);
                compv(wc, GA, e0 + 4, o0);
                loadv(wc, EiA, e0 + 12, lane);
                compv(wd, GB, e0 + 4, o1);
            }
            loadv(wd, EiB, 124, lane); compv(wa, GA, 120, o0); compv(wb, GB, 120, o1);
#pragma unroll
            for (int q = 0; q < 4; ++q) { rw0[q] = *(const v4u*)(R + (size_t)(2 * j) * D + lane * 32 + q * 8); rw1[q] = *(const v4u*)(R + (size_t)(2 * j + 1) * D + lane * 32 + q * 8); }
            mu0 = STx[32 * (size_t)(2 * j)]; rs0 = STx[32 * (size_t)(2 * j) + 1]; mu1 = STx[32 * (size_t)(2 * j + 1)]; rs1 = STx[32 * (size_t)(2 * j + 1) + 1];
            compv(wc, GA, 124, o0);
            LDS_WAIT();
            loadv(wa, nbase, 0, lane); loadv(wb, nbase + 128, 0, lane);
            compv(wd, GB, 124, o1);
        }
        auto finish = [&](const int r, const float mu, const float rstd, v32f& o, const v4u (&rw)[4]) __attribute__((always_inline)) {
            float s1 = 0.f;
#pragma unroll
            for (int q = 0; q < 4; ++q) {
                const v4u w = rw[q];
                const int p0_ = ((2 * q) * 64 + lane) * 4, p1_ = ((2 * q + 1) * 64 + lane) * 4;
                const f32x4 g0 = *(const LAS f32x4*)(PAR + p0_), g1 = *(const LAS f32x4*)(PAR + p1_), b0 = *(const LAS f32x4*)(PAR + 2048 + p0_), b1 = *(const LAS f32x4*)(PAR + 2048 + p1_);
                float xl[8];
                xl[0] = (bflo(w.x) - mu) * rstd * g0.x + b0.x; xl[1] = (bfhi(w.x) - mu) * rstd * g0.y + b0.y;
                xl[2] = (bflo(w.y) - mu) * rstd * g0.z + b0.z; xl[3] = (bfhi(w.y) - mu) * rstd * g0.w + b0.w;
                xl[4] = (bflo(w.z) - mu) * rstd * g1.x + b1.x; xl[5] = (bfhi(w.z) - mu) * rstd * g1.y + b1.y;
                xl[6] = (bflo(w.w) - mu) * rstd * g1.z + b1.z; xl[7] = (bfhi(w.w) - mu) * rstd * g1.w + b1.w;
#pragma unroll
                for (int c = 0; c < 8; ++c) { const int i = 8 * q + c; const int m = MK_FP6_ORDER ? ((i & 15) * 2 + (i >> 4)) : i; o[m] = xl[c] * ALPHA + o[m]; s1 += o[m]; }
            }
            const float mean = wave_sum(s1) * (1.f / D); float s2 = 0.f;
#pragma unroll
            for (int i = 0; i < 32; ++i) { o[i] = o[i] - mean; s2 += o[i] * o[i]; }
            const float rstd2 = 1.f / sqrtf(wave_sum(s2) * (1.f / D) + LN_EPS);
#pragma unroll
            for (int q = 0; q < 8; ++q) {
                const int e0 = lane * 32 + q * 4;
                const f32x4 g = *(const LAS f32x4*)(PAR + 4096 + (q * 64 + lane) * 4), bb = *(const LAS f32x4*)(PAR + 6144 + (q * 64 + lane) * 4);
                float oo[4];
#pragma unroll
                for (int c = 0; c < 4; ++c) { const int i = q * 4 + c; oo[c] = o[MK_FP6_ORDER ? ((i & 15) * 2 + (i >> 4)) : i]; }
                f32x4 y; y.x = oo[0] * rstd2 * g.x + bb.x; y.y = oo[1] * rstd2 * g.y + bb.y; y.z = oo[2] * rstd2 * g.z + bb.z; y.w = oo[3] * rstd2 * g.w + bb.w;
                *(f32x4*)(p.out + (size_t)r * D + e0) = y;
            }
        };
        finish(2 * j, mu0, rs0, o0, rw0);
        loadv(wc, nbase, 4, lane);
        finish(2 * j + 1, mu1, rs1, o1, rw1);
    }
}

__device__ __forceinline__ void phase_gemm_in(const Params& p, LAS unsigned char* lds) {
    pg8::Gemm g{(const bf16*)(p.ws + WS_H0F8), (const bf16*)(p.ws + WS_BT_IN8), MP, NINP, D / 2};
    pg8::StaticOrder S; S.init(MP, NINP, gridDim.x, blockIdx.x, MK_WGM_IN); S.colmap = MK_COLMAP;
    pg8::EpiInProj E{p.ws, (unsigned char*)p.out};
#if MK_STAG
    { const unsigned long long t0 = wall_clock64(); const unsigned long long d = (unsigned long long)(blockIdx.x & 3) * MK_STAG; while (wall_clock64() - t0 < d) __builtin_amdgcn_s_sleep(8); }
#endif
    pg8::gemm_phase<pg8::EpiInProj, pg8::StaticOrder, true, true, true>(lds, g, S, E);
}
__device__ __forceinline__ void phase_gemm_g2a(const Params& p, LAS unsigned char* lds) {
    pg8::Gemm g{(const bf16*)(p.ws + WS_YA8), (const bf16*)(p.ws + WS_BT_PA), MX, D, D / 2};
    pg8::StaticOrder S; S.init(MX, D, gridDim.x, blockIdx.x, MK_WGM_SQ);
    pg8::EpiGate<false> E{(const bf16*)(MK_DBG == 16 ? p.ws + WS_H0 : MK_DBG == 14 ? p.ws + 489 * MiB : (unsigned char*)p.out + OUT_SGA), nullptr, (bf16*)(p.ws + WS_TMP)};
    pg8::gemm_phase<pg8::EpiGate<false>, pg8::StaticOrder, MK_ALIGN, MK_SP2, true>(lds, g, S, E);
}
__device__ __forceinline__ void phase_gemm_g2b(const Params& p, LAS unsigned char* lds) {
    pg8::Gemm g{(const bf16*)(p.ws + WS_YB), (const bf16*)(p.ws + WS_BT_PB), MX, D, D / 2};
    pg8::StaticOrder S; S.init(MX, D, gridDim.x, blockIdx.x, MK_WGM_SQ);
    pg8::EpiGate<true> E{(const bf16*)((unsigned char*)p.out + OUT_SGB), (const bf16*)(p.ws + WS_TMP), (bf16*)(p.ws + WS_MERGED)};
    pg8::gemm_phase<pg8::EpiGate<true>, pg8::StaticOrder, MK_ALIGN, MK_SP2, true>(lds, g, S, E);
}
__device__ __forceinline__ void phase_gemm_g2(const Params& p, LAS unsigned char* lds) {
    static_assert(WS_YB > WS_YA8 && WS_BT_PB > WS_BT_PA, "the second product's operands sit behind the first's");
    pg8::Gemm g{(const bf16*)(p.ws + WS_YA8), (const bf16*)(p.ws + WS_BT_PA), MX, D, D / 2};
    pg8::StaticOrder S; S.init(MX, D, gridDim.x, blockIdx.x, MK_WGM_SQ);
    pg8::EpiGate2 E{(const unsigned char*)p.out + OUT_SGA, (const unsigned char*)p.out + OUT_SGB, p.ws + WS_MERGED};
    pg8::gemm_phase<pg8::EpiGate2, pg8::StaticOrder, MK_ALIGN, MK_SP2, true>(lds, g, S, E);
}
__device__ __forceinline__ void phase_gemm_g3(const Params& p, LAS unsigned char* lds) {
    pg8::Gemm g{(const bf16*)(p.ws + WS_MERGED), (const bf16*)(p.ws + WS_BT_WO), MX, D, D / 2};
    pg8::StaticOrder S; S.init(MX, D, gridDim.x, blockIdx.x, MK_WGM_SQ);
    pg8::EpiResid E{(const bf16*)(p.ws + WS_H0), (bf16*)(p.ws + WS_R)};
    pg8::gemm_phase<pg8::EpiResid, pg8::StaticOrder, MK_ALIGN, MK_SP2, true>(lds, g, S, E);
}
__device__ __forceinline__ void phase_gemm_pq(const Params& p, LAS unsigned char* lds) {
    pg8::Gemm g{(const bf16*)(p.ws + WS_R), (const bf16*)(p.ws + WS_BT_F), MX, D, D};
    pg8::StaticOrder S; S.init(MX, D, gridDim.x, blockIdx.x, MK_WGM_SQ);
    pg8::EpiScores E{(_Float16*)(p.ws + WS_TMP)};
    pg8::gemm_phase<pg8::EpiScores, pg8::StaticOrder, MK_ALIGN, MK_SP2>(lds, g, S, E);
}


namespace ml {
typedef short s16x4 __attribute__((ext_vector_type(4)));
typedef short bf16x8 __attribute__((ext_vector_type(8)));
typedef float f32x16 __attribute__((ext_vector_type(16)));
using mk::v4u; using mk::f32x4; using mk::bf16; using mk::Params;
constexpr int QROW = 272, KROW = 320, VROW = 576, PROW = 144, HROW = 528;
constexpr int L_QS = 0, L_QS2 = L_QS + 64 * QROW, L_KS = L_QS2 + 64 * QROW, L_VS = L_KS + 64 * KROW, L_PS = L_VS + 64 * VROW, L_HS = L_PS + 64 * PROW;
constexpr int L_VEC = L_HS + 64 * HROW;
constexpr int VECSET = 6 * 256;
constexpr int L_NS = L_VEC + 2 * VECSET;
constexpr int L_DEN = L_NS + 1024;
constexpr int L_TAB = L_DEN + 256;
constexpr int L_END = L_TAB + 1088;
static_assert(L_END <= mk::LDS_BYTES, "mLSTM LDS map");
constexpr size_t STATE_F = 32768 + 128;
constexpr size_t WS_STATE = mk::WS_BT_IN;
constexpr size_t WS_DT = mk::WS_BT_IN + 16 * 16 * STATE_F * 4;
static_assert(WS_DT + 1024 <= mk::WS_CB, "state region");

__device__ __forceinline__ int crow(int reg, int h) { return (reg & 3) + 8 * (reg >> 2) + 4 * h; }
__device__ __forceinline__ float scan_add(float v, int lane) {
#pragma unroll
    for (int o = 1; o < 64; o <<= 1) { const float t = __shfl_up(v, o); if (lane >= o) v += t; }
    return v;
}
__device__ __forceinline__ float scan_max(float v, int lane) {
#pragma unroll
    for (int o = 1; o < 64; o <<= 1) { const float t = __shfl_up(v, o); if (lane >= o) v = fmaxf(v, t); }
    return v;
}
__device__ __forceinline__ float wave_max(float v) {
#pragma unroll
    for (int o = 1; o < 64; o <<= 1) v = fmaxf(v, __shfl_xor(v, o));
    return v;
}
__device__ __forceinline__ void gate_load(const Params& p, int b, int hd, int ci, int lane, float& ip, float& fp) {
    const float* GIF = (const float*)(p.ws + mk::WS_GIF);
    const int row = (ci == 0) ? mk::MX + (lane & 15) : b * mk::SEQ + (ci - 1) * 64 + lane;
    ip = GIF[(size_t)row * 16 + hd]; fp = GIF[(size_t)row * 16 + 8 + hd];
}
__device__ __forceinline__ void gate_math(const Params& p, int hd, int ci, int lane, float ip, float fp, float& li, float& lf) {
    const bool pad = (ci == 0) && lane >= 16;
    ip += p.b_if[hd]; fp += p.b_if[8 + hd];
    li = pad ? -1e30f : ip;
    lf = pad ? 0.f : (fminf(fp, 0.f) - log1pf(__expf(-fabsf(fp))));
}
__device__ __forceinline__ bf16x8 tr_frag(LAS unsigned char* tile, int rowstride, int k0, int n0, int lane) {
    const int h = lane >> 5, blk = (lane >> 4) & 1, q = (lane & 15) >> 2, pp = lane & 3;
    LAS unsigned char* a = tile + (k0 + 8 * h + q) * rowstride + 2 * (n0 + 16 * blk + 4 * pp);
    const s16x4 lo = __builtin_amdgcn_ds_read_tr16_b64_v4i16((LAS s16x4*)a);
    const s16x4 hi = __builtin_amdgcn_ds_read_tr16_b64_v4i16((LAS s16x4*)(a + 4 * rowstride));
    return __builtin_shufflevector(lo, hi, 0, 1, 2, 3, 4, 5, 6, 7);
}
#define ML_MFMA32(a, b, c) __builtin_amdgcn_mfma_f32_32x32x16_bf16((a), (b), (c), 0, 0, 0)
#define ML_MFMA16(a, b, c) __builtin_amdgcn_mfma_f32_16x16x32_bf16((a), (b), (c), 0, 0, 0)

template <bool FULL>
__device__ __forceinline__ void mlstm_pass(const Params& p, LAS unsigned char* lds) {
    const int tid = pg8::ftid(), lane = tid & 63, w = __builtin_amdgcn_readfirstlane(tid >> 6);
    const int r = lane & 31, h5 = lane >> 5;
    const bf16* Qg = (const bf16*)(p.ws + mk::WS_Q); const bf16* Kg = (const bf16*)(p.ws + mk::WS_K); bf16* Vg = (bf16*)(p.ws + mk::WS_V);
    const bf16* SOg = (const bf16*)(p.ws + mk::WS_SIGO);
    float* STATE = (float*)(p.ws + WS_STATE); float* MU = (float*)(p.ws + WS_DT); float* BLS = MU + 256; const float* MSTART = MU + 512;
    LAS float* DEN = (LAS float*)(lds + L_DEN);
    int kc = 0;
    const int cgt = blockIdx.x * 512 + tid, cNT = gridDim.x * 512;
    for (int item = blockIdx.x; item < 256; item += gridDim.x) {
        const int bh = item >> 4, j = item & 15, b = bh >> 3, hd = bh & 7;
        const int nchunks = (j == 0) ? 9 : 8, ci0 = (j == 0) ? 0 : 8 * j + 1;
        float m_prev = FULL ? MSTART[bh * 16 + j] : -INFINITY;
        float blsum = 0.f;
        f32x16 Cacc[4];
        if (FULL && j > 0) {
            const float* src = STATE + ((size_t)bh * 16 + (j - 1)) * STATE_F;
#pragma unroll
            for (int i = 0; i < 4; ++i)
#pragma unroll
                for (int g = 0; g < 16; ++g) Cacc[i][g] = src[((w * 4 + i) * 16 + g) * 64 + lane];
            if (tid < 128) ((LAS float*)(lds + L_NS))[tid] = src[32768 + tid];
        } else {
#pragma unroll
            for (int i = 0; i < 4; ++i)
#pragma unroll
                for (int g = 0; g < 16; ++g) Cacc[i][g] = 0.f;
            if (tid < 128) ((LAS float*)(lds + L_NS))[tid] = 0.f;
        }
        v4u pq[2], pk[2], pv[4];
        auto issue_loads = [&](int ci, int tl) {
            const bool meta = (ci == 0);
            const bf16* kb = meta ? Kg + (size_t)16 * 8192 * 128 + (size_t)hd * 16 * 128 : Kg + ((size_t)bh * 8192 + (ci - 1) * 64) * 128;
            const bf16* vb = meta ? Vg + (size_t)16 * 8192 * 256 + (size_t)hd * 16 * 256 : Vg + ((size_t)bh * 8192 + (ci - 1) * 64) * 256;
            const bf16* qb = Qg + ((size_t)bh * 8192 + (meta ? 0 : (ci - 1) * 64)) * 128;
#pragma unroll
            for (int u = 0; u < 2; ++u) { const int id = tl + 512 * u, rr = id >> 4;
                const bool ok = !meta || rr < 16;
                pk[u] = ok ? *(const v4u*)(kb + (size_t)id * 8) : (v4u){0u, 0u, 0u, 0u};
                if (FULL) pq[u] = !meta ? *(const v4u*)(qb + (size_t)id * 8) : (v4u){0u, 0u, 0u, 0u}; }
#pragma unroll
            for (int u = 0; u < 4; ++u) { const int id = tl + 512 * u, rr = id >> 5;
                const bool ok = !meta || rr < 16;
                pv[u] = ok ? *(const v4u*)(vb + (size_t)id * 8) : (v4u){0u, 0u, 0u, 0u}; }
        };
        { int tl = tid; asm volatile("" : "+v"(tl)); issue_loads(ci0, tl); }
        float gip = 0.f, gfp = 0.f; if (w == 7) gate_load(p, b, hd, ci0, lane, gip, gfp);
        auto make_vec = [&](int kk) {
            const int cix = ci0 + kk;
            LAS float* VS_ = (LAS float*)(lds + L_VEC + (kk & 1) * VECSET);
            float li, lf; gate_math(p, hd, cix, lane, gip, gfp, li, lf);
            if (kk + 1 < nchunks) gate_load(p, b, hd, cix + 1, lane, gip, gfp);
            const float bb = scan_add(lf, lane); const float g = li - bb; const float G = fmaxf(m_prev, scan_max(g, lane));
            const float Gend = __shfl(G, 63), bl = __shfl(bb, 63);
            VS_[lane] = g; VS_[64 + lane] = G; VS_[128 + lane] = __expf(m_prev - G); VS_[192 + lane] = __expf(g - Gend); VS_[256 + lane] = __expf(-(bb + G));
            const float decay = __expf(m_prev - Gend);
            if (lane == 0) VS_[320] = decay;
            blsum += bl; m_prev = bl + Gend;
        };
        if (w == 7) make_vec(0);
#pragma unroll 1
        for (int k = 0; k < nchunks; ++k) {
            const int ci = ci0 + k; const bool meta = (ci == 0); const bool outp = FULL && !meta;
            int tl = tid; asm volatile("" : "+v"(tl));
            const int row0 = meta ? mk::MX : b * mk::SEQ + (ci - 1) * 64;
            LAS float* VEC = (LAS float*)(lds + L_VEC + (k & 1) * VECSET);
            LAS float* NScur = (LAS float*)(lds + L_NS + (k & 1) * 512); LAS float* NSnxt = (LAS float*)(lds + L_NS + ((k + 1) & 1) * 512);
#pragma unroll
            for (int u = 0; u < 2; ++u) { const int id = tid + 512 * u, rr = id >> 4, cp = id & 15;
                *(LAS v4u*)(lds + L_KS + rr * KROW + 16 * cp) = pk[u];
                if (FULL) *(LAS v4u*)(lds + L_QS + rr * QROW + 16 * cp) = pq[u]; }
#pragma unroll
            for (int u = 0; u < 4; ++u) { const int id = tid + 512 * u, rr = id >> 5, cp = id & 31; *(LAS v4u*)(lds + L_VS + rr * VROW + 16 * cp) = pv[u]; }
            __syncthreads();
            if (!FULL && k + 1 < nchunks) issue_loads(ci + 1, tl);
            mk::v2u czm2 = {0u, 0u}, czm1 = {0u, 0u}, cz[4], ccb[4]; int cs = -1;
            if (!FULL) { const int s_ = tl - tid + cgt + cNT * kc; if (k < 8 && s_ < mk::CONV_SLICES) { cs = s_; mk::conv_issue(p, cs, czm2, czm1, cz, ccb); ++kc; } }
            if (outp) {
#pragma unroll
                for (int u = 0; u < 2; ++u) { const int id = tid + 512 * u, rr = id >> 4, cp = id & 15; const float s = VEC[128 + rr]; const v4u q = pq[u];
                    v4u o; o.x = mk::pk2(mk::bflo(q.x) * s, mk::bfhi(q.x) * s); o.y = mk::pk2(mk::bflo(q.y) * s, mk::bfhi(q.y) * s); o.z = mk::pk2(mk::bflo(q.z) * s, mk::bfhi(q.z) * s); o.w = mk::pk2(mk::bflo(q.w) * s, mk::bfhi(q.w) * s);
                    *(LAS v4u*)(lds + L_QS2 + rr * QROW + 16 * cp) = o; }
            }
            if (outp) {
                const int ti = w >> 1, fr = lane & 15, fq = lane >> 4;
#pragma unroll
                for (int tt = 0; tt < 2; ++tt) { const int tj = 2 * (w & 1) + tt;
                    f32x4 sacc = (f32x4){0.f, 0.f, 0.f, 0.f};
                    if (tj <= ti) {
#pragma unroll
                        for (int kk = 0; kk < 4; ++kk) {
                            const bf16x8 a = *(const LAS bf16x8*)(lds + L_QS + (16 * ti + fr) * QROW + 2 * (32 * kk + 8 * fq));
                            const bf16x8 bb = *(const LAS bf16x8*)(lds + L_KS + (16 * tj + fr) * KROW + 2 * (32 * kk + 8 * fq));
                            sacc = ML_MFMA16(a, bb, sacc);
                        }
                    }
                    const int s = 16 * tj + fr; const float gs = VEC[s];
#pragma unroll
                    for (int i = 0; i < 4; ++i) { const int t = 16 * ti + 4 * fq + i; const float Gt = VEC[64 + t];
                        const float wgt = (s <= t) ? __expf(gs - Gt) : 0.f; const float pv_ = sacc[i] * wgt;
                        *(LAS unsigned short*)(lds + L_PS + t * PROW + 2 * s) = (unsigned short)(mk::pk2(pv_, 0.f) & 0xffffu); }
                }
            }
            __syncthreads();
            if (w == 7 && k + 1 < nchunks) make_vec(k + 1);
            v4u po[4];
            if (outp) {
#pragma unroll
                for (int u = 0; u < 4; ++u) po[u] = *(const v4u*)(SOg + ((size_t)bh * 8192 + (ci - 1) * 64 + (tl >> 3)) * 256 + 32 * (tl & 7) + 8 * u);
            }
            bf16x8 vf[4];
#pragma unroll
            for (int ks = 0; ks < 4; ++ks) vf[ks] = tr_frag(lds + L_VS, VROW, 16 * ks, 32 * w, lane);
            f32x16 Hacc[2];
            if (outp) {
#pragma unroll
                for (int ti = 0; ti < 2; ++ti) {
#pragma unroll
                    for (int g = 0; g < 16; ++g) Hacc[ti][g] = 0.f;
#pragma unroll
                    for (int ks = 0; ks < 4; ++ks) { const bf16x8 a = *(const LAS bf16x8*)(lds + L_PS + (32 * ti + r) * PROW + 2 * (16 * ks + 8 * h5)); Hacc[ti] = ML_MFMA32(a, vf[ks], Hacc[ti]); }
                    asm volatile("" ::: "memory");
                }
#pragma unroll
                for (int i = 0; i < 4; ++i)
#pragma unroll
                    for (int s = 0; s < 2; ++s) {
                        v4u cb; cb.x = mk::pk2(Cacc[i][8 * s], Cacc[i][8 * s + 1]); cb.y = mk::pk2(Cacc[i][8 * s + 2], Cacc[i][8 * s + 3]); cb.z = mk::pk2(Cacc[i][8 * s + 4], Cacc[i][8 * s + 5]); cb.w = mk::pk2(Cacc[i][8 * s + 6], Cacc[i][8 * s + 7]);
                        const bf16x8 bfrag = __builtin_bit_cast(bf16x8, cb);
#pragma unroll
                        for (int ti = 0; ti < 2; ++ti) {
                            const LAS unsigned char* qa = lds + L_QS2 + (32 * ti + r) * QROW + 2 * (32 * i + 16 * s + 4 * h5);
                            const s16x4 lo = *(const LAS s16x4*)qa, hi = *(const LAS s16x4*)(qa + 16);
                            Hacc[ti] = ML_MFMA32(__builtin_shufflevector(lo, hi, 0, 1, 2, 3, 4, 5, 6, 7), bfrag, Hacc[ti]);
                        }
                        asm volatile("" ::: "memory");
                    }
                { const int t = tid >> 3, part = tid & 7;
                  const v4u pr = *(const LAS v4u*)(lds + L_PS + t * PROW + 16 * part);
                  float d = ((mk::bflo(pr.x) + mk::bfhi(pr.x)) + (mk::bflo(pr.y) + mk::bfhi(pr.y))) + ((mk::bflo(pr.z) + mk::bfhi(pr.z)) + (mk::bflo(pr.w) + mk::bfhi(pr.w)));
#pragma unroll
                  for (int u = 0; u < 2; ++u) { const v4u qv = *(const LAS v4u*)(lds + L_QS2 + t * QROW + 32 * part + 16 * u); const LAS float* nn = NScur + 16 * part + 8 * u;
                      d += mk::bflo(qv.x) * nn[0] + mk::bfhi(qv.x) * nn[1] + mk::bflo(qv.y) * nn[2] + mk::bfhi(qv.y) * nn[3] + mk::bflo(qv.z) * nn[4] + mk::bfhi(qv.z) * nn[5] + mk::bflo(qv.w) * nn[6] + mk::bfhi(qv.w) * nn[7]; }
                  d = mk::oct_sum(d);
                  if (part == 0) DEN[t] = d; }
            }
            if (outp) {
#pragma unroll
                for (int ti = 0; ti < 2; ++ti)
#pragma unroll
                    for (int g = 0; g < 16; ++g) *(LAS unsigned short*)(lds + L_HS + (32 * ti + crow(g, h5)) * HROW + 2 * (32 * w + r)) = (unsigned short)(mk::pk2(Hacc[ti][g], 0.f) & 0xffffu);
            }
            if (FULL && k + 1 < nchunks) issue_loads(ci + 1, tl);
            {
                const float decay = VEC[320];
#pragma unroll
                for (int ks = 0; ks < 4; ++ks) { const f32x4 w0 = *(const LAS f32x4*)(VEC + 192 + 16 * ks + 8 * h5), w1 = *(const LAS f32x4*)(VEC + 192 + 16 * ks + 8 * h5 + 4);
                    const v4u x = __builtin_bit_cast(v4u, vf[ks]); v4u o;
                    o.x = mk::pk2(mk::bflo(x.x) * w0.x, mk::bfhi(x.x) * w0.y); o.y = mk::pk2(mk::bflo(x.y) * w0.z, mk::bfhi(x.y) * w0.w);
                    o.z = mk::pk2(mk::bflo(x.z) * w1.x, mk::bfhi(x.z) * w1.y); o.w = mk::pk2(mk::bflo(x.w) * w1.z, mk::bfhi(x.w) * w1.w);
                    vf[ks] = __builtin_bit_cast(bf16x8, o); }
#pragma unroll
                for (int i = 0; i < 4; ++i) {
#pragma unroll
                    for (int g = 0; g < 16; ++g) Cacc[i][g] *= decay;
#pragma unroll
                    for (int ks = 0; ks < 4; ++ks) { const bf16x8 a = tr_frag(lds + L_KS, KROW, 16 * ks, 32 * i, lane); Cacc[i] = ML_MFMA32(a, vf[ks], Cacc[i]); }
                    asm volatile("" ::: "memory");
                }
                if (tid < 128) { float a = decay * NScur[tid];
#pragma unroll 8
                    for (int s = 0; s < 64; ++s) a += VEC[192 + s] * mk::bf2f(*(const LAS unsigned short*)(lds + L_KS + s * KROW + 2 * tid));
                    NSnxt[tid] = a; }
            }
            if (!FULL) { if (cs >= 0) mk::conv_finish(p, cs, czm2, czm1, cz, ccb); }
            __syncthreads();
            if (outp) {
                const int t = tl >> 3, part = tl & 7;
                v4u hv[4]; float ss = 0.f;
#pragma unroll
                for (int u = 0; u < 4; ++u) { hv[u] = *(const LAS v4u*)(lds + L_HS + t * HROW + 2 * (32 * part + 8 * u));
                    const float a0 = mk::bflo(hv[u].x), a1 = mk::bfhi(hv[u].x), a2 = mk::bflo(hv[u].y), a3 = mk::bfhi(hv[u].y), a4 = mk::bflo(hv[u].z), a5 = mk::bfhi(hv[u].z), a6 = mk::bflo(hv[u].w), a7 = mk::bfhi(hv[u].w);
                    ss += ((a0 * a0 + a1 * a1) + (a2 * a2 + a3 * a3)) + ((a4 * a4 + a5 * a5) + (a6 * a6 + a7 * a7)); }
                ss = mk::oct_sum(ss);
                const float inv = 1.f / fmaxf(fabsf(DEN[t]), VEC[256 + t]);
                const float sc = inv / sqrtf(inv * inv * ss * (1.f / 256.f) + mk::LN_EPS);
                const GAS float* nw = (const GAS float*)(p.mh_w + hd * 256 + 32 * part); asm volatile("" : "+v"(nw));
                unsigned char* dst = p.ws + mk::WS_YB + (size_t)(row0 + t) * 2048 + hd * 256 + 32 * part;
                unsigned o8[8];
#pragma unroll
                for (int u = 0; u < 4; ++u) { const f32x4 n0 = *(const GAS f32x4*)(nw + 8 * u), n1 = *(const GAS f32x4*)(nw + 8 * u + 4); const v4u so = po[u], hh = hv[u];
                    o8[2 * u] = mk::pk4_fp8(mk::bflo(so.x) * n0.x * sc * mk::bflo(hh.x), mk::bfhi(so.x) * n0.y * sc * mk::bfhi(hh.x), mk::bflo(so.y) * n0.z * sc * mk::bflo(hh.y), mk::bfhi(so.y) * n0.w * sc * mk::bfhi(hh.y));
                    o8[2 * u + 1] = mk::pk4_fp8(mk::bflo(so.z) * n1.x * sc * mk::bflo(hh.z), mk::bfhi(so.z) * n1.y * sc * mk::bfhi(hh.z), mk::bflo(so.w) * n1.z * sc * mk::bflo(hh.w), mk::bfhi(so.w) * n1.w * sc * mk::bfhi(hh.w)); }
                *(v4u*)dst = (v4u){o8[0], o8[1], o8[2], o8[3]}; *(v4u*)(dst + 16) = (v4u){o8[4], o8[5], o8[6], o8[7]};
            }
        }
        if (!FULL) {
            float* dst = STATE + ((size_t)bh * 16 + j) * STATE_F;
#pragma unroll
            for (int i = 0; i < 4; ++i)
#pragma unroll
                for (int g = 0; g < 16; ++g) dst[((w * 4 + i) * 16 + g) * 64 + lane] = Cacc[i][g];
            if (tid < 128) dst[32768 + tid] = ((LAS float*)(lds + L_NS + (nchunks & 1) * 512))[tid];
            if (tid == 448) { MU[bh * 16 + j] = m_prev; BLS[bh * 16 + j] = blsum; }
        }
        __syncthreads();
    }
    if (!FULL) {
#pragma unroll 1
        for (;; ++kc) { const long long s_ = (long long)cgt + (long long)cNT * kc; if (s_ >= mk::CONV_SLICES) break;
            mk::v2u czm2, czm1, cz[4], ccb[4]; mk::conv_issue(p, (int)s_, czm2, czm1, cz, ccb); mk::conv_finish(p, (int)s_, czm2, czm1, cz, ccb); }
    }
}
__device__ __forceinline__ void mlstm_combine(const Params& p) {
    float* STATE = (float*)(p.ws + WS_STATE); const float* MU = (const float*)(p.ws + WS_DT); const float* BLS = MU + 256; float* MSTART = (float*)(p.ws + WS_DT) + 512;
    const int tid = pg8::ftid();
#pragma unroll 1
    for (int w = blockIdx.x; w < 256; w += gridDim.x) {
        const int bh = w >> 4, sub = w & 15;
        float dj[15], sa[15]; float mm = 0.f;
        if (sub == 0 && tid == 0) MSTART[bh * 16] = 0.f;
#pragma unroll
        for (int j = 0; j < 15; ++j) {
            const float mu = MU[bh * 16 + j], bls = BLS[bh * 16 + j];
            const float mn = bls + fmaxf(mm, mu - bls);
            dj[j] = __expf(mm + bls - mn); sa[j] = __expf(mu - mn); mm = mn;
            if (sub == 0 && tid == 0) MSTART[bh * 16 + j + 1] = mn;
        }
        float a[5][15];
#pragma unroll
        for (int k = 0; k < 5; ++k) { const int el = sub * 512 + tid + k * 8192; const bool ok = el < STATE_F;
#pragma unroll
            for (int j = 0; j < 15; ++j) a[k][j] = ok ? STATE[((size_t)bh * 16 + j) * STATE_F + el] : 0.f; }
#pragma unroll
        for (int k = 0; k < 5; ++k) { float c = 0.f;
#pragma unroll
            for (int j = 0; j < 15; ++j) { c = dj[j] * c + sa[j] * a[k][j]; a[k][j] = c; } }
#pragma unroll
        for (int k = 0; k < 5; ++k) { const int el = sub * 512 + tid + k * 8192;
            if (el < STATE_F) {
#pragma unroll
                for (int j = 0; j < 15; ++j) STATE[((size_t)bh * 16 + j) * STATE_F + el] = a[k][j]; } }
    }
}
}
typedef GAS unsigned gu32;
#define XB_TMO      128
#define XB_XCNT(j)  (256  + 64 * (j))
#define XB_XSUB(j)  (1280 + 64 * (j))
#define XB_XGEN(j)  (2304 + 64 * (j))
#define XB_TOP      3328
#define XB_TOPGEN   3392
#define XCD_BAR_WORDS 3456
#define XB_SPIN_CAP (1u << 18)

__device__ __forceinline__ unsigned xb_ld(unsigned* p)              { return __hip_atomic_load(p, __ATOMIC_RELAXED, __HIP_MEMORY_SCOPE_AGENT); }
__device__ __forceinline__ unsigned xb_add(unsigned* p, unsigned v) { return __hip_atomic_fetch_add(p, v, __ATOMIC_RELAXED, __HIP_MEMORY_SCOPE_AGENT); }
__device__ __forceinline__ unsigned xb_xcc_id() { return (unsigned)__builtin_amdgcn_s_getreg((3 << 11) | 20) & 0xFu; }
#define XB_SPIN(cond, bar) do { unsigned _sp = 0; while (cond) { __builtin_amdgcn_s_sleep(1); \
    if ((++_sp & 255u) == 0u) { if (xb_ld(&(bar)[XB_TMO])) break; if (_sp > XB_SPIN_CAP) { atomicAdd(&(bar)[XB_TMO], 1u); break; } } } } while (0)

struct XcdBarrier {
    unsigned* bar; unsigned x;
    volatile LAS unsigned* st;
};

__device__ __forceinline__ XcdBarrier xcd_barrier_post(unsigned* bar, volatile LAS unsigned* st) {
    XcdBarrier b; b.bar = bar; b.x = xb_xcc_id(); b.st = st;
    if (threadIdx.x == 0) (void)xb_add(&bar[XB_XCNT(b.x)], 1u);
    return b;
}
__device__ __forceinline__ void xcd_barrier_complete(unsigned* bar, unsigned x, unsigned& nloc, unsigned& nx) {
    const unsigned G = gridDim.x * gridDim.y * gridDim.z;
    unsigned sum, cnt, mine, sp = 0u;
    for (;;) {
        sum = 0u; cnt = 0u; mine = 0u;
#pragma unroll 1
        for (unsigned j = 0; j < 16; ++j) { const unsigned c = xb_ld(&bar[XB_XCNT(j)]); sum += c; cnt += (c > 0u) ? 1u : 0u; mine = (j == x) ? c : mine; }
        if (sum == G) break;
        __builtin_amdgcn_s_sleep(1);
        if ((++sp & 255u) == 0u) { if (xb_ld(&bar[XB_TMO])) break; if (sp > XB_SPIN_CAP) { atomicAdd(&bar[XB_TMO], 1u); break; } }
    }
    nloc = mine > 0u ? mine : 1u; nx = cnt > 0u ? cnt : 1u;
}

__device__ __forceinline__ void xcd_barrier(const XcdBarrier& b) {
    asm volatile("s_waitcnt vmcnt(0)" ::: "memory");
    __syncthreads();
    if (threadIdx.x == 0) {
        unsigned* bar = b.bar;
        __builtin_amdgcn_s_waitcnt(0);
        unsigned nloc = b.st[0], nx = b.st[1];
        if (nloc == 0u) { xcd_barrier_complete(bar, b.x, nloc, nx); b.st[0] = nloc; b.st[1] = nx; }
        const unsigned old = xb_add(&bar[XB_XSUB(b.x)], 1u);
        const unsigned gen = old / nloc;
        if (old + 1u == (gen + 1u) * nloc) {
            __builtin_amdgcn_fence(__ATOMIC_RELEASE, "agent");
            asm volatile("s_waitcnt vmcnt(0)" ::: "memory");
            const unsigned og = xb_add(&bar[XB_TOP], 1u);
            const unsigned tg = og / nx;
            if (og + 1u == (tg + 1u) * nx) xb_add(&bar[XB_TOPGEN], 1u);
            else XB_SPIN(xb_ld(&bar[XB_TOPGEN]) == tg, bar);
            __builtin_amdgcn_fence(__ATOMIC_ACQUIRE, "agent");
            xb_add(&bar[XB_XGEN(b.x)], 1u);
            asm volatile("s_waitcnt vmcnt(0)" ::: "memory");
        } else {
            XB_SPIN(xb_ld(&bar[XB_XGEN(b.x)]) == gen, bar);
            __builtin_amdgcn_fence(__ATOMIC_ACQUIRE, "agent");
            asm volatile("s_waitcnt vmcnt(0)" ::: "memory");
        }
    }
    __syncthreads();
}

constexpr int CW_BAR = 4096;
constexpr int LDS_BARST = LDS_BYTES - 64;
static_assert((CW_BAR + XCD_BAR_WORDS) * 4 <= 65536, "barrier words inside the memset region");
__global__ void __launch_bounds__(512, 2) k_fused(Params p) {
    extern __shared__ __attribute__((aligned(16))) unsigned char lds_raw[]; LAS unsigned char* lds = (LAS unsigned char*)lds_raw;
    if (pg8::ftid() < 16) ((LAS unsigned*)(lds + LDS_BARST))[pg8::ftid()] = 0u;
    __syncthreads();
    (void)xcd_barrier_post((unsigned*)(p.ws + WS_CTL) + CW_BAR, (volatile LAS unsigned*)(lds + LDS_BARST));
#define GRID_SYNC() do { XcdBarrier b_; b_.bar = (unsigned*)(p.ws + WS_CTL) + CW_BAR; b_.x = xb_xcc_id(); b_.st = (volatile LAS unsigned*)(lds + LDS_BARST); xcd_barrier(b_); } while (0)
#define MK_REP(bit) for (int rep_ = 0; rep_ < (((MK_PROBE) >> (bit)) & 1) + 1; ++rep_)
    MK_REP(0) { phase0(p, lds); GRID_SYNC(); }
    MK_REP(1) { phase_gemm_in(p, lds); phase_uvconv_early(p); GRID_SYNC(); }
    MK_REP(2) { ml::mlstm_pass<false>(p, lds); } phase_c1c0(p); GRID_SYNC();
    ml::mlstm_combine(p); GRID_SYNC();
    MK_REP(8) { ml::mlstm_pass<true>(p, lds); } GRID_SYNC();
    MK_REP(3) { phase_uvconv(p); }
    MK_REP(4) { phase_gemm_g2(p, lds); } GRID_SYNC();
    MK_REP(5) { phase_gemm_g3(p, lds); GRID_SYNC(); }
    MK_REP(6) { phase_gemm_pq(p, lds); GRID_SYNC(); }
    if ((MK_PROBE >> 7) & 1) { for (int i = 0; i < 8; ++i) GRID_SYNC(); }
#if MK_PEER_SPLIT
#if MK_PEER_SPLIT == 3
    peer_fill_par(p, lds);
    {
        constexpr int HT = MX / 2;
#if MK_PEER_OVL
        phase_peer_sel(p, lds, 0, HT, 0, 8); GRID_SYNC();
        phase_peer_us(p, lds, 0, HT, 0, 8); GRID_SYNC();
        phase_peer_sel(p, lds, HT, MX, 0, 4); phase_peer<1>(p, lds, 0, HT, 4, 4); GRID_SYNC();
        phase_peer_us(p, lds, HT, MX, 0, 8); GRID_SYNC();
        phase_peer<1>(p, lds, HT, MX, 0, 8);
#else
        MK_REP(15) { phase_peer_sel(p, lds, 0, MX, 0, 8, true); GRID_SYNC(); }
        MK_REP(17) { phase_peer_us(p, lds, 0, MX, 0, 8, (((MK_PROBE) >> 18) & 1) && rep_ == 0 ? 1 : 0); GRID_SYNC(); }
#if MK_VPAIR
        phase_peer_v2(p, lds);
#else
        phase_peer<1>(p, lds, 0, MX, 0, 8);
#endif
#endif
    }
#else
    MK_REP(15) { phase_peer<0>(p, lds); GRID_SYNC(); } MK_REP(16) { phase_peer<1>(p, lds); if (rep_ == 0 && ((MK_PROBE >> 16) & 1)) GRID_SYNC(); }
#endif
#else
    phase_peer<2>(p, lds);
#endif
}
}

extern "C" void kernel_launch(void* const* d_in, const int* in_sizes, int n_in, void* d_out, int out_size, void* d_ws, size_t ws_size, hipStream_t stream) {
    using namespace mk;
    static int grid = 0;
    if (grid == 0) {
        if (n_in != 19 || ws_size < WS_END || out_size != MX * D) { fprintf(stderr, "kernel_launch: unexpected shapes (n_in %d, ws %zu, out %d)\n", n_in, ws_size, out_size); grid = -1; return; }
        if (hipFuncSetAttribute((const void*)k_fused, hipFuncAttributeMaxDynamicSharedMemorySize, LDS_BYTES) != hipSuccess) { fprintf(stderr, "kernel_launch: hipFuncSetAttribute failed\n"); grid = -1; return; }
        int dev = 0, cus = 0, per_cu = 0; (void)hipGetDevice(&dev); (void)hipDeviceGetAttribute(&cus, hipDeviceAttributeMultiprocessorCount, dev);
        if (hipOccupancyMaxActiveBlocksPerMultiprocessor(&per_cu, (const void*)k_fused, 512, LDS_BYTES) != hipSuccess || per_cu < 1) { fprintf(stderr, "kernel_launch: occupancy query says %d blocks per CU\n", per_cu); grid = -1; return; }
        grid = cus;
    }
    if (grid < 0) return;
    Params p{};
    const float** pf = (const float**)&p;
    for (int i = 0; i < 19; ++i) pf[i] = (const float*)d_in[i];
    p.out = (float*)d_out; p.ws = (unsigned char*)d_ws;
    if (hipMemsetAsync((char*)d_ws + WS_CTL, 0, 65536, stream) != hipSuccess) { fprintf(stderr, "kernel_launch: hipMemsetAsync of the barrier words failed\n"); return; }
    hipLaunchKernelGGL(k_fused, dim3(grid), dim3(512), LDS_BYTES, stream, p);
}
```
